# Optimizing an MI355X kernel written in HIP

```python
import math
import jax, jax.numpy as jnp
from jax import lax
import numpy as np

D_MODEL = 1024
BATCH = 16
SEQ = 2048
DEPTH = 4

MEM_LEN = 256
ML_HEADS = 4
ML_DHEAD = 128
SB_HEADS = 4
SB_DHEAD = 128
ML_WIDTH = ML_HEADS * ML_DHEAD
SB_WIDTH = SB_HEADS * SB_DHEAD
D_MIX = ML_WIDTH + SB_WIDTH
CONV_W = 4
ML_CHUNK = 128
SB_BLOCK = 128
IN_SIZES = (ML_WIDTH, ML_WIDTH, ML_WIDTH, ML_WIDTH, ML_HEADS, ML_HEADS, SB_WIDTH, SB_WIDTH, SB_WIDTH)
D_IN = 4 * ML_WIDTH + 2 * ML_HEADS + 3 * SB_WIDTH
XA_HEADS = 4
XA_DHEAD = D_MODEL // XA_HEADS
N_GROUPS = 4
EXP_PER_GROUP = 4
TOP_K = 2
D_EXPERT = 512
EPS = 1e-6

kernel_name = 'hybrid_mlstm_stickbreak_hmoe'


def rmsnorm(x, g):
    x32 = x.astype(jnp.float32)
    y = x32 * lax.rsqrt(jnp.mean(x32 * x32, axis=-1, keepdims=True) + EPS)
    return y.astype(x.dtype) * g


def head_rmsnorm(y, g):
    H, d = y.shape[-2], y.shape[-1]
    y32 = y.astype(jnp.float32)
    y32 = y32 * lax.rsqrt(jnp.mean(y32 * y32, axis=-1, keepdims=True) + EPS)
    return y32.astype(g.dtype) * g.reshape(H, d)


def causal_conv(x, w, b):
    S = x.shape[1]
    xp = jnp.pad(x, ((0, 0), (CONV_W - 1, 0), (0, 0)))
    y = b
    for tap in range(CONV_W):
        y = y + xp[:, tap:tap + S] * w[tap]
    return y


def mlstm_chunkwise(q, k, v, i_pre, f_pre):
    B, S, H, d = q.shape
    L = ML_CHUNK
    nc = S // L
    f32 = jnp.float32

    def chunks(t):
        return t.astype(f32).reshape(B, nc, L, H, d).transpose(1, 0, 3, 2, 4)

    def gchunks(t):
        return t.astype(f32).reshape(B, nc, L, H).transpose(1, 0, 3, 2)

    qc = chunks(q)
    kc = chunks(k) * (d ** -0.5)
    vc = chunks(v)
    ic = gchunks(i_pre)
    bc = jnp.cumsum(jax.nn.log_sigmoid(gchunks(f_pre)), axis=-1)
    causal = jnp.tril(jnp.ones((L, L), dtype=bool))

    def step(carry, inp):
        C, n, m = carry
        q_, k_, v_, i_, b_ = inp
        logd = b_[..., :, None] - b_[..., None, :] + i_[..., None, :]
        logd = jnp.where(causal, logd, -jnp.inf)
        inter = b_ + m[..., None]
        m_t = jnp.maximum(inter, jnp.max(logd, axis=-1))
        s = jnp.einsum('bhtd,bhsd->bhts', q_, k_) * jnp.exp(logd - m_t[..., None])
        w_inter = jnp.exp(inter - m_t)
        num = jnp.einsum('bhts,bhsd->bhtd', s, v_) + w_inter[..., None] * jnp.einsum('bhvk,bhtk->bhtv', C, q_)
        den = jnp.sum(s, axis=-1) + w_inter * jnp.einsum('bhk,bhtk->bht', n, q_)
        h = num / jnp.maximum(jnp.abs(den), jnp.exp(-m_t))[..., None]
        b_last = b_[..., -1]
        end_log = b_last[..., None] - b_ + i_
        m_new = jnp.maximum(b_last + m, jnp.max(end_log, axis=-1))
        w_old = jnp.exp(b_last + m - m_new)
        w_s = jnp.exp(end_log - m_new[..., None])
        C_new = w_old[..., None, None] * C + jnp.einsum('bhs,bhsv,bhsk->bhvk', w_s, v_, k_)
        n_new = w_old[..., None] * n + jnp.einsum('bhs,bhsk->bhk', w_s, k_)
        return (C_new, n_new, m_new), h

    init = (jnp.zeros((B, H, d, d), f32), jnp.zeros((B, H, d), f32), jnp.zeros((B, H), f32))
    _, hc = lax.scan(step, init, (qc, kc, vc, ic, bc))
    return hc.transpose(1, 0, 3, 2, 4).reshape(B, S, H, d)


def stick_breaking(q, k, v):
    B, S, H, d = q.shape
    f32 = jnp.float32
    qh = q.astype(f32).transpose(0, 2, 1, 3) * (d ** -0.5)
    kh = k.astype(f32).transpose(0, 2, 1, 3)
    vh = v.astype(f32).transpose(0, 2, 1, 3)
    outs = []
    for blk in range(S // SB_BLOCK):
        t0 = blk * SB_BLOCK
        t1 = t0 + SB_BLOCK
        z = jnp.einsum('bhtd,bhsd->bhts', qh[:, :, t0:t1], kh[:, :, :t1])
        t_idx = t0 + jnp.arange(SB_BLOCK)[:, None]
        s_idx = jnp.arange(t1)[None, :]
        mask = s_idx < t_idx
        log_1m = jnp.where(mask, jax.nn.log_sigmoid(-z), 0.0)
        tail = lax.cumsum(log_1m, axis=3, reverse=True) - log_1m
        a = jnp.where(mask, jnp.exp(jax.nn.log_sigmoid(z) + tail), 0.0)
        outs.append(jnp.einsum('bhts,bhsd->bhtd', a, vh[:, :, :t1]))
    o = jnp.concatenate(outs, axis=2)
    return o.transpose(0, 2, 1, 3)


def parallel_mixer(h, w_in, conv_w, conv_b, i_bias, f_bias, ml_head_g, sb_head_g, w_out):
    B, S, _ = h.shape
    proj = h @ w_in
    cuts = []
    acc = 0
    for sz in IN_SIZES[:-1]:
        acc += sz
        cuts.append(acc)
    mq, mk, mv, mo, mi, mf, sq, sk, sv = jnp.split(proj, cuts, axis=-1)
    qk = jax.nn.silu(causal_conv(jnp.concatenate([mq, mk], axis=-1), conv_w, conv_b))
    mq, mk = qk[..., :ML_WIDTH], qk[..., ML_WIDTH:]
    hs = (B, S, ML_HEADS, ML_DHEAD)
    h_ml = mlstm_chunkwise(mq.reshape(hs), mk.reshape(hs), mv.reshape(hs), mi + i_bias, mf + f_bias)
    h_ml = jax.nn.sigmoid(mo).reshape(hs) * head_rmsnorm(h_ml.astype(h.dtype), ml_head_g)
    ss = (B, S, SB_HEADS, SB_DHEAD)
    h_sb = stick_breaking(sq.reshape(ss), sk.reshape(ss), sv.reshape(ss))
    h_sb = head_rmsnorm(h_sb.astype(h.dtype), sb_head_g)
    y = jnp.concatenate([h_ml.reshape(B, S, ML_WIDTH), h_sb.reshape(B, S, SB_WIDTH)], axis=-1)
    return y @ w_out


def memory_attention(h, m, w_mq, w_mk, w_mv, w_mo):
    B, S, D = h.shape
    M = m.shape[1]
    q = (h @ w_mq).reshape(B, S, XA_HEADS, XA_DHEAD)
    k = (m @ w_mk).reshape(B, M, XA_HEADS, XA_DHEAD)
    v = (m @ w_mv).reshape(B, M, XA_HEADS, XA_DHEAD)
    s = jnp.einsum('bshd,bmhd->bhsm', q, k).astype(jnp.float32) * (XA_DHEAD ** -0.5)
    p = jax.nn.softmax(s, axis=-1).astype(v.dtype)
    o = jnp.einsum('bhsm,bmhd->bshd', p, v).reshape(B, S, D)
    return o @ w_mo


def hier_moe(h, w_rg, b_rg, w_re, b_re, w_e1, w_e3, w_e2):
    B, S, D = h.shape
    t = h.reshape(-1, D)
    n_tok = t.shape[0]
    p_g = jax.nn.softmax((t @ w_rg + b_rg).astype(jnp.float32), axis=-1)
    onehot_g = jax.nn.one_hot(jnp.argmax(p_g, axis=-1), N_GROUPS, dtype=jnp.float32)
    p_sel = jnp.sum(p_g * onehot_g, axis=-1)
    e_logits = (t @ w_re + b_re).astype(jnp.float32).reshape(n_tok, N_GROUPS, EXP_PER_GROUP)
    e_sel = jnp.einsum('nge,ng->ne', e_logits, onehot_g)
    top_w, top_i = lax.top_k(jax.nn.softmax(e_sel, axis=-1), TOP_K)
    top_w = top_w / jnp.sum(top_w, axis=-1, keepdims=True)
    e_gate = jnp.sum(jax.nn.one_hot(top_i, EXP_PER_GROUP, dtype=jnp.float32) * top_w[..., None], axis=1)
    gate = (onehot_g[:, :, None] * (p_sel[:, None] * e_gate)[:, None, :]).astype(h.dtype)
    y = jnp.zeros((n_tok, D), h.dtype)
    for g in range(N_GROUPS):
        a = jnp.einsum('nd,edf->nef', t, w_e1[g])
        u = jnp.einsum('nd,edf->nef', t, w_e3[g])
        y = y + jnp.einsum('nef,efd->nd', jax.nn.silu(a) * u * gate[:, g, :, None], w_e2[g])
    return y.reshape(B, S, D)


def setup_inputs(seed: int = 0) -> dict:
    key = jax.random.key(seed)
    ks = jax.random.split(key, 32)
    nrm = jax.random.normal
    f32 = jnp.float32
    G, E, F = N_GROUPS, EXP_PER_GROUP, D_EXPERT
    return {
        'x': nrm(ks[0], (BATCH, SEQ, D_MODEL), f32),
        'mem': nrm(ks[1], (BATCH, MEM_LEN, D_MODEL), f32),
        'ln_mix': 1.0 + 0.02 * nrm(ks[2], (DEPTH, D_MODEL), f32),
        'w_in': nrm(ks[3], (DEPTH, D_MODEL, D_IN), f32) * D_MODEL ** -0.5,
        'conv_w': nrm(ks[4], (DEPTH, CONV_W, 2 * ML_WIDTH), f32) * CONV_W ** -0.5,
        'conv_b': 0.02 * nrm(ks[5], (DEPTH, 2 * ML_WIDTH), f32),
        'i_bias': 0.1 * nrm(ks[6], (DEPTH, ML_HEADS), f32),
        'f_bias': jnp.linspace(3.0, 6.0, ML_HEADS, dtype=f32)[None, :] + 0.1 * nrm(ks[7], (DEPTH, ML_HEADS), f32),
        'ml_head_g': 1.0 + 0.02 * nrm(ks[8], (DEPTH, ML_WIDTH), f32),
        'sb_head_g': 1.0 + 0.02 * nrm(ks[9], (DEPTH, SB_WIDTH), f32),
        'w_out': nrm(ks[10], (DEPTH, D_MIX, D_MODEL), f32) * D_MIX ** -0.5,
        'ln_mem': 1.0 + 0.02 * nrm(ks[11], (DEPTH, D_MODEL), f32),
        'ln_memkv': 1.0 + 0.02 * nrm(ks[12], (DEPTH, D_MODEL), f32),
        'w_mq': nrm(ks[13], (DEPTH, D_MODEL, D_MODEL), f32) * D_MODEL ** -0.5,
        'w_mk': nrm(ks[14], (DEPTH, D_MODEL, D_MODEL), f32) * D_MODEL ** -0.5,
        'w_mv': nrm(ks[15], (DEPTH, D_MODEL, D_MODEL), f32) * D_MODEL ** -0.5,
        'w_mo': nrm(ks[16], (DEPTH, D_MODEL, D_MODEL), f32) * D_MODEL ** -0.5,
        'ln_ffn': 1.0 + 0.02 * nrm(ks[17], (DEPTH, D_MODEL), f32),
        'w_rg': nrm(ks[18], (DEPTH, D_MODEL, G), f32) * D_MODEL ** -0.5,
        'b_rg': 0.01 * nrm(ks[19], (DEPTH, G), f32),
        'w_re': nrm(ks[20], (DEPTH, D_MODEL, G * E), f32) * D_MODEL ** -0.5,
        'b_re': 0.01 * nrm(ks[21], (DEPTH, G * E), f32),
        'w_e1': nrm(ks[22], (DEPTH, G, E, D_MODEL, F), f32) * D_MODEL ** -0.5,
        'w_e3': nrm(ks[23], (DEPTH, G, E, D_MODEL, F), f32) * D_MODEL ** -0.5,
        'w_e2': nrm(ks[24], (DEPTH, G, E, F, D_MODEL), f32) * F ** -0.5,
        'ln_final': 1.0 + 0.02 * nrm(ks[25], (D_MODEL,), f32),
    }


def reference(x, mem, ln_mix, w_in, conv_w, conv_b, i_bias, f_bias, ml_head_g, sb_head_g, w_out,
              ln_mem, ln_memkv, w_mq, w_mk, w_mv, w_mo, ln_ffn, w_rg, b_rg, w_re, b_re,
              w_e1, w_e3, w_e2, ln_final):
    for l in range(DEPTH):
        h = rmsnorm(x, ln_mix[l])
        x = x + parallel_mixer(h, w_in[l], conv_w[l], conv_b[l], i_bias[l], f_bias[l],
                               ml_head_g[l], sb_head_g[l], w_out[l])
        h = rmsnorm(x, ln_mem[l])
        m = rmsnorm(mem, ln_memkv[l])
        x = x + memory_attention(h, m, w_mq[l], w_mk[l], w_mv[l], w_mo[l])
        h = rmsnorm(x, ln_ffn[l])
        x = x + hier_moe(h, w_rg[l], b_rg[l], w_re[l], b_re[l], w_e1[l], w_e3[l], w_e2[l])
    return rmsnorm(x, ln_final)
```

```cpp
#include <hip/hip_runtime.h>
#include <cstdio>
#include <cstdint>

#ifndef MK_N_LAUNCHES
#define MK_N_LAUNCHES 1
#endif

#ifndef MK_PROBE_QSTART
#define MK_PROBE_QSTART 0
#endif
#ifndef MK_PROBE_MODE
#define MK_PROBE_MODE 0
#endif
#ifndef MK_REPEAT_P
#define MK_REPEAT_P (-1)
#endif
#define LAS __attribute__((address_space(3)))
#define GAS __attribute__((address_space(1)))
typedef unsigned short bf16;
typedef short bf16x8 __attribute__((ext_vector_type(8)));
typedef float f32x4 __attribute__((ext_vector_type(4)));
typedef float f32x2 __attribute__((ext_vector_type(2)));
typedef unsigned u32x4 __attribute__((ext_vector_type(4)));
typedef unsigned u32x2 __attribute__((ext_vector_type(2)));

constexpr int D = 1024, BATCH = 16, SEQ = 2048, DEPTH = 4, NTOK = BATCH * SEQ, MEML = 256, NMEM = BATCH * MEML;
constexpr int MLH = 4, DH = 128, MLW = 512, DIN = 3592, NPROJ = 3584, NINP = 3840;
constexpr int XAH = 4, XAD = 256, NG = 4, NE = 4, DEXP = 512, NCLS = 24, CLSCAP = NTOK;
constexpr float EPS = 1e-6f;
constexpr int NWAVES = 8, NTHREADS = 512;
constexpr int PH_PER_LAYER = 13, PH_FINAL = DEPTH * PH_PER_LAYER, N_PHASES = PH_FINAL + 1;

constexpr size_t MiB = 1u << 20;
constexpr size_t WS_CTL = 0, CTL_ZERO_BYTES = 64 * 1024;
constexpr size_t WS_WR = 1 * MiB;
constexpr size_t WS_WIN = 2 * MiB;
constexpr size_t WS_WOUT = WS_WIN + (size_t)NINP * D * 2;
constexpr size_t WS_WMQ = WS_WOUT + 2 * MiB;
constexpr size_t WS_WMKV = WS_WMQ + 2 * MiB;
constexpr size_t WS_WMO = WS_WMKV + 4 * MiB;
constexpr size_t WS_W13 = WS_WMO + 2 * MiB;
constexpr size_t WS_W2C = WS_W13 + 32 * MiB;
constexpr size_t WS_XB = WS_W2C + 48 * MiB;
constexpr size_t WS_SSQ = WS_XB + 64 * MiB;
constexpr size_t WS_MEMB = WS_SSQ + 2 * MiB;
constexpr size_t WS_MEMR = WS_MEMB + 8 * MiB;
constexpr size_t WS_TOKINFO = WS_MEMR + 64 * 1024, WS_CNTB = WS_MEMR + 640 * 1024;
constexpr size_t WS_KV = WS_MEMR + 1 * MiB;
constexpr size_t WS_GATES = WS_KV + 16 * MiB;
constexpr size_t WS_Y = WS_GATES + 1 * MiB;
constexpr size_t WS_SLOT = WS_Y + 64 * MiB;
constexpr size_t SLOT_ARR = (size_t)NCLS * CLSCAP * 4;
constexpr size_t WS_PROJ = WS_SLOT + 4 * SLOT_ARR;
constexpr size_t WS_Q = WS_PROJ, WS_O = WS_PROJ + 64 * MiB, WS_HID = WS_PROJ + 128 * MiB;
constexpr size_t WS_QCV = WS_PROJ + (size_t)NTOK * NPROJ * 2;
constexpr size_t WS_KCV = WS_QCV + 32 * MiB, WS_DC = WS_KCV + 32 * MiB, WS_CPREV = WS_DC + 32 * MiB, WS_GBUF = WS_CPREV + 32 * MiB;
constexpr size_t WS_DN = WS_GBUF + 2 * MiB, WS_NPREV = WS_DN + 512 * 1024, WS_SCAL = WS_NPREV + 512 * 1024;
constexpr size_t WS_END = WS_SCAL + 64 * 1024;
constexpr size_t WS_WMKV2 = WS_W13 + 16 * MiB;
constexpr size_t WS_MEMB8 = WS_WMKV2 + 4 * MiB;
constexpr size_t WS_XQ8 = WS_QCV;
static_assert(WS_HID + (size_t)(128 + NCLS) * 256 * 1024 * 2 <= WS_END, "hidden overlay fits in proj");
constexpr int CW_TMO = 0, CW_CODE = 1, CW_BAR = 4096, CW_CNT = 8192, CW_Q = 8192 + 256;

constexpr int LDS_BYTES = 163840;
constexpr int RING_BYTES = 131072, SCR_OFF = RING_BYTES, LDSCTL_OFF = LDS_BYTES - 1024, MISC_OFF = LDSCTL_OFF + 320, PTAB_OFF = LDSCTL_OFF + 512;

#define RLX_AGENT __ATOMIC_RELAXED, __HIP_MEMORY_SCOPE_AGENT
typedef _Float16 f16x2 __attribute__((ext_vector_type(2)));
typedef _Float16 f16x8 __attribute__((ext_vector_type(8)));
__device__ __forceinline__ unsigned f2bf(float f) { return (unsigned)__builtin_bit_cast(unsigned short, (_Float16)f); }
__device__ __forceinline__ unsigned pk2(float lo, float hi) { const f32x2 v = {lo, hi}; return __builtin_bit_cast(unsigned, __builtin_convertvector(v, f16x2)); }
__device__ __forceinline__ float bf2f(unsigned short b) { return (float)__builtin_bit_cast(_Float16, b); }
__device__ __forceinline__ float bflo(unsigned w) { return (float)__builtin_bit_cast(_Float16, (unsigned short)(w & 0xffffu)); }
__device__ __forceinline__ float bfhi(unsigned w) { return (float)__builtin_bit_cast(_Float16, (unsigned short)(w >> 16)); }
#define DPPF(old_, src_, ctrl_, rm_) __builtin_bit_cast(float, __builtin_amdgcn_update_dpp(__builtin_bit_cast(int, (float)(old_)), __builtin_bit_cast(int, (float)(src_)), (ctrl_), (rm_), 0xF, false))
__device__ __forceinline__ float wave_sum(float v) {
    v += DPPF(0.f, v, 0xB1, 0xF); v += DPPF(0.f, v, 0x4E, 0xF); v += DPPF(0.f, v, 0x141, 0xF); v += DPPF(0.f, v, 0x140, 0xF);
    v += DPPF(0.f, v, 0x142, 0xA); v += DPPF(0.f, v, 0x143, 0xC);
    return __builtin_bit_cast(float, __builtin_amdgcn_readlane(__builtin_bit_cast(int, v), 63));
}
__device__ __forceinline__ float wave_max(float v) {
    v = fmaxf(v, DPPF(v, v, 0xB1, 0xF)); v = fmaxf(v, DPPF(v, v, 0x4E, 0xF)); v = fmaxf(v, DPPF(v, v, 0x141, 0xF)); v = fmaxf(v, DPPF(v, v, 0x140, 0xF));
    v = fmaxf(v, DPPF(v, v, 0x142, 0xA)); v = fmaxf(v, DPPF(v, v, 0x143, 0xC));
    return __builtin_bit_cast(float, __builtin_amdgcn_readlane(__builtin_bit_cast(int, v), 63));
}
__device__ __forceinline__ float xor16_sum(float x) { auto s = __builtin_amdgcn_permlane16_swap(__float_as_uint(x), __float_as_uint(x), false, false); return __uint_as_float(s[0]) + __uint_as_float(s[1]); }
__device__ __forceinline__ float xor32_sum(float x) { auto t = __builtin_amdgcn_permlane32_swap(__float_as_uint(x), __float_as_uint(x), false, false); return __uint_as_float(t[0]) + __uint_as_float(t[1]); }
__device__ __forceinline__ float bperm(int srclane, float v) { return __builtin_bit_cast(float, __builtin_amdgcn_ds_bpermute(srclane << 2, __builtin_bit_cast(int, v))); }
__device__ __forceinline__ float softplusf(float z) { return fmaxf(z, 0.f) + 0.6931471805599453f * __builtin_amdgcn_logf(1.0f + __builtin_amdgcn_exp2f(-1.4426950408889634f * fabsf(z))); }
__device__ __forceinline__ float siluf(float a) { return a * __builtin_amdgcn_rcpf(1.f + __builtin_amdgcn_exp2f(-1.4426950408889634f * a)); }
__device__ __forceinline__ float sigmf(float a) { return __builtin_amdgcn_rcpf(1.f + __builtin_amdgcn_exp2f(-1.4426950408889634f * a)); }

namespace pg8 {
constexpr int BM = 256, BK = 64, HALF = 128, HTB = HALF * BK * 2, STAGE_BYTES = 8 * HTB, NXCD = 8, WGM = 8;
__host__ __device__ __forceinline__ int lds_byte(int r, int c) { const int st = (r >> 4) * 2 + (c >> 5), rr = r & 15, cc = c & 31, ob = rr * 64 + cc * 2; return st * 1024 + (ob ^ (((ob >> 9) & 1) << 5)); }
__host__ __device__ __forceinline__ void stage_rc(int b, int& R, int& C) { const int st = b / 1024, sb = b % 1024, swz = sb ^ (((sb >> 9) & 1) << 5); R = (st >> 1) * 16 + swz / 64; C = (st & 1) * 32 + (swz % 64) / 2; }
__host__ __device__ __forceinline__ int perm32(int rho) { const int n = rho >> 4, i = rho & 15; return 8 * (i >> 2) + 4 * n + (i & 3); }

struct Unit { int pm, pn; const char* a; const char* b; const int* rows; int nvalid; int cls; int slot0; };

__device__ __forceinline__ unsigned cvt_pk_bf16(float lo, float hi) { return pk2(lo, hi); }
__device__ __forceinline__ int lane_fresh() { int l; asm volatile("v_mbcnt_lo_u32_b32 %0, -1, 0\n\tv_mbcnt_hi_u32_b32 %0, -1, %0" : "=v"(l)); return l; }
#ifndef FP8_FROM
#define FP8_FROM 0
#endif
#ifndef F8_MO
#define F8_MO 1
#endif
#ifndef F8_Q
#define F8_Q 1
#endif
static_assert(FP8_FROM == 0, "WS_WMKV2 lives in the half of WS_W13 that only the fp8 expert weights leave free");
constexpr float F8_WSCALE = 64.0f, F8_HSCALE = 16.0f;
__device__ __forceinline__ float f8clamp(float x) { return __builtin_amdgcn_fmed3f(x, -448.0f, 448.0f); }
__device__ __forceinline__ unsigned f8x4(float a, float b, float c, float d) { int v = __builtin_amdgcn_cvt_pk_fp8_f32(f8clamp(a), f8clamp(b), 0, false); v = __builtin_amdgcn_cvt_pk_fp8_f32(f8clamp(c), f8clamp(d), v, true); return (unsigned)v; }
__device__ __forceinline__ bool layer_f8(int l) { return FP8_FROM <= 0 ? true : (FP8_FROM >= DEPTH ? false : l >= FP8_FROM); }

__device__ __forceinline__ int xcd_remap(int L, int nwg) { const int q = nwg / NXCD, r = nwg % NXCD, xcd = L % NXCD, off = L / NXCD; return (xcd < r ? xcd * (q + 1) : r * (q + 1) + (xcd - r) * q) + off; }

struct SchedInKv {
    const char* A; const char* B; const char* A2; const char* B2; int G, c; size_t tstep; int ncol, nkv;
    __device__ __forceinline__ bool next(int i, Unit& u) const {
        const int nin = 128 * ncol;
        const long L = (long)i * G + c; if (L >= nin + nkv) return false;
        u.rows = nullptr; u.nvalid = 256; u.slot0 = 0;
        if (L < nin) { const int wgid = xcd_remap((int)L, nin); const int nig = WGM * ncol, gid = wgid / nig, fm = gid * WGM;
            u.pm = fm + ((wgid % nig) % WGM); u.pn = (wgid % nig) / WGM; u.a = A + (size_t)u.pm * tstep; u.b = B + (size_t)u.pn * tstep; u.cls = 0; }
        else { const int id = (int)L - nin; u.pm = id >> 3; u.pn = id & 7; u.a = A2 + (size_t)u.pm * tstep; u.b = B2 + (size_t)u.pn * tstep; u.cls = 1; }
        return true;
    }
};
struct SchedKv {
    const char* A2; const char* B2; int G, c; size_t tstep;
    __device__ __forceinline__ bool next(int i, Unit& u) const {
        const long L = (long)i * G + (G - 1 - c); if (L >= 128) return false;
        const int id = (int)L; u.pm = id >> 3; u.pn = id & 7; u.a = A2 + (size_t)u.pm * tstep; u.b = B2 + (size_t)u.pn * tstep; u.cls = 1; u.rows = nullptr; u.nvalid = 256; u.slot0 = 0; return true;
    }
};
struct SchedDense {
    const char* A; const char* B; int nM, nN, nwg, G, c; size_t tstep;
    __device__ void init(const void* A_, const void* B_, int M, int N, int K, int G_, int c_) { A = (const char*)A_; B = (const char*)B_; nM = M / BM; nN = N / BM; nwg = nM * nN; G = G_; c = c_; tstep = (size_t)BM * K * 2; }
    __device__ __forceinline__ bool next(int i, Unit& u) const {
        const long L = (long)i * G + c; if (L >= nwg) return false;
        const int wgid = xcd_remap((int)L, nwg);
        const int nig = WGM * nN, gid = wgid / nig, fm = gid * WGM, gsz = (nM - fm) < WGM ? (nM - fm) : WGM;
        u.pm = fm + ((wgid % nig) % gsz); u.pn = (wgid % nig) / gsz;
        u.a = A + (size_t)u.pm * tstep; u.b = B + (size_t)u.pn * tstep; u.rows = nullptr; u.nvalid = 256; u.cls = 0; u.slot0 = 0; return true;
    }
};

typedef int v8i_t __attribute__((ext_vector_type(8)));
typedef int i32x4_t __attribute__((ext_vector_type(4)));
template <class Epi, class Sched, bool GATHER, bool F8 = false>
__device__ __forceinline__ void gemm_phase(LAS unsigned char* lds, const int tid, const int K, const Sched& S, const Epi& E) {
    const int wid = __builtin_amdgcn_readfirstlane(tid >> 6), lane = tid & 63, wr = wid >> 2, wc = wid & 3, fr = lane & 15, fq = lane >> 4;
    const int nt = K / BK;
    unsigned voffB[2], va[2][2];
#pragma unroll
    for (int i = 0; i < 2; ++i) { int R, C; stage_rc(tid * 16 + i * 8192, R, C); const int Rb = Epi::PERM ? ((R & ~31) + perm32(R & 31)) : R;
        voffB[i] = (unsigned)(Rb * K + C) * 2u; va[0][i] = (unsigned)(R * K + C) * 2u; va[1][i] = (unsigned)((R + HALF) * K + C) * 2u; }
    const size_t kstep = (size_t)(BK * 2);
    const size_t hstep = (size_t)HALF * K * 2;
    const unsigned ldsw = (unsigned)wid * 1024u;
    const int aoff = lds_byte(wr * 64 + fr, fq * 8), boff = lds_byte(wc * 32 + fr, fq * 8);
#define PG8_SA(b, h) (((b) * 2 + (h)) * HTB)
#define PG8_SB(b, h) ((4 + (b) * 2 + (h)) * HTB)
#define PG8_STAGEB(bufoff, gbase) do { if constexpr (F8) { const __amdgpu_buffer_rsrc_t _r = __builtin_amdgcn_make_buffer_rsrc((void*)(gbase), 0, 0x7fffffff, 0x00020000); _Pragma("unroll") for (int _i = 0; _i < 2; ++_i) \
        __builtin_amdgcn_raw_ptr_buffer_load_lds(_r, (LAS void*)(lds + (bufoff) + ldsw + _i * 8192), 16, (int)voffB[_i], 0, 0, 0); } else { _Pragma("unroll") for (int _i = 0; _i < 2; ++_i) \
        __builtin_amdgcn_global_load_lds((const unsigned*)((const char*)(gbase) + voffB[_i]), (LAS unsigned*)(lds + (bufoff) + ldsw + _i * 8192), 16, 0, 0); } } while (0)
#define PG8_STAGEA(bufoff, gbase, h) do { if constexpr (F8) { const __amdgpu_buffer_rsrc_t _r = __builtin_amdgcn_make_buffer_rsrc((void*)(gbase), 0, 0x7fffffff, 0x00020000); _Pragma("unroll") for (int _i = 0; _i < 2; ++_i) \
        __builtin_amdgcn_raw_ptr_buffer_load_lds(_r, (LAS void*)(lds + (bufoff) + ldsw + _i * 8192), 16, (int)va[h][_i], 0, 0, 0); } else { _Pragma("unroll") for (int _i = 0; _i < 2; ++_i) \
        __builtin_amdgcn_global_load_lds((const unsigned*)((const char*)(gbase) + va[h][_i]), (LAS unsigned*)(lds + (bufoff) + ldsw + _i * 8192), 16, 0, 0); } } while (0)
#define PG8_LDA(dst, b, h) do { _Pragma("unroll") for (int m = 0; m < 4; ++m) _Pragma("unroll") for (int k = 0; k < 2; ++k) dst[m][k] = *(const LAS bf16x8*)(lds + PG8_SA(b, h) + aoff + m * 2048 + k * 1024); } while (0)
#define PG8_LDB(dst, b, h) do { _Pragma("unroll") for (int n = 0; n < 2; ++n) _Pragma("unroll") for (int k = 0; k < 2; ++k) dst[n][k] = *(const LAS bf16x8*)(lds + PG8_SB(b, h) + boff + n * 2048 + k * 1024); } while (0)
#define PG8_MMA(ai, bj, At, Bt) do { __builtin_amdgcn_s_setprio(1); _Pragma("unroll") for (int m = 0; m < 4; ++m) _Pragma("unroll") for (int n = 0; n < 2; ++n) { \
        if constexpr (F8) { const v8i_t fb = __builtin_shufflevector(__builtin_bit_cast(i32x4_t, Bt[n][0]), __builtin_bit_cast(i32x4_t, Bt[n][1]), 0, 1, 2, 3, 4, 5, 6, 7), fa = __builtin_shufflevector(__builtin_bit_cast(i32x4_t, At[m][0]), __builtin_bit_cast(i32x4_t, At[m][1]), 0, 1, 2, 3, 4, 5, 6, 7); \
            acc[ai][bj][m][n] = __builtin_amdgcn_mfma_scale_f32_16x16x128_f8f6f4(fb, fa, acc[ai][bj][m][n], 0, 0, 0, 0x7f7f7f7f, 0, 0x7f7f7f7f); } \
        else { _Pragma("unroll") for (int k = 0; k < 2; ++k) acc[ai][bj][m][n] = __builtin_amdgcn_mfma_f32_16x16x32_f16(__builtin_bit_cast(f16x8, Bt[n][k]), __builtin_bit_cast(f16x8, At[m][k]), acc[ai][bj][m][n], 0, 0, 0); } } \
        __builtin_amdgcn_s_setprio(0); } while (0)
#define PG8_LDA8(dst, b, h, m0) do { _Pragma("unroll") for (int m = 0; m < 2; ++m) _Pragma("unroll") for (int k = 0; k < 2; ++k) dst[m][k] = *(const LAS bf16x8*)(lds + PG8_SA(b, h) + aoff + ((m0) + m) * 2048 + k * 1024); } while (0)
#define PG8_MMA8(ai, mm, Am, B0_, B1_) do { _Pragma("unroll") for (int bj = 0; bj < 2; ++bj) _Pragma("unroll") for (int n = 0; n < 2; ++n) { \
        const v8i_t fb = bj ? __builtin_shufflevector(__builtin_bit_cast(i32x4_t, B1_[n][0]), __builtin_bit_cast(i32x4_t, B1_[n][1]), 0, 1, 2, 3, 4, 5, 6, 7) : __builtin_shufflevector(__builtin_bit_cast(i32x4_t, B0_[n][0]), __builtin_bit_cast(i32x4_t, B0_[n][1]), 0, 1, 2, 3, 4, 5, 6, 7); \
        const v8i_t fa = __builtin_shufflevector(__builtin_bit_cast(i32x4_t, Am[0]), __builtin_bit_cast(i32x4_t, Am[1]), 0, 1, 2, 3, 4, 5, 6, 7); \
        acc[ai][bj][mm][n] = __builtin_amdgcn_mfma_scale_f32_16x16x128_f8f6f4(fb, fa, acc[ai][bj][mm][n], 0, 0, 0, 0x7f7f7f7f, 0, 0x7f7f7f7f); } } while (0)
#define PG8_PHASE8(ai, b, h) do { PG8_WAIT_L(0); PG8_BAR; __builtin_amdgcn_s_setprio(1); PG8_MMA8(ai, 0, At[0], B0, B1); PG8_SCHED; { _Pragma("unroll") for (int k = 0; k < 2; ++k) At[0][k] = *(const LAS bf16x8*)(lds + PG8_SA(b, h) + aoff + 2 * 2048 + k * 1024); } PG8_SCHED; \
        PG8_MMA8(ai, 1, At[1], B0, B1); PG8_SCHED; { _Pragma("unroll") for (int k = 0; k < 2; ++k) At[1][k] = *(const LAS bf16x8*)(lds + PG8_SA(b, h) + aoff + 3 * 2048 + k * 1024); } PG8_SCHED; \
        PG8_MMA8(ai, 2, At[0], B0, B1); PG8_MMA8(ai, 3, At[1], B0, B1); __builtin_amdgcn_s_setprio(0); PG8_WAIT_L(0); PG8_BAR; PG8_SCHED; } while (0)
#define PG8_WAIT_V(n) asm volatile("s_waitcnt vmcnt(" #n ")" ::: "memory")
#define PG8_WAIT_L(n) asm volatile("s_waitcnt lgkmcnt(" #n ")" ::: "memory")
#define PG8_BAR __builtin_amdgcn_s_barrier()
#define PG8_SCHED __builtin_amdgcn_sched_barrier(0)
#define PG8_LOADVA(u, dst) do { int _t = tid; asm volatile("" : "+v"(_t)); _Pragma("unroll") for (int _i = 0; _i < 2; ++_i) { int _R, _C; stage_rc(_t * 16 + _i * 8192, _R, _C); \
        _Pragma("unroll") for (int _h = 0; _h < 2; ++_h) { const int _s = _h * HALF + _R; \
        const int _r = (_s < (u).nvalid) ? (u).rows[_s] : 0; dst[_h][_i] = (unsigned)(_r * K + _C) * 2u; } } } while (0)
    Unit cur, nxt; int ui = 0;
    if (!S.next(0, cur)) return;
    f32x4 acc[2][2][4][2];
#pragma unroll
    for (int a = 0; a < 2; ++a)
#pragma unroll
        for (int b = 0; b < 2; ++b)
#pragma unroll
            for (int m = 0; m < 4; ++m)
#pragma unroll
                for (int n = 0; n < 2; ++n) acc[a][b][m][n] = (f32x4){0.f, 0.f, 0.f, 0.f};
    bf16x8 At[F8 ? 2 : 4][2], B0[2][2], B1[2][2];
    const char* cA = cur.a; const char* cB = cur.b;
    if constexpr (GATHER) { PG8_LOADVA(cur, va); }
    PG8_STAGEB(PG8_SB(0, 0), cB); PG8_STAGEB(PG8_SB(0, 1), cB + hstep); PG8_STAGEA(PG8_SA(0, 0), cA, 0); PG8_STAGEA(PG8_SA(0, 1), cA, 1);
    if (wr == 1) PG8_BAR;
    PG8_WAIT_V(2); PG8_BAR;
    PG8_STAGEB(PG8_SB(1, 0), cB + kstep); PG8_STAGEA(PG8_SA(1, 0), cA + kstep, 0); PG8_STAGEB(PG8_SB(1, 1), cB + hstep + kstep);
    PG8_WAIT_V(6); PG8_BAR;
    for (;;) {
        const bool has_next = S.next(ui + 1, nxt);
        const char* nA = has_next ? nxt.a : cA; const char* nB = has_next ? nxt.b : cB;
#pragma unroll 1
        for (int t = 0; t < nt; t += 2) {
            const bool last = (t == nt - 2);
            const char* a1 = cA + (size_t)(t + 1) * kstep;
            const char* a2 = last ? nA : cA + (size_t)(t + 2) * kstep; const char* b2 = last ? nB : cB + (size_t)(t + 2) * kstep;
            const char* a3 = a2 + kstep; const char* b3 = b2 + kstep;
            if constexpr (F8) {
            PG8_LDB(B0, 0, 0); PG8_LDB(B1, 0, 1); PG8_SCHED; PG8_LDA8(At, 0, 0, 0); PG8_STAGEA(PG8_SA(1, 1), a1, 1);
            if constexpr (GATHER) { if (last && has_next) { PG8_LOADVA(nxt, va); } }
            PG8_WAIT_V(8); PG8_PHASE8(0, 0, 0);
            PG8_LDA8(At, 0, 1, 0); PG8_STAGEB(PG8_SB(0, 0), b2); PG8_STAGEB(PG8_SB(0, 1), b2 + hstep); PG8_STAGEA(PG8_SA(0, 0), a2, 0);
            PG8_WAIT_V(8); PG8_PHASE8(1, 0, 1);
            PG8_LDB(B0, 1, 0); PG8_LDB(B1, 1, 1); PG8_SCHED; PG8_LDA8(At, 1, 0, 0); PG8_STAGEA(PG8_SA(0, 1), a2, 1);
            PG8_WAIT_V(8); PG8_PHASE8(0, 1, 0);
            PG8_LDA8(At, 1, 1, 0); PG8_STAGEB(PG8_SB(1, 0), b3); PG8_STAGEB(PG8_SB(1, 1), b3 + hstep); PG8_STAGEA(PG8_SA(1, 0), a3, 0);
            PG8_WAIT_V(8); PG8_PHASE8(1, 1, 1);
            } else {
            PG8_LDB(B0, 0, 0); PG8_LDB(B1, 0, 1); PG8_SCHED; PG8_LDA(At, 0, 0); PG8_STAGEA(PG8_SA(1, 1), a1, 1);
            if constexpr (GATHER) { if (last && has_next) { PG8_LOADVA(nxt, va); } }
            PG8_WAIT_V(8); PG8_WAIT_L(0); PG8_BAR; PG8_MMA(0, 0, At, B0); PG8_MMA(0, 1, At, B1); PG8_BAR; PG8_SCHED;
            PG8_LDA(At, 0, 1); PG8_STAGEB(PG8_SB(0, 0), b2); PG8_STAGEB(PG8_SB(0, 1), b2 + hstep); PG8_STAGEA(PG8_SA(0, 0), a2, 0);
            PG8_WAIT_V(8); PG8_WAIT_L(0); PG8_BAR; PG8_MMA(1, 0, At, B0); PG8_MMA(1, 1, At, B1); PG8_BAR; PG8_SCHED;
            PG8_LDB(B0, 1, 0); PG8_LDB(B1, 1, 1); PG8_SCHED; PG8_LDA(At, 1, 0); PG8_STAGEA(PG8_SA(0, 1), a2, 1);
            PG8_WAIT_V(8); PG8_WAIT_L(0); PG8_BAR; PG8_MMA(0, 0, At, B0); PG8_MMA(0, 1, At, B1); PG8_BAR; PG8_SCHED;
            PG8_LDA(At, 1, 1); PG8_STAGEB(PG8_SB(1, 0), b3); PG8_STAGEB(PG8_SB(1, 1), b3 + hstep); PG8_STAGEA(PG8_SA(1, 0), a3, 0);
            PG8_WAIT_V(8); PG8_WAIT_L(0); PG8_BAR; PG8_MMA(1, 0, At, B0); PG8_MMA(1, 1, At, B1); PG8_BAR; PG8_SCHED;
            }
        }
        if (wr == 0) PG8_BAR;
        { Unit ce = cur; ce.pm = __builtin_amdgcn_readfirstlane(cur.pm); ce.pn = __builtin_amdgcn_readfirstlane(cur.pn); ce.cls = __builtin_amdgcn_readfirstlane(cur.cls); ce.slot0 = __builtin_amdgcn_readfirstlane(cur.slot0); ce.nvalid = __builtin_amdgcn_readfirstlane(cur.nvalid);
          asm volatile("" : "+s"(ce.pm), "+s"(ce.pn), "+s"(ce.cls), "+s"(ce.slot0), "+s"(ce.nvalid));
          E(acc, ce, wr, wc, fr, fq); }
        if (!has_next) break;
#pragma unroll
        for (int a = 0; a < 2; ++a)
#pragma unroll
            for (int b = 0; b < 2; ++b)
#pragma unroll
                for (int m = 0; m < 4; ++m)
#pragma unroll
                    for (int n = 0; n < 2; ++n) acc[a][b][m][n] = (f32x4){0.f, 0.f, 0.f, 0.f};
        cur = nxt; cA = nA; cB = nB; ++ui;
        if (wr == 1) PG8_BAR;
    }
    PG8_WAIT_V(0);
    PG8_BAR;
#undef PG8_SA
#undef PG8_SB
#undef PG8_STAGEA
#undef PG8_STAGEB
#undef PG8_LDA
#undef PG8_LDB
#undef PG8_MMA
#undef PG8_WAIT_V
#undef PG8_LDA8
#undef PG8_MMA8
#undef PG8_PHASE8
#undef PG8_WAIT_L
#undef PG8_BAR
#undef PG8_SCHED
#undef PG8_LOADVA
}

__device__ __forceinline__ float rstd_from_ssq(const float* ssq, int row) {
    const f32x4* p = (const f32x4*)(ssq + (size_t)row * 16); const f32x4 a = p[0], b = p[1], c = p[2], d = p[3];
    const float s = ((a[0] + a[1]) + (a[2] + a[3])) + ((b[0] + b[1]) + (b[2] + b[3])) + ((c[0] + c[1]) + (c[2] + c[3])) + ((d[0] + d[1]) + (d[2] + d[3]));
    return rsqrtf(s * (1.0f / D) + EPS);
}
struct EpiScaleBf16 {
    static constexpr bool PERM = true;
    bf16* O; int ldc; const float* ssq; const float* rtab; float* gates; int gate_pn; bf16* O2; int ldc2; const float* rtab2;
    float osc = 1.0f;
    __device__ __forceinline__ void operator()(const f32x4 (&acc)[2][2][4][2], const Unit& u, int wr, int wc, int fr, int fq) const {
        { const int ln_ = lane_fresh(); fr = ln_ & 15; fq = ln_ >> 4; }
        const int row0 = u.pm * BM + wr * 64 + fr; const int col0 = u.pn * BM + wc * 32 + 8 * fq;
        if (u.cls == 1) {
#pragma unroll
            for (int ai = 0; ai < 2; ++ai)
#pragma unroll
                for (int m = 0; m < 4; ++m) { const int row = row0 + ai * HALF + m * 16; const float rs = rtab2[row] * osc; bf16* rowp = O2 + (size_t)row * ldc2 + col0;
#pragma unroll
                    for (int bj = 0; bj < 2; ++bj) { const f32x4 v0 = acc[ai][bj][m][0] * rs, v1 = acc[ai][bj][m][1] * rs; u32x4 w; w.x = cvt_pk_bf16(v0[0], v0[1]); w.y = cvt_pk_bf16(v0[2], v0[3]); w.z = cvt_pk_bf16(v1[0], v1[1]); w.w = cvt_pk_bf16(v1[2], v1[3]);
                        *(u32x4*)(rowp + bj * HALF) = w; } }
            return; }
#pragma unroll
        for (int ai = 0; ai < 2; ++ai)
#pragma unroll
            for (int m = 0; m < 4; ++m) { const int row = row0 + ai * HALF + m * 16; const float rs = (rtab ? rtab[row] : rstd_from_ssq(ssq, row)) * osc;
                if (u.pn < gate_pn) { bf16* rowp = O + (size_t)row * ldc + col0;
#pragma unroll
                    for (int bj = 0; bj < 2; ++bj) { const f32x4 v0 = acc[ai][bj][m][0] * rs, v1 = acc[ai][bj][m][1] * rs; u32x4 w; w.x = cvt_pk_bf16(v0[0], v0[1]); w.y = cvt_pk_bf16(v0[2], v0[3]); w.z = cvt_pk_bf16(v1[0], v1[1]); w.w = cvt_pk_bf16(v1[2], v1[3]);
                        *(u32x4*)(rowp + bj * HALF) = w; } }
                else if (wc == 0 && fq == 0) { *(f32x4*)(gates + (size_t)row * 8) = acc[ai][0][m][0] * rs; *(f32x4*)(gates + (size_t)row * 8 + 4) = acc[ai][0][m][1] * rs; } }
    }
};
template <bool SCATTER, bool F8 = false> struct EpiRes {
    static constexpr bool PERM = true;
    bf16* xb; float* ssq; int probe; unsigned char* x8 = nullptr;
    __device__ __forceinline__ void operator()(const f32x4 (&acc)[2][2][4][2], const Unit& u, int wr, int wc, int fr, int fq) const {
        { const int ln_ = lane_fresh(); fr = ln_ & 15; fq = ln_ >> 4; }
        const int col0 = u.pn * BM + wc * 32 + 8 * fq;
#pragma unroll
        for (int ai = 0; ai < 2; ++ai)
#pragma unroll
            for (int m = 0; m < 4; ++m) { const int lr = wr * 64 + fr + ai * HALF + m * 16; int row; bool ok = true;
                if constexpr (SCATTER) { ok = lr < u.nvalid; row = ok ? u.rows[lr] : 0; } else row = u.pm * BM + lr;
                float ss = 0.f; bf16* rowp = xb + (size_t)row * D + col0;
#pragma unroll
                for (int bj = 0; bj < 2; ++bj) { const u32x4 v = *(const u32x4*)(rowp + bj * HALF); constexpr float ASC = F8 ? 1.0f / (F8_WSCALE * F8_HSCALE) : 1.0f; const f32x4 a0 = acc[ai][bj][m][0] * ASC, a1 = acc[ai][bj][m][1] * ASC;
                    float o[8] = {bflo(v.x), bfhi(v.x), bflo(v.y), bfhi(v.y), bflo(v.z), bfhi(v.z), bflo(v.w), bfhi(v.w)};
                    if (!probe) { o[0] += a0[0]; o[1] += a0[1]; o[2] += a0[2]; o[3] += a0[3]; o[4] += a1[0]; o[5] += a1[1]; o[6] += a1[2]; o[7] += a1[3]; }
                    ss += (o[0] * o[0] + o[1] * o[1]) + (o[2] * o[2] + o[3] * o[3]) + (o[4] * o[4] + o[5] * o[5]) + (o[6] * o[6] + o[7] * o[7]);
                    u32x4 w; w.x = cvt_pk_bf16(o[0], o[1]); w.y = cvt_pk_bf16(o[2], o[3]); w.z = cvt_pk_bf16(o[4], o[5]); w.w = cvt_pk_bf16(o[6], o[7]);
                    if (ok) *(u32x4*)(rowp + bj * HALF) = w;
                    if constexpr (!SCATTER) { if (x8) { u32x2 w8; w8.x = f8x4(o[0], o[1], o[2], o[3]); w8.y = f8x4(o[4], o[5], o[6], o[7]); *(u32x2*)(x8 + (size_t)row * D + col0 + bj * HALF) = w8; } } }
                ss = xor16_sum(ss); ss = xor32_sum(ss);
                if (fq == 0 && ok) ssq[(size_t)row * 16 + u.pn * 4 + wc] = ss; }
    }
};
template <bool F8 = false> struct EpiMoe1 {
    static constexpr bool PERM = true;
    bf16* hid; const float* rs; const float* gwa; const float* gwb;
    __device__ __forceinline__ void operator()(const f32x4 (&acc)[2][2][4][2], const Unit& u, int wr, int wc, int fr, int fq) const {
        { const int ln_ = lane_fresh(); fr = ln_ & 15; fq = ln_ >> 4; }
        const float* gw = (u.pn < 4 ? gwa : gwb) + (size_t)u.cls * CLSCAP + u.slot0; const float* rsp = rs + (size_t)u.cls * CLSCAP + u.slot0;
        const int col0 = (u.pn >> 2) * 512 + (u.pn & 3) * 128 + wc * 32 + 8 * fq;
#pragma unroll
        for (int ai = 0; ai < 2; ++ai)
#pragma unroll
            for (int m = 0; m < 4; ++m) { const int lr = wr * 64 + fr + ai * HALF + m * 16; const float r = rsp[lr] * (F8 ? 1.0f / F8_WSCALE : 1.0f), ru = F8 ? r * F8_HSCALE : r, g = gw[lr]; float h[8];
#pragma unroll
                for (int n = 0; n < 2; ++n)
#pragma unroll
                    for (int j = 0; j < 4; ++j) { const float a = acc[ai][0][m][n][j] * r, uu = acc[ai][1][m][n][j] * ru; h[n * 4 + j] = siluf(a) * uu * g; }
                u32x4 w; w.x = cvt_pk_bf16(h[0], h[1]); w.y = cvt_pk_bf16(h[2], h[3]); w.z = cvt_pk_bf16(h[4], h[5]); w.w = cvt_pk_bf16(h[6], h[7]);
                if constexpr (F8) { u32x2 w8; w8.x = f8x4(h[0], h[1], h[2], h[3]); w8.y = f8x4(h[4], h[5], h[6], h[7]); *(u32x2*)((unsigned char*)hid + ((size_t)u.pm * BM + lr) * 1024 + col0) = w8; }
                else *(u32x4*)(hid + ((size_t)u.pm * BM + lr) * 1024 + col0) = w; }
    }
};
}
using pg8::f8x4; using pg8::layer_f8; using pg8::F8_WSCALE; using pg8::F8_HSCALE;

#define XB_TMO      128
#define XB_XCNT(j)  (256  + 64 * (j))
#define XB_XSUB(j)  (1280 + 64 * (j))
#define XB_XGEN(j)  (2304 + 64 * (j))
#define XB_TOP      3328
#define XB_TOPGEN   3392
#define XCD_BAR_WORDS 3456
#define XB_SPIN_CAP (1u << 20)
__device__ __forceinline__ unsigned xb_ld(unsigned* p)              { return __hip_atomic_load(p, __ATOMIC_RELAXED, __HIP_MEMORY_SCOPE_AGENT); }
__device__ __forceinline__ unsigned xb_add(unsigned* p, unsigned v) { return __hip_atomic_fetch_add(p, v, __ATOMIC_RELAXED, __HIP_MEMORY_SCOPE_AGENT); }
__device__ __forceinline__ unsigned xb_xcc_id() { return (unsigned)__builtin_amdgcn_s_getreg((3 << 11) | 20) & 0xFu; }
#define XB_SPIN(cond, bar) do { unsigned _sp = 0; while (cond) { __builtin_amdgcn_s_sleep(1); \
    if ((++_sp & 255u) == 0u) { if (xb_ld(&(bar)[XB_TMO])) break; if (_sp > XB_SPIN_CAP) { atomicAdd(&(bar)[XB_TMO], 1u); break; } } } } while (0)
struct XcdBarrier { unsigned* bar; unsigned x; volatile LAS unsigned* st; };
__device__ __forceinline__ XcdBarrier xcd_barrier_post(unsigned* bar, volatile LAS unsigned* st) {
    XcdBarrier b; b.bar = bar; b.x = xb_xcc_id(); b.st = st;
    if (threadIdx.x == 0) (void)xb_add(&bar[XB_XCNT(b.x)], 1u);
    return b;
}
__device__ __forceinline__ void xcd_barrier_complete(unsigned* bar, unsigned x, unsigned& nloc, unsigned& nx) {
    const unsigned G = gridDim.x * gridDim.y * gridDim.z;
    unsigned sum, cnt, mine, sp = 0u;
    for (;;) {
        sum = 0u; cnt = 0u; mine = 0u;
#pragma unroll 1
        for (unsigned j = 0; j < 16; ++j) { const unsigned c = xb_ld(&bar[XB_XCNT(j)]); sum += c; cnt += (c > 0u) ? 1u : 0u; mine = (j == x) ? c : mine; }
        if (sum == G) break;
        __builtin_amdgcn_s_sleep(1);
        if ((++sp & 255u) == 0u) { if (xb_ld(&bar[XB_TMO])) break; if (sp > XB_SPIN_CAP) { atomicAdd(&bar[XB_TMO], 1u); break; } }
    }
    nloc = mine > 0u ? mine : 1u; nx = cnt > 0u ? cnt : 1u;
}
__device__ __forceinline__ void xcd_barrier(const XcdBarrier& b) {
    asm volatile("s_waitcnt vmcnt(0)" ::: "memory");
    __syncthreads();
    if (threadIdx.x == 0) {
        unsigned* bar = b.bar; asm volatile("" : "+s"(bar));
        __builtin_amdgcn_s_waitcnt(0);
        unsigned nloc = b.st[0], nx = b.st[1];
        if (nloc == 0u) { xcd_barrier_complete(bar, b.x, nloc, nx); b.st[0] = nloc; b.st[1] = nx; }
        const unsigned old = xb_add(&bar[XB_XSUB(b.x)], 1u);
        const unsigned gen = old / nloc;
        if (old + 1u == (gen + 1u) * nloc) {
            __builtin_amdgcn_fence(__ATOMIC_RELEASE, "agent");
            asm volatile("s_waitcnt vmcnt(0)" ::: "memory");
            const unsigned og = xb_add(&bar[XB_TOP], 1u);
            const unsigned tg = og / nx;
            __builtin_amdgcn_fence(__ATOMIC_ACQUIRE, "agent");
            if (og + 1u != (tg + 1u) * nx) XB_SPIN(xb_ld(&bar[XB_TOP]) < (tg + 1u) * nx, bar);
            xb_add(&bar[XB_XGEN(b.x)], 1u);
            asm volatile("s_waitcnt vmcnt(0)" ::: "memory");
        } else {
            __builtin_amdgcn_fence(__ATOMIC_ACQUIRE, "agent");
            XB_SPIN(xb_ld(&bar[XB_XGEN(b.x)]) == gen, bar);
            asm volatile("s_waitcnt vmcnt(0)" ::: "memory");
        }
    }
    __syncthreads();
}

struct Args { const float* in[26]; float* out; unsigned char* ws; int ph_lo, ph_hi, mode, pad; };
struct Frame {
    LAS unsigned char* lds; volatile LAS unsigned* MISC; unsigned* ctl; unsigned char* ws;
    int tid, lane, wave, G, bx;
    float* out;
    __device__ __forceinline__ const float* in_(int i) const { const LAS unsigned* t = (const LAS unsigned*)(lds + PTAB_OFF); const unsigned lo = __builtin_amdgcn_readfirstlane(t[2 * i]), hi = __builtin_amdgcn_readfirstlane(t[2 * i + 1]); return (const float*)(const GAS float*)(((unsigned long long)hi << 32) | lo); }
};
#define LDS_WAIT() asm volatile("s_waitcnt lgkmcnt(0)" ::: "memory")

__device__ __forceinline__ void tr_item(const float* W, int ldw, int k0, int n0, int ncols, const float* g, float cs, bf16* dst0, bf16* dst1, bf16* dst2, int ldd, LAS float* scr, int lane) {
    const int nl = lane & 31;
#pragma unroll 8
    for (int i = 0; i < 32; ++i) { const int kk = 2 * i + (lane >> 5); float v = 0.f; if (nl < ncols) v = W[(size_t)(k0 + kk) * ldw + n0 + nl] * (g ? g[k0 + kk] * cs : cs); scr[kk * 33 + nl] = v; }
    LDS_WAIT(); asm volatile("" ::: "memory");
    const int c = lane & 7;
#pragma unroll
    for (int j = 0; j < 4; ++j) { const int n = (lane >> 3) + 8 * j; const LAS float* s = scr + (8 * c) * 33 + n;
        u32x4 o; o.x = pk2(s[0 * 33], s[1 * 33]); o.y = pk2(s[2 * 33], s[3 * 33]); o.z = pk2(s[4 * 33], s[5 * 33]); o.w = pk2(s[6 * 33], s[7 * 33]);
        if (n < ncols) { *(u32x4*)(dst0 + (size_t)n * ldd + 8 * c) = o; if (dst1) *(u32x4*)(dst1 + (size_t)n * ldd + 8 * c) = o; if (dst2) *(u32x4*)(dst2 + (size_t)n * ldd + 8 * c) = o; } }
    LDS_WAIT(); asm volatile("" ::: "memory");
}
__device__ __forceinline__ void tr_item64(const float* W, int ldw, int k0, int n0, const float* g, float cs, bf16* dst0, bf16* dst1, bf16* dst2, int ldd, LAS float* scr, int lane) {
    const int r4 = lane >> 4, c4 = (lane & 15) * 4;
#pragma unroll 4
    for (int i = 0; i < 16; ++i) { const int kk = 4 * i + r4; f32x4 v = __builtin_nontemporal_load((const f32x4*)(W + (size_t)(k0 + kk) * ldw + n0 + c4));   const float sc = g ? g[k0 + kk] * cs : cs; v = v * sc; *(LAS f32x4*)(scr + kk * 68 + c4) = v; }
    LDS_WAIT(); asm volatile("" ::: "memory");
    const int c = lane & 7;
#pragma unroll
    for (int j = 0; j < 8; ++j) { const int n = (lane >> 3) + 8 * j; const LAS float* s_ = scr + (8 * c) * 68 + n;
        u32x4 o; o.x = pk2(s_[0 * 68], s_[1 * 68]); o.y = pk2(s_[2 * 68], s_[3 * 68]); o.z = pk2(s_[4 * 68], s_[5 * 68]); o.w = pk2(s_[6 * 68], s_[7 * 68]);
        *(u32x4*)(dst0 + (size_t)n * ldd + 8 * c) = o; if (dst1) *(u32x4*)(dst1 + (size_t)n * ldd + 8 * c) = o; if (dst2) *(u32x4*)(dst2 + (size_t)n * ldd + 8 * c) = o; }
    LDS_WAIT(); asm volatile("" ::: "memory");
}
__device__ __forceinline__ void tr_item64_f8(const float* W, int ldw, int k0, int n0, const float* g, float cs, unsigned char* dst0, unsigned char* dst1, unsigned char* dst2, int ldd, LAS float* scr, int lane) {
    const int r4 = lane >> 4, c4 = (lane & 15) * 4;
#pragma unroll 4
    for (int i = 0; i < 16; ++i) { const int kk = 4 * i + r4; f32x4 v = __builtin_nontemporal_load((const f32x4*)(W + (size_t)(k0 + kk) * ldw + n0 + c4)); const float sc = g ? g[k0 + kk] * cs : cs; v = v * sc; *(LAS f32x4*)(scr + kk * 68 + c4) = v; }
    LDS_WAIT(); asm volatile("" ::: "memory");
    const int c = lane & 7;
#pragma unroll
    for (int j = 0; j < 8; ++j) { const int n = (lane >> 3) + 8 * j; const LAS float* s_ = scr + (8 * c) * 68 + n;
        u32x2 o; o.x = f8x4(s_[0 * 68], s_[1 * 68], s_[2 * 68], s_[3 * 68]); o.y = f8x4(s_[4 * 68], s_[5 * 68], s_[6 * 68], s_[7 * 68]);
        *(u32x2*)(dst0 + (size_t)n * ldd + 8 * c) = o; if (dst1) *(u32x2*)(dst1 + (size_t)n * ldd + 8 * c) = o; if (dst2) *(u32x2*)(dst2 + (size_t)n * ldd + 8 * c) = o; }
    LDS_WAIT(); asm volatile("" ::: "memory");
}
__device__ __forceinline__ int pair_index(int a, int b) { return a == 0 ? (b - 1) : (a == 1 ? (b + 1) : 5); }

__device__ __forceinline__ void phase_convert(Frame& F, int l) {
    LAS float* scr = (LAS float*)(F.lds + F.wave * (64 * 68 * 4));
    const int gw = F.bx * NWAVES + F.wave, NGW = F.G * NWAVES, lane = F.lane;
    unsigned char* ws = F.ws;
    bf16* Win = (bf16*)(ws + WS_WIN); bf16* Wout = (bf16*)(ws + WS_WOUT); bf16* Wmq = (bf16*)(ws + WS_WMQ); bf16* Wmkv = (bf16*)(ws + WS_WMKV); bf16* Wmo = (bf16*)(ws + WS_WMO);
    bf16* W13 = (bf16*)(ws + WS_W13); bf16* W2c = (bf16*)(ws + WS_W2C);
    const float* w_in = F.in_(3) + (size_t)l * D * DIN; const float* ln_mix = F.in_(2) + l * D;
    const float* w_out = F.in_(10) + (size_t)l * D * D;
    const float* ln_mem = F.in_(11) + l * D; const float* ln_memkv = F.in_(12) + l * D;
    const float* w_mq = F.in_(13) + (size_t)l * D * D; const float* w_mk = F.in_(14) + (size_t)l * D * D; const float* w_mv = F.in_(15) + (size_t)l * D * D; const float* w_mo = F.in_(16) + (size_t)l * D * D;
    const float* ln_ffn = F.in_(17) + l * D;
    const float* w_e1 = F.in_(22) + (size_t)l * 16 * D * DEXP; const float* w_e3 = F.in_(23) + (size_t)l * 16 * D * DEXP; const float* w_e2 = F.in_(24) + (size_t)l * 16 * DEXP * D;
    constexpr int I_SEG = 128;
    constexpr int I_IN = 7 * I_SEG, I_GATE = 16, I_SQ = 256, I_E13 = 32 * I_SEG, I_E2 = 16 * 128;
    const int kvp = (l == 0) ? 2 : (l + 1 < DEPTH ? 1 : 0); const int I_SQS = (3 + 2 * kvp) * I_SQ;
    const int NITEMS = I_IN + I_GATE + I_SQS + I_E13 + I_E2;
    for (int it = gw; it < NITEMS; it += NGW) {
        int r = it;
        if (r < I_IN) { const int seg = r / I_SEG, q = r % I_SEG, kb = q / 8, nb = q % 8;
            const int srcc = seg < 4 ? seg * 512 : 2056 + (seg - 4) * 512; const int dstr = seg * 512; const float cs = (seg == 4) ? (0.08838834764831845f * 1.4426950408889634f) : 1.0f;
            tr_item64(w_in, DIN, kb * 64, srcc + nb * 64, ln_mix, cs, Win + (size_t)(dstr + nb * 64) * D + kb * 64, nullptr, nullptr, D, scr, lane); continue; }
        r -= I_IN;
        if (r < I_GATE) { tr_item(w_in, DIN, r * 64, 2048, 8, ln_mix, 1.0f, Win + (size_t)NPROJ * D + r * 64, nullptr, nullptr, D, scr, lane); continue; }
        r -= I_GATE;
        if (r < I_SQS) { const int m5 = r / I_SQ, q = r % I_SQ, kb = q / 16, nb = q % 16;
            const int mat = m5 < 3 ? (m5 == 2 ? 4 : m5) : 2 + ((m5 - 3) & 1);
            const int lk = m5 < 3 ? l : ((l == 0) ? ((m5 - 3) >> 1) : l + 1);
            const float* W = mat == 0 ? w_out : mat == 1 ? w_mq : mat == 2 ? F.in_(14) + (size_t)lk * D * D : mat == 3 ? F.in_(15) + (size_t)lk * D * D : w_mo;
            const float* g = mat == 1 ? ln_mem : (mat == 2 || mat == 3) ? F.in_(12) + lk * D : nullptr;
            const float cs = (mat == 1) ? (0.0625f * 1.4426950408889634f) : 1.0f;
            bf16* Wkv = (lk & 1) ? (bf16*)(ws + WS_WMKV2) : Wmkv;
            bf16* dst = mat == 0 ? Wout : mat == 1 ? Wmq : mat == 2 ? Wkv : mat == 3 ? (Wkv + (size_t)1024 * D) : Wmo;
            if ((mat == 1 && F8_Q) || (mat == 4 && F8_MO) || ((mat == 2 || mat == 3) && lk > 0)) tr_item64_f8(W, D, kb * 64, nb * 64, g, cs * F8_WSCALE, (mat == 3 ? (unsigned char*)Wkv + (size_t)1024 * D : (unsigned char*)dst) + (size_t)(nb * 64) * D + kb * 64, nullptr, nullptr, D, scr, lane);
            else tr_item64(W, D, kb * 64, nb * 64, g, cs, dst + (size_t)(nb * 64) * D + kb * 64, nullptr, nullptr, D, scr, lane);
            continue; }
        r -= I_SQS;
        if (r < I_E13) { const int mat = r / I_SEG, q = r % I_SEG, kb = q / 8, nb = q % 8; const int ge = mat >> 1, which = mat & 1;
            const float* W = (which ? w_e3 : w_e1) + (size_t)ge * D * DEXP; const int c0 = nb * 64;
            bf16* dst = W13 + ((size_t)ge * 1024 + (c0 >> 7) * 256 + which * 128 + (c0 & 127)) * D + kb * 64;
            if (layer_f8(l)) tr_item64_f8(W, DEXP, kb * 64, c0, ln_ffn, F8_WSCALE, (unsigned char*)W13 + ((size_t)ge * 1024 + (c0 >> 7) * 256 + which * 128 + (c0 & 127)) * D + kb * 64, nullptr, nullptr, D, scr, lane);
            else tr_item64(W, DEXP, kb * 64, c0, ln_ffn, 1.0f, dst, nullptr, nullptr, D, scr, lane);
            continue; }
        r -= I_E13;
        { const int ge = r / 128, q = r % 128, kb = q / 16, nb = q % 16; const int g = ge >> 2, e = ge & 3;
            const float* W = w_e2 + (size_t)ge * DEXP * D; bf16* dd[3];
#pragma unroll
            for (int j = 0; j < 3; ++j) { const int o = (e + 1 + j) & 3; const int a = o < e ? o : e, b = o < e ? e : o; const int cls = g * 6 + pair_index(a, b); const int pos = (e == b) ? 1 : 0;
                dd[j] = W2c + ((size_t)cls * 1024 + nb * 64) * 1024 + pos * 512 + kb * 64; }
            if (layer_f8(l)) { unsigned char* d8[3];
#pragma unroll
                for (int j = 0; j < 3; ++j) d8[j] = (unsigned char*)W2c + (size_t)(dd[j] - W2c);
                tr_item64_f8(W, D, kb * 64, nb * 64, nullptr, F8_WSCALE, d8[0], d8[1], d8[2], 1024, scr, lane); }
            else tr_item64(W, D, kb * 64, nb * 64, nullptr, 1.0f, dd[0], dd[1], dd[2], 1024, scr, lane); }
    }
    { float* wr = (float*)(ws + WS_WR); const float* w_rg = F.in_(18) + (size_t)l * D * NG; const float* w_re = F.in_(20) + (size_t)l * D * 16;
      const float* b_rg = F.in_(19) + l * NG; const float* b_re = F.in_(21) + l * 16;
      const int gt = F.bx * NTHREADS + F.tid, NT = F.G * NTHREADS;
      for (int e = gt; e < 20 * D; e += NT) { const int j = e / D, k = e % D; wr[e] = ln_ffn[k] * (j < 4 ? w_rg[k * NG + j] : w_re[k * 16 + (j - 4)]); }
      if (gt < 20) wr[20 * D + gt] = gt < 4 ? b_rg[gt] : b_re[gt - 4]; }
    if (l == 0) {
        const float* x = F.in_(0); const float* mem = F.in_(1); bf16* xb = (bf16*)(ws + WS_XB); float* ssq = (float*)(ws + WS_SSQ); bf16* memb = (bf16*)(ws + WS_MEMB); float* memr = (float*)(ws + WS_MEMR);
        for (int m = gw; m < NTOK + NMEM; m += NGW) { const bool ism = m >= NTOK; const int row = ism ? m - NTOK : m;
            const f32x4* xr = (const f32x4*)((ism ? mem : x) + (size_t)row * D) + lane; unsigned long long* o8 = (unsigned long long*)((ism ? memb : xb) + (size_t)row * D) + lane;
            float s = 0.f;
#pragma unroll
            for (int j = 0; j < 4; ++j) { const f32x4 v = xr[64 * j]; s += (v[0] * v[0] + v[1] * v[1]) + (v[2] * v[2] + v[3] * v[3]); o8[64 * j] = (unsigned long long)pk2(v[0], v[1]) | ((unsigned long long)pk2(v[2], v[3]) << 32);
                if (ism) ((unsigned*)(ws + WS_MEMB8 + (size_t)row * D))[lane + 64 * j] = f8x4(v[0], v[1], v[2], v[3]); }
            s = wave_sum(s);
            if (ism) { if (lane == 0) memr[row] = rsqrtf(s * (1.0f / D) + EPS); }
            else if (lane < 16) ssq[(size_t)row * 16 + lane] = lane == 0 ? s : 0.f; }
    }
}

typedef float f32x16 __attribute__((ext_vector_type(16)));
typedef short s16x4 __attribute__((ext_vector_type(4)));
namespace sbat {
constexpr int KST = 272, VST = 320, KBUF = 64 * KST, VBUF = 64 * VST, STG = KBUF + VBUF, OST = 272;
__device__ __forceinline__ f16x8 cvt8(float a, float b, float c, float d, float e, float f, float g, float h) { u32x4 w; w.x = pk2(a, b); w.y = pk2(c, d); w.z = pk2(e, f); w.w = pk2(g, h); return __builtin_bit_cast(f16x8, w); }
typedef short v4i16_t __attribute__((ext_vector_type(4)));
__device__ __forceinline__ s16x4 vtr(const LAS unsigned char* p) { return __builtin_bit_cast(s16x4, __builtin_amdgcn_ds_read_tr16_b64_v4i16((LAS v4i16_t*)p)); }
#define SB_MFMA(a, b, c) __builtin_amdgcn_mfma_f32_32x32x16_f16((a), (b), (c), 0, 0, 0)
}
__device__ __forceinline__ void sb_unit(Frame& F, int l, const int bh, const int qb) {
    using namespace sbat;
    unsigned char* ws = F.ws; const bf16* proj = (const bf16*)(ws + WS_PROJ); bf16* y = (bf16*)(ws + WS_Y); const float* sg = F.in_(9) + l * 512;
    const int tid = F.tid, lane = F.lane, w = F.wave, t32 = lane & 31, hi = lane >> 5;
    LAS unsigned char* lds = F.lds;
    f16x8 tri0, tri1, ones;
#pragma unroll
    for (int j = 0; j < 8; ++j) { const int k0 = 8 * (j >> 2) + 4 * hi + (j & 3); tri0[j] = (k0 > t32) ? (_Float16)1.0f : (_Float16)0.0f; tri1[j] = (16 + k0 > t32) ? (_Float16)1.0f : (_Float16)0.0f; ones[j] = (_Float16)1.0f; }
    {
        const int b = bh >> 2, hh = bh & 3;
        const size_t tokb = (size_t)b * SEQ; const int q0 = qb * 256, t0w = q0 + 32 * w, tg = t0w + t32;
        f16x8 qf[8];
        { const bf16* qrow = proj + (tokb + tg) * NPROJ + 2048 + hh * 128 + 8 * hi;
#pragma unroll
          for (int kk = 0; kk < 8; ++kk) qf[kk] = *(const f16x8*)(qrow + 16 * kk); }
        f32x16 O[4]; f32x16 Rv;
#pragma unroll
        for (int r = 0; r < 16; ++r) { O[0][r] = 0.f; O[1][r] = 0.f; O[2][r] = 0.f; O[3][r] = 0.f; Rv[r] = 0.f; }
        const int njt = 4 * qb + 4;
        LAS float* rmaxL = (LAS float*)(lds + 2 * STG);
        const int rowL = tid >> 4, chunk = tid & 15;
        const bf16* kg = proj + (tokb + rowL) * NPROJ + 2560 + hh * 128 + chunk * 8; const bf16* vg = kg + 512;
        const int kdst = rowL * KST + chunk * 16, vdst = KBUF + rowL * VST + chunk * 16;
        u32x4 kr0, kr1, vr0, vr1;
        { const size_t o = (size_t)(64 * (njt - 1)) * NPROJ; kr0 = *(const u32x4*)(kg + o); kr1 = *(const u32x4*)(kg + o + 32 * NPROJ); vr0 = *(const u32x4*)(vg + o); vr1 = *(const u32x4*)(vg + o + 32 * NPROJ); }
        *(LAS u32x4*)(lds + kdst) = kr0; *(LAS u32x4*)(lds + kdst + 32 * KST) = kr1; *(LAS u32x4*)(lds + vdst) = vr0; *(LAS u32x4*)(lds + vdst + 32 * VST) = vr1;
        __syncthreads();
        int cur = 0;
        for (int jt = njt - 1; jt >= 0; --jt) {
            const bool act = (64 * jt <= t0w);
            const LAS unsigned char* Kb = lds + cur * STG; const LAS unsigned char* Vb = Kb + KBUF;
            f16x8 Af[2][2];
            if (act) {
                f32x16 p0, p1;
#pragma unroll
                for (int r = 0; r < 16; ++r) { p0[r] = 0.f; p1[r] = 0.f; }
#pragma unroll
                for (int kk = 0; kk < 8; ++kk) { const f16x8 k0 = *(const LAS f16x8*)(Kb + t32 * KST + 32 * kk + 16 * hi); const f16x8 k1 = *(const LAS f16x8*)(Kb + (t32 + 32) * KST + 32 * kk + 16 * hi);
                    p0 = SB_MFMA(k0, qf[kk], p0); p1 = SB_MFMA(k1, qf[kk], p1); }
                const bool diag = (64 * jt + 63 >= t0w);
                float L0[16], L1[16];
#pragma unroll
                for (int r = 0; r < 16; ++r) { const int sl = 64 * jt + (r & 3) + 8 * (r >> 2) + 4 * hi;
                    { const float z = fminf(p0[r], 115.f); const float lg = __builtin_amdgcn_logf(1.0f + __builtin_amdgcn_exp2f(z)); float Lv = -lg, lb = z - lg; if (diag && !(sl < tg)) { Lv = 0.f; lb = -1e30f; } L0[r] = Lv; p0[r] = lb; }
                    { const float z = fminf(p1[r], 115.f); const float lg = __builtin_amdgcn_logf(1.0f + __builtin_amdgcn_exp2f(z)); float Lv = -lg, lb = z - lg; if (diag && !(sl + 32 < tg)) { Lv = 0.f; lb = -1e30f; } L1[r] = Lv; p1[r] = lb; } }
                const f16x8 X0a = cvt8(L0[0], L0[1], L0[2], L0[3], L0[4], L0[5], L0[6], L0[7]), X0b = cvt8(L0[8], L0[9], L0[10], L0[11], L0[12], L0[13], L0[14], L0[15]);
                const f16x8 X1a = cvt8(L1[0], L1[1], L1[2], L1[3], L1[4], L1[5], L1[6], L1[7]), X1b = cvt8(L1[8], L1[9], L1[10], L1[11], L1[12], L1[13], L1[14], L1[15]);
                f32x16 Y1 = SB_MFMA(tri0, X1a, Rv); Y1 = SB_MFMA(tri1, X1b, Y1);
                f32x16 U = SB_MFMA(ones, X1a, Rv); U = SB_MFMA(ones, X1b, U);
                f32x16 Y0 = SB_MFMA(tri0, X0a, U); Y0 = SB_MFMA(tri1, X0b, Y0);
                Rv = SB_MFMA(ones, X0a, U); Rv = SB_MFMA(ones, X0b, Rv);
#pragma unroll
                for (int r = 0; r < 16; ++r) { p0[r] = __builtin_amdgcn_exp2f(p0[r] + Y0[r]); p1[r] = __builtin_amdgcn_exp2f(p1[r] + Y1[r]); }
                Af[0][0] = cvt8(p0[0], p0[1], p0[2], p0[3], p0[4], p0[5], p0[6], p0[7]); Af[0][1] = cvt8(p0[8], p0[9], p0[10], p0[11], p0[12], p0[13], p0[14], p0[15]);
                Af[1][0] = cvt8(p1[0], p1[1], p1[2], p1[3], p1[4], p1[5], p1[6], p1[7]); Af[1][1] = cvt8(p1[8], p1[9], p1[10], p1[11], p1[12], p1[13], p1[14], p1[15]);
            }
            if (jt > 0) { const size_t o = (size_t)(64 * (jt - 1)) * NPROJ; kr0 = *(const u32x4*)(kg + o); kr1 = *(const u32x4*)(kg + o + 32 * NPROJ); vr0 = *(const u32x4*)(vg + o); vr1 = *(const u32x4*)(vg + o + 32 * NPROJ); }
            if (act) {
                const int i16 = lane & 15, dhalf = (lane >> 4) & 1;
                const LAS unsigned char* va = Vb + (4 * hi + (i16 >> 2)) * VST + (dhalf * 16 + 4 * (i16 & 3)) * 2;
#pragma unroll
                for (int dblk = 0; dblk < 4; ++dblk)
#pragma unroll
                    for (int sb = 0; sb < 2; ++sb)
#pragma unroll
                        for (int sp = 0; sp < 2; ++sp) { const LAS unsigned char* pp = va + (32 * sb + 16 * sp) * VST + dblk * 64; const s16x4 lo = vtr(pp), h4 = vtr(pp + 8 * VST);
                            const bf16x8 vf = (bf16x8){lo[0], lo[1], lo[2], lo[3], h4[0], h4[1], h4[2], h4[3]};
                            O[dblk] = SB_MFMA(__builtin_bit_cast(f16x8, vf), Af[sb][sp], O[dblk]); }
            }
            if (jt > 0) { const int nb = (cur ^ 1) * STG; *(LAS u32x4*)(lds + nb + kdst) = kr0; *(LAS u32x4*)(lds + nb + kdst + 32 * KST) = kr1; *(LAS u32x4*)(lds + nb + vdst) = vr0; *(LAS u32x4*)(lds + nb + vdst + 32 * VST) = vr1; }
            { const float rw = wave_max(Rv[0]); if (lane == 0) rmaxL[(jt & 1) * 8 + w] = rw; }
            __syncthreads(); cur ^= 1;
            { const f32x4 ra = *(const LAS f32x4*)(rmaxL + (jt & 1) * 8), rb = *(const LAS f32x4*)(rmaxL + (jt & 1) * 8 + 4);
              const float rm = fmaxf(fmaxf(fmaxf(ra[0], ra[1]), fmaxf(ra[2], ra[3])), fmaxf(fmaxf(rb[0], rb[1]), fmaxf(rb[2], rb[3])));
              if (rm < -27.0f) break; }
        }
        { float ss = 0.f;
#pragma unroll
          for (int dblk = 0; dblk < 4; ++dblk)
#pragma unroll
              for (int r = 0; r < 16; ++r) ss += O[dblk][r] * O[dblk][r];
          ss = xor32_sum(ss); const float rr = rsqrtf(ss * (1.0f / 128) + EPS);
          LAS unsigned char* st = lds + w * (32 * OST);
#pragma unroll
          for (int dblk = 0; dblk < 4; ++dblk)
#pragma unroll
              for (int rq = 0; rq < 4; ++rq) { u32x2 v; v.x = pk2(O[dblk][4 * rq] * rr, O[dblk][4 * rq + 1] * rr); v.y = pk2(O[dblk][4 * rq + 2] * rr, O[dblk][4 * rq + 3] * rr);
                  *(LAS u32x2*)(st + t32 * OST + (dblk * 32 + 8 * rq + 4 * hi) * 2) = v; }
          LDS_WAIT();
          int le = lane; asm volatile("" : "+v"(le));
          const int ch = le & 15; const f32x4 g0 = *(const f32x4*)(sg + hh * 128 + ch * 8), g1 = *(const f32x4*)(sg + hh * 128 + ch * 8 + 4);
#pragma unroll
          for (int i = 0; i < 8; ++i) { const int row = i * 4 + (le >> 4); const u32x4 v = *(const LAS u32x4*)(st + row * OST + ch * 16); u32x4 o;
              o.x = pk2(bflo(v.x) * g0[0], bfhi(v.x) * g0[1]); o.y = pk2(bflo(v.y) * g0[2], bfhi(v.y) * g0[3]); o.z = pk2(bflo(v.z) * g1[0], bfhi(v.z) * g1[1]); o.w = pk2(bflo(v.w) * g1[2], bfhi(v.w) * g1[3]);
              *(u32x4*)(y + (tokb + t0w + row) * D + 512 + hh * 128 + ch * 8) = o; }
        }
        __syncthreads();
    }
}


namespace mls {
constexpr int ST = 272, KC = 0, VC = 128 * ST, CT = 2 * 128 * ST, QC = 3 * 128 * ST, GB = 4 * 128 * ST;
static_assert(GB + 2560 <= LDSCTL_OFF, "mLSTM LDS map");
#define ML_MFMA(a, b, c) __builtin_amdgcn_mfma_f32_16x16x32_f16((a), (b), (c), 0, 0, 0)
__device__ __forceinline__ f16x8 tr8(const LAS unsigned char* p, int second_off) { const s16x4 lo = sbat::vtr(p), h4 = sbat::vtr(p + second_off); const bf16x8 v = (bf16x8){lo[0], lo[1], lo[2], lo[3], h4[0], h4[1], h4[2], h4[3]}; return __builtin_bit_cast(f16x8, v); }
}
__device__ __forceinline__ void ml_x1(Frame& F, int l, const int item) {
    using namespace mls;
    unsigned char* ws = F.ws; const bf16* proj = (const bf16*)(ws + WS_PROJ); const float* gates = (const float*)(ws + WS_GATES);
    const int tid = F.tid, lane = F.lane, w = F.wave, l16 = lane & 15, g = lane >> 4; LAS unsigned char* lds = F.lds;
    const int chain = item >> 4, c = item & 15, b = chain >> 2, h = chain & 3;
    const float* convw = F.in_(4) + (size_t)l * 4 * 1024; const float* convb = F.in_(5) + l * 1024; const float ib = F.in_(6)[l * 4 + h], fb = F.in_(7)[l * 4 + h];
    bf16* qcv = (bf16*)(ws + WS_QCV) + (size_t)item * 16384; bf16* kcv = (bf16*)(ws + WS_KCV) + (size_t)item * 16384; bf16* dC = (bf16*)(ws + WS_DC) + (size_t)item * 16384;
    float* gbuf = (float*)(ws + WS_GBUF) + (size_t)item * 384; float* dn = (float*)(ws + WS_DN) + (size_t)item * 128; float* scal = (float*)(ws + WS_SCAL) + (size_t)item * 4;
    LAS float* gL = (LAS float*)(lds + GB) + 128; LAS _Float16* wS = (LAS _Float16*)(lds + GB + 2048);
    const int ts0 = c * 128; const size_t tokc = (size_t)b * SEQ + ts0; const int q4 = l16 >> 2, p4 = l16 & 3;
    { const int cg = tid & 15, r0 = 4 * (tid >> 4);
#pragma unroll
      for (int qk = 0; qk < 2; ++qk) { const int ch = qk * 512 + h * 128 + cg * 8; u32x4 raw[7];
#pragma unroll
          for (int j = 0; j < 7; ++j) { const int tt = ts0 + r0 - 3 + j; const int ttc = tt < 0 ? 0 : tt; u32x4 r_ = *(const u32x4*)(proj + ((size_t)b * SEQ + ttc) * NPROJ + ch);
              if (tt < 0) r_ = (u32x4){0u, 0u, 0u, 0u}; raw[j] = r_; }
          float wv[4][8], bv[8];
#pragma unroll
          for (int e4 = 0; e4 < 2; ++e4) { const f32x4 t_ = *(const f32x4*)(convb + ch + 4 * e4); bv[4 * e4] = t_[0]; bv[4 * e4 + 1] = t_[1]; bv[4 * e4 + 2] = t_[2]; bv[4 * e4 + 3] = t_[3];
#pragma unroll
              for (int tap = 0; tap < 4; ++tap) { const f32x4 u_ = *(const f32x4*)(convw + tap * 1024 + ch + 4 * e4); wv[tap][4 * e4] = u_[0]; wv[tap][4 * e4 + 1] = u_[1]; wv[tap][4 * e4 + 2] = u_[2]; wv[tap][4 * e4 + 3] = u_[3]; } }
          const float sc = qk ? 0.08838834764831845f : 1.0f;
#pragma unroll
          for (int r = 0; r < 4; ++r) { float a[8];
#pragma unroll
              for (int e = 0; e < 8; ++e) a[e] = bv[e];
#pragma unroll
              for (int tap = 0; tap < 4; ++tap) { const u32x4 r_ = raw[r + tap];
                  a[0] += wv[tap][0] * bflo(r_.x); a[1] += wv[tap][1] * bfhi(r_.x); a[2] += wv[tap][2] * bflo(r_.y); a[3] += wv[tap][3] * bfhi(r_.y);
                  a[4] += wv[tap][4] * bflo(r_.z); a[5] += wv[tap][5] * bfhi(r_.z); a[6] += wv[tap][6] * bflo(r_.w); a[7] += wv[tap][7] * bfhi(r_.w); }
              u32x4 o_; o_.x = pk2(siluf(a[0]) * sc, siluf(a[1]) * sc); o_.y = pk2(siluf(a[2]) * sc, siluf(a[3]) * sc); o_.z = pk2(siluf(a[4]) * sc, siluf(a[5]) * sc); o_.w = pk2(siluf(a[6]) * sc, siluf(a[7]) * sc);
              *(u32x4*)((qk ? kcv : qcv) + (r0 + r) * 128 + cg * 8) = o_;
              if (qk) *(LAS u32x4*)(lds + KC + (r0 + r) * ST + cg * 16) = o_; } }
#pragma unroll
      for (int r = 0; r < 4; ++r) *(LAS u32x4*)(lds + VC + (r0 + r) * ST + cg * 16) = *(const u32x4*)(proj + (tokc + r0 + r) * NPROJ + 1024 + h * 128 + cg * 8); }
    if (w == 0) { const int t0 = 2 * lane; const float* gp = gates + (tokc + t0) * 8;
        const float i0 = gp[h] + ib, f0 = gp[4 + h] + fb, i1 = gp[8 + h] + ib, f1 = gp[12 + h] + fb;
        const float lf0 = -softplusf(-f0), lf1 = -softplusf(-f1); const float s2 = lf0 + lf1; float incl = s2;
        incl += DPPF(0.f, incl, 0x111, 0xF); incl += DPPF(0.f, incl, 0x112, 0xF); incl += DPPF(0.f, incl, 0x114, 0xF); incl += DPPF(0.f, incl, 0x118, 0xF);
        incl += DPPF(0.f, incl, 0x142, 0xA); incl += DPPF(0.f, incl, 0x143, 0xC);
        const float b0 = incl - s2 + lf0, b1 = b0 + lf1; const float g0 = i0 - b0, g1 = i1 - b1; float pm = fmaxf(g0, g1);
        pm = fmaxf(pm, DPPF(-INFINITY, pm, 0x111, 0xF)); pm = fmaxf(pm, DPPF(-INFINITY, pm, 0x112, 0xF)); pm = fmaxf(pm, DPPF(-INFINITY, pm, 0x114, 0xF)); pm = fmaxf(pm, DPPF(-INFINITY, pm, 0x118, 0xF));
        pm = fmaxf(pm, DPPF(-INFINITY, pm, 0x142, 0xA)); pm = fmaxf(pm, DPPF(-INFINITY, pm, 0x143, 0xC));
        const float pe = DPPF(-INFINITY, pm, 0x138, 0xF);
        const float G0 = fmaxf(pe, g0), G1 = fmaxf(G0, g1);
        const float Gmax = __builtin_bit_cast(float, __builtin_amdgcn_readlane(__builtin_bit_cast(int, G1), 63)), blast = __builtin_bit_cast(float, __builtin_amdgcn_readlane(__builtin_bit_cast(int, b1), 63));
        *(f32x2*)(gbuf + t0) = (f32x2){b0, b1}; *(f32x2*)(gbuf + 128 + t0) = (f32x2){g0, g1}; *(f32x2*)(gbuf + 256 + t0) = (f32x2){G0, G1};
        wS[t0] = (_Float16)__expf(g0 - Gmax); wS[t0 + 1] = (_Float16)__expf(g1 - Gmax);
        if (lane == 0) { scal[0] = blast; scal[1] = Gmax; } }
    __syncthreads();
    { f32x4 Cacc[8]; f32x4 Cn = (f32x4){0.f, 0.f, 0.f, 0.f};
#pragma unroll
      for (int vt = 0; vt < 8; ++vt) Cacc[vt] = (f32x4){0.f, 0.f, 0.f, 0.f};
#pragma unroll
      for (int ks = 0; ks < 4; ++ks) { const f16x8 kb = tr8(lds + KC + (32 * ks + 4 * g + q4) * ST + (16 * w + 4 * p4) * 2, 16 * ST);
          const u32x2 wa = *(const LAS u32x2*)(wS + 32 * ks + 4 * g), wb = *(const LAS u32x2*)(wS + 32 * ks + 16 + 4 * g); const u32x4 w4 = (u32x4){wa.x, wa.y, wb.x, wb.y}; const f16x8 wf = __builtin_bit_cast(f16x8, w4);
          Cn = ML_MFMA(wf, kb, Cn);
          f16x8 vfb[8];
#pragma unroll
          for (int vt = 0; vt < 8; ++vt) vfb[vt] = tr8(lds + VC + (32 * ks + 4 * g + q4) * ST + (16 * vt + 4 * p4) * 2, 16 * ST);
          __builtin_amdgcn_sched_barrier(0);
#pragma unroll
          for (int vt = 0; vt < 8; ++vt) Cacc[vt] = ML_MFMA(vfb[vt] * wf, kb, Cacc[vt]);
          __builtin_amdgcn_sched_barrier(0); }
#pragma unroll
      for (int vt = 0; vt < 8; ++vt) { u32x2 o_; o_.x = pk2(Cacc[vt][0], Cacc[vt][1]); o_.y = pk2(Cacc[vt][2], Cacc[vt][3]); *(u32x2*)(dC + (16 * w + l16) * 128 + 16 * vt + 4 * g) = o_; }
      if (g == 0) dn[16 * w + l16] = Cn[0]; }
    __syncthreads();
}
__device__ __forceinline__ void phase_ml_scan(Frame& F) {
    unsigned char* ws = F.ws; const int tid = F.tid;
    for (int u = F.bx; u < 256; u += F.G) { const int chain = u >> 2, qtr = u & 3; const size_t e0 = (size_t)qtr * 4096 + tid * 8;
        const bf16* dC = (const bf16*)(ws + WS_DC) + (size_t)chain * 16 * 16384 + e0; bf16* Cp = (bf16*)(ws + WS_CPREV) + (size_t)chain * 16 * 16384 + e0;
        const float* dn = (const float*)(ws + WS_DN) + (size_t)chain * 16 * 128; float* np = (float*)(ws + WS_NPREV) + (size_t)chain * 16 * 128; float* scal = (float*)(ws + WS_SCAL) + (size_t)chain * 16 * 4;
        float z0 = 0.f; asm volatile("" : "+v"(z0));
        float C[8] = {z0, z0, z0, z0, z0, z0, z0, z0}; float nn = z0; float m = z0; const bool don = (qtr == 0 && tid < 128);
        u32x4 dall[16]; float dnall[16]; f32x2 scall[16];
#pragma unroll
        for (int c = 0; c < 16; ++c) { dall[c] = *(const u32x4*)(dC + (size_t)c * 16384); dnall[c] = don ? dn[c * 128 + tid] : z0; scall[c] = *(const f32x2*)(scal + c * 4); }
#pragma unroll
        for (int c = 0; c < 16; ++c) { const u32x4 dcur = dall[c]; const float dncur = dnall[c]; const f32x2 sc = scall[c];
            u32x4 o_; o_.x = pk2(C[0], C[1]); o_.y = pk2(C[2], C[3]); o_.z = pk2(C[4], C[5]); o_.w = pk2(C[6], C[7]); *(u32x4*)(Cp + (size_t)c * 16384) = o_;
            if (don) np[c * 128 + tid] = nn;
            if (qtr == 0 && tid == 0) scal[c * 4 + 2] = m;
            const float Mlast = fmaxf(m, sc[1]), wold = __expf(m - Mlast), wloc = __expf(sc[1] - Mlast);
            C[0] = wold * C[0] + wloc * bflo(dcur.x); C[1] = wold * C[1] + wloc * bfhi(dcur.x); C[2] = wold * C[2] + wloc * bflo(dcur.y); C[3] = wold * C[3] + wloc * bfhi(dcur.y);
            C[4] = wold * C[4] + wloc * bflo(dcur.z); C[5] = wold * C[5] + wloc * bfhi(dcur.z); C[6] = wold * C[6] + wloc * bflo(dcur.w); C[7] = wold * C[7] + wloc * bfhi(dcur.w);
            nn = wold * nn + wloc * dncur; m = sc[0] + Mlast; } }
}
struct X3Pf { u32x4 q[4], k[4], c[4], v[4]; f32x4 g; float mp; };
__device__ __forceinline__ void x3_load(Frame& F, const int item, X3Pf& pf) {
    unsigned char* ws = F.ws; const bf16* proj = (const bf16*)(ws + WS_PROJ); const int tid = F.wave * 64 + pg8::lane_fresh();
    const int chain = item >> 4, c = item & 15, b = chain >> 2, h = chain & 3; const size_t tokc = (size_t)b * SEQ + c * 128;
    const bf16* qcv = (const bf16*)(ws + WS_QCV) + (size_t)item * 16384; const bf16* kcv = (const bf16*)(ws + WS_KCV) + (size_t)item * 16384; const bf16* Cp = (const bf16*)(ws + WS_CPREV) + (size_t)item * 16384;
    const float* gbuf = (const float*)(ws + WS_GBUF) + (size_t)item * 384; const float* np = (const float*)(ws + WS_NPREV) + (size_t)item * 128; const float* scal = (const float*)(ws + WS_SCAL) + (size_t)item * 4;
    const int cg = tid & 15, r0 = tid >> 4;
#pragma unroll
    for (int i = 0; i < 4; ++i) { const int row = r0 + 32 * i;
        pf.q[i] = *(const u32x4*)(qcv + row * 128 + cg * 8); pf.k[i] = *(const u32x4*)(kcv + row * 128 + cg * 8);
        pf.c[i] = *(const u32x4*)(Cp + row * 128 + cg * 8); pf.v[i] = *(const u32x4*)(proj + (tokc + row) * NPROJ + 1024 + h * 128 + cg * 8); }
    pf.g = (f32x4){0.f, 0.f, 0.f, 0.f};
    if (tid < 96) pf.g = *(const f32x4*)(gbuf + 4 * tid); else if (tid < 128) pf.g = *(const f32x4*)(np + 4 * (tid - 96));
    pf.mp = scal[2];
}
__device__ __forceinline__ void ml_x3(Frame& F, int l, const int item, X3Pf& pf, const int next_item) {
    using namespace mls;
    unsigned char* ws = F.ws; const bf16* proj = (const bf16*)(ws + WS_PROJ); bf16* y = (bf16*)(ws + WS_Y);
    const int tid = F.tid, lane = F.lane, w = F.wave, l16 = lane & 15, g = lane >> 4; LAS unsigned char* lds = F.lds;
    const int chain = item >> 4, c = item & 15, b = chain >> 2, h = chain & 3;
    const float* hg = F.in_(8) + l * 512 + h * 128;
    const bf16* qcv = (const bf16*)(ws + WS_QCV) + (size_t)item * 16384; const bf16* kcv = (const bf16*)(ws + WS_KCV) + (size_t)item * 16384; const bf16* Cp = (const bf16*)(ws + WS_CPREV) + (size_t)item * 16384;
    const float* gbuf = (const float*)(ws + WS_GBUF) + (size_t)item * 384; const float* np = (const float*)(ws + WS_NPREV) + (size_t)item * 128; const float* scal = (const float*)(ws + WS_SCAL) + (size_t)item * 4;
    LAS float* bL = (LAS float*)(lds + GB); LAS float* gL = bL + 128; LAS float* GL = bL + 256; LAS float* nL = bL + 384;
    const size_t tokc = (size_t)b * SEQ + c * 128; const int q4 = l16 >> 2, p4 = l16 & 3;
    { const int cg = tid & 15, r0 = tid >> 4;
#pragma unroll
      for (int i = 0; i < 4; ++i) { const int row = r0 + 32 * i;
          *(LAS u32x4*)(lds + QC + row * ST + cg * 16) = pf.q[i]; *(LAS u32x4*)(lds + KC + row * ST + cg * 16) = pf.k[i];
          *(LAS u32x4*)(lds + CT + row * ST + cg * 16) = pf.c[i]; *(LAS u32x4*)(lds + VC + row * ST + cg * 16) = pf.v[i]; }
      if (tid < 96) *(LAS f32x4*)(bL + 4 * tid) = pf.g;
      else if (tid < 128) *(LAS f32x4*)(nL + 4 * (tid - 96)) = pf.g; }
    const float mp = pf.mp;
    __syncthreads();
    if (next_item >= 0) x3_load(F, next_item, pf);
    { const int t = 16 * w + l16; const size_t tok = tokc + t; const float Mt = fmaxf(mp, GL[t]), bt = bL[t]; const float wi = __expf(mp - Mt);
      u32x2 mo8[8];
#pragma unroll
      for (int vt = 0; vt < 8; ++vt) mo8[vt] = *(const u32x2*)(proj + tok * NPROJ + 1536 + h * 128 + 16 * vt + 4 * g);
      f16x8 qf[4], qs[4];
#pragma unroll
      for (int kk = 0; kk < 4; ++kk) { qf[kk] = *(const LAS f16x8*)(lds + QC + (16 * w + l16) * ST + (32 * kk + 8 * g) * 2); qs[kk] = qf[kk] * (_Float16)wi; }
      f32x4 sa[8];
#pragma unroll
      for (int st = 0; st < 8; ++st) { sa[st] = (f32x4){0.f, 0.f, 0.f, 0.f};
          if (st <= w) { f16x8 kf[4];
#pragma unroll
              for (int kk = 0; kk < 4; ++kk) kf[kk] = *(const LAS f16x8*)(lds + KC + (16 * st + l16) * ST + (32 * kk + 8 * g) * 2);
              __builtin_amdgcn_sched_barrier(0);
#pragma unroll
              for (int kk = 0; kk < 4; ++kk) sa[st] = ML_MFMA(kf[kk], qf[kk], sa[st]);
              __builtin_amdgcn_sched_barrier(0); } }
      float den = 0.f;
#pragma unroll
      for (int st = 0; st < 8; ++st) { const f32x4 gv = *(const LAS f32x4*)(gL + 16 * st + 4 * g);
#pragma unroll
          for (int r = 0; r < 4; ++r) { const int s_ = 16 * st + 4 * g + r; const float p = (s_ <= t) ? sa[st][r] * __expf(gv[r] - Mt) : 0.f; den += p; sa[st][r] = p; } }
      f16x8 Pf[4];
#pragma unroll
      for (int ks = 0; ks < 4; ++ks) Pf[ks] = sbat::cvt8(sa[2 * ks][0], sa[2 * ks][1], sa[2 * ks][2], sa[2 * ks][3], sa[2 * ks + 1][0], sa[2 * ks + 1][1], sa[2 * ks + 1][2], sa[2 * ks + 1][3]);
      f32x4 nt[8];
#pragma unroll
      for (int vt = 0; vt < 8; ++vt) { nt[vt] = (f32x4){0.f, 0.f, 0.f, 0.f}; f16x8 vf[4], cf[4];
#pragma unroll
          for (int ks = 0; ks < 4; ++ks) if (32 * ks <= 16 * w + 15) vf[ks] = tr8(lds + VC + (32 * ks + 4 * g + q4) * ST + (16 * vt + 4 * p4) * 2, 16 * ST);
#pragma unroll
          for (int kk = 0; kk < 4; ++kk) cf[kk] = tr8(lds + CT + (32 * kk + 8 * g + q4) * ST + (16 * vt + 4 * p4) * 2, 4 * ST);
          __builtin_amdgcn_sched_barrier(0);
#pragma unroll
          for (int ks = 0; ks < 4; ++ks) if (32 * ks <= 16 * w + 15) nt[vt] = ML_MFMA(vf[ks], Pf[ks], nt[vt]);
#pragma unroll
          for (int kk = 0; kk < 4; ++kk) nt[vt] = ML_MFMA(cf[kk], qs[kk], nt[vt]);
          __builtin_amdgcn_sched_barrier(0); }
      den = xor16_sum(den); den = xor32_sum(den);
      float nq = 0.f;
#pragma unroll
      for (int kk = 0; kk < 4; ++kk) { const f32x4 n0 = *(const LAS f32x4*)(nL + 32 * kk + 8 * g), n1 = *(const LAS f32x4*)(nL + 32 * kk + 8 * g + 4);
          nq += n0[0] * (float)qf[kk][0] + n0[1] * (float)qf[kk][1] + n0[2] * (float)qf[kk][2] + n0[3] * (float)qf[kk][3] + n1[0] * (float)qf[kk][4] + n1[1] * (float)qf[kk][5] + n1[2] * (float)qf[kk][6] + n1[3] * (float)qf[kk][7]; }
      nq = xor16_sum(nq); nq = xor32_sum(nq);
      den += wi * nq;
      const float dn_ = __builtin_amdgcn_rcpf(fmaxf(fabsf(den), __expf(-(bt + Mt)))); float ss = 0.f;
#pragma unroll
      for (int vt = 0; vt < 8; ++vt)
#pragma unroll
          for (int r = 0; r < 4; ++r) { nt[vt][r] *= dn_; ss += nt[vt][r] * nt[vt][r]; }
      ss = xor16_sum(ss); ss = xor32_sum(ss); const float rr = rsqrtf(ss * (1.0f / 128) + EPS);
#pragma unroll
      for (int vt = 0; vt < 8; ++vt) { const int v0 = 16 * vt + 4 * g; const u32x2 mo = mo8[vt]; const f32x4 gg = *(const f32x4*)(hg + v0);
          u32x2 o_; o_.x = pk2(sigmf(bflo(mo.x)) * nt[vt][0] * rr * gg[0], sigmf(bfhi(mo.x)) * nt[vt][1] * rr * gg[1]); o_.y = pk2(sigmf(bflo(mo.y)) * nt[vt][2] * rr * gg[2], sigmf(bfhi(mo.y)) * nt[vt][3] * rr * gg[3]);
          *(u32x2*)(y + tok * D + h * 128 + v0) = o_; } }
    __syncthreads();
}

__device__ __forceinline__ void phase_mixer(Frame& F, int l, int qidx, int mode) {
    volatile LAS int* qs = (volatile LAS int*)(F.lds + MISC_OFF + 64); unsigned* qc = F.ctl + CW_Q + qidx;
    int ahead = 0; if (F.tid == 0) ahead = (int)atomicAdd(qc, 1u);
    for (;;) {
        if (F.tid == 0) *qs = ahead;
        __syncthreads();
        const int it = __builtin_amdgcn_readfirstlane(*qs);
        __syncthreads();
        if (it >= 512 + 1024) break;
        if (F.tid == 0) ahead = (int)atomicAdd(qc, 1u);
        if (mode == 1 && it < 512) continue;
        if (mode == 3 && it >= 512) break;
        Frame G = F;
        { int t_ = F.tid; asm volatile("" : "+v"(t_)); G.tid = t_; G.lane = t_ & 63; G.wave = __builtin_amdgcn_readfirstlane(t_ >> 6);
          unsigned lb_ = 0; asm volatile("" : "+s"(lb_)); G.lds = F.lds + lb_;
          GAS unsigned char* w_ = (GAS unsigned char*)F.ws; asm volatile("" : "+s"(w_)); G.ws = (unsigned char*)w_; }
        if (it >= 512) ml_x1(G, l, it - 512);
        else sb_unit(G, l, it & 63, 7 - (it >> 6));
    }
}

namespace xat {
constexpr int KST = 272, VST = 320, BUFB = 64 * VST, OST = 272;
typedef __amdgpu_buffer_rsrc_t rsrc_t;
__device__ __forceinline__ float xor32_max(float x) { auto t = __builtin_amdgcn_permlane32_swap(__float_as_uint(x), __float_as_uint(x), false, false); return fmaxf(__uint_as_float(t[0]), __uint_as_float(t[1])); }
template <int S> struct Step { static constexpr int isV = S >= 8, tile = isV ? ((S - 8) & 3) : (S >> 1), dh = isV ? ((S - 8) >> 2) : (S & 1), buf = S % 3; };
template <int S> __device__ __forceinline__ void ld(u32x4 (&r)[2], rsrc_t kvr, unsigned loff) {
    if constexpr (S < 16) {
#pragma unroll
        for (int i = 0; i < 2; ++i) r[i] = __builtin_bit_cast(u32x4, __builtin_amdgcn_raw_buffer_load_b128(kvr, loff, ((64 * Step<S>::tile + 32 * i) * 2048 + Step<S>::isV * 1024 + Step<S>::dh * 128) * 2, 0)); }
}
template <int S> __device__ __forceinline__ void st(const u32x4 (&r)[2], LAS unsigned char* lds, unsigned lk, unsigned lv) {
    if constexpr (S < 16) { constexpr int ST = Step<S>::isV ? VST : KST;
#pragma unroll
        for (int i = 0; i < 2; ++i) *(LAS u32x4*)(lds + (Step<S>::isV ? lv : lk) + Step<S>::buf * BUFB + 32 * i * ST) = r[i]; }
}
template <int S> __device__ __forceinline__ void qk(f32x16& S0, f32x16& S1, const f16x8 (&qf)[16], const LAS unsigned char* lds, int t32, int hi) {
#pragma unroll
    for (int kk = 0; kk < 8; ++kk) { const f16x8 k0 = *(const LAS f16x8*)(lds + Step<S>::buf * BUFB + t32 * KST + 32 * kk + 16 * hi); const f16x8 k1 = *(const LAS f16x8*)(lds + Step<S>::buf * BUFB + (32 + t32) * KST + 32 * kk + 16 * hi);
        S0 = SB_MFMA(k0, qf[8 * Step<S>::dh + kk], S0); S1 = SB_MFMA(k1, qf[8 * Step<S>::dh + kk], S1); }
}
template <int TILE> __device__ __forceinline__ void smax(f32x16& S0, f32x16& S1, f16x8 (&Pf)[8][2], float (&mt)[4], float& m, float& sum) {
    float tm = fmaxf(S0[0], S1[0]);
#pragma unroll
    for (int r = 1; r < 16; ++r) tm = fmaxf(tm, fmaxf(S0[r], S1[r]));
    tm = xor32_max(tm);
    const float mn = fmaxf(m, tm); sum *= __builtin_amdgcn_exp2f(m - mn); m = mn; mt[TILE] = mn;
    float ps = 0.f;
#pragma unroll
    for (int r = 0; r < 16; ++r) { S0[r] = __builtin_amdgcn_exp2f(S0[r] - mn); S1[r] = __builtin_amdgcn_exp2f(S1[r] - mn); ps += S0[r] + S1[r]; }
    sum += ps;
    Pf[2 * TILE][0] = sbat::cvt8(S0[0], S0[1], S0[2], S0[3], S0[4], S0[5], S0[6], S0[7]); Pf[2 * TILE][1] = sbat::cvt8(S0[8], S0[9], S0[10], S0[11], S0[12], S0[13], S0[14], S0[15]);
    Pf[2 * TILE + 1][0] = sbat::cvt8(S1[0], S1[1], S1[2], S1[3], S1[4], S1[5], S1[6], S1[7]); Pf[2 * TILE + 1][1] = sbat::cvt8(S1[8], S1[9], S1[10], S1[11], S1[12], S1[13], S1[14], S1[15]);
#pragma unroll
    for (int r = 0; r < 16; ++r) { S0[r] = 0.f; S1[r] = 0.f; }
}
template <int S> __device__ __forceinline__ void pv(f32x16 (&O)[4], const f16x8 (&Pf)[8][2], const LAS unsigned char* lds, int lane, int hi) {
    const int i16 = lane & 15, dhalf = (lane >> 4) & 1;
    const LAS unsigned char* va = lds + Step<S>::buf * BUFB + (4 * hi + (i16 >> 2)) * VST + (dhalf * 16 + 4 * (i16 & 3)) * 2;
#pragma unroll
    for (int dblk = 0; dblk < 4; ++dblk)
#pragma unroll
        for (int sb = 0; sb < 2; ++sb)
#pragma unroll
            for (int sp = 0; sp < 2; ++sp) { const LAS unsigned char* pp = va + (32 * sb + 16 * sp) * VST + dblk * 64; const s16x4 lo = sbat::vtr(pp), h4 = sbat::vtr(pp + 8 * VST);
                const bf16x8 vf = (bf16x8){lo[0], lo[1], lo[2], lo[3], h4[0], h4[1], h4[2], h4[3]};
                O[dblk] = SB_MFMA(__builtin_bit_cast(f16x8, vf), Pf[2 * Step<S>::tile + sb][sp], O[dblk]); }
}
}
__device__ __forceinline__ void phase_xattn(Frame& F) {
    using namespace xat;
    unsigned char* ws = F.ws; const bf16* q = (const bf16*)(ws + WS_Q); const bf16* kv = (const bf16*)(ws + WS_KV); bf16* o = (bf16*)(ws + WS_O);
    const int tid = F.tid, lane = F.lane, w = F.wave, t32 = lane & 31, hi = lane >> 5; LAS unsigned char* lds = F.lds;
    const unsigned loff = (unsigned)((tid >> 4) * 2048 + (tid & 15) * 8) * 2u, lk = (unsigned)((tid >> 4) * KST + (tid & 15) * 16), lv = (unsigned)((tid >> 4) * VST + (tid & 15) * 16);
    for (int unit = F.bx; unit < 512; unit += F.G) {
        const int bh = (unit & 255) >> 2, qblk = ((unit & 3) << 1) | (unit >> 8), b = bh >> 2, hd = bh & 3;
        const size_t tok0 = (size_t)b * SEQ + qblk * 256 + 32 * w;
        const bf16* kvb = kv + (size_t)b * MEML * 2048 + hd * 256;
        const rsrc_t kvr = __builtin_amdgcn_make_buffer_rsrc((void*)kvb, 0, 0x7fffffff, 0x00020000);
        f16x8 qf[16];
        { const bf16* qrow = q + (tok0 + t32) * D + hd * 256 + 8 * hi;
#pragma unroll
          for (int kk = 0; kk < 16; ++kk) qf[kk] = *(const f16x8*)(qrow + 16 * kk); }
        f16x8 Pf[8][2]; float mt[4]; float m = -INFINITY, sum = 0.f;
        f32x16 S0, S1;
#pragma unroll
        for (int r = 0; r < 16; ++r) { S0[r] = 0.f; S1[r] = 0.f; }
        u32x4 rA[2], rB[2];
        ld<0>(rA, kvr, loff); st<0>(rA, lds, lk, lv); ld<1>(rB, kvr, loff); __syncthreads();
#define XA_KSTEP(S_, RL, RS) ld<S_ + 2>(RL, kvr, loff); qk<S_>(S0, S1, qf, lds, t32, hi); if ((S_) & 1) smax<((S_) / 2)>(S0, S1, Pf, mt, m, sum); st<S_ + 1>(RS, lds, lk, lv); __syncthreads();
        XA_KSTEP(0, rA, rB) XA_KSTEP(1, rB, rA) XA_KSTEP(2, rA, rB) XA_KSTEP(3, rB, rA) XA_KSTEP(4, rA, rB) XA_KSTEP(5, rB, rA) XA_KSTEP(6, rA, rB) XA_KSTEP(7, rB, rA)
#undef XA_KSTEP
#pragma unroll
        for (int t = 0; t < 3; ++t) { const _Float16 f = (_Float16)__builtin_amdgcn_exp2f(mt[t] - m);
#pragma unroll
            for (int sb = 0; sb < 2; ++sb)
#pragma unroll
                for (int sp = 0; sp < 2; ++sp) Pf[2 * t + sb][sp] = Pf[2 * t + sb][sp] * f; }
        sum = xor32_sum(sum); const float inv = 1.0f / sum;
        LAS unsigned char* stg = lds + 3 * BUFB + w * (32 * OST);
#define XA_VSTEP(S_, RL, RS) ld<S_ + 2>(RL, kvr, loff); pv<S_>(O, Pf, lds, lane, hi); st<S_ + 1>(RS, lds, lk, lv); __syncthreads();
#pragma unroll
        for (int dh = 0; dh < 2; ++dh) {
            f32x16 O[4];
#pragma unroll
            for (int dblk = 0; dblk < 4; ++dblk)
#pragma unroll
                for (int r = 0; r < 16; ++r) O[dblk][r] = 0.f;
            if (dh == 0) { XA_VSTEP(8, rA, rB) XA_VSTEP(9, rB, rA) XA_VSTEP(10, rA, rB) XA_VSTEP(11, rB, rA) }
            else         { XA_VSTEP(12, rA, rB) XA_VSTEP(13, rB, rA) XA_VSTEP(14, rA, rB) XA_VSTEP(15, rB, rA) }
            int le = lane; asm volatile("" : "+v"(le));
            const int t32e = le & 31, hie = le >> 5;
#pragma unroll
            for (int db = 0; db < 4; ++db)
#pragma unroll
                for (int rq = 0; rq < 4; ++rq) { u32x2 v; v.x = pk2(O[db][4 * rq] * inv, O[db][4 * rq + 1] * inv); v.y = pk2(O[db][4 * rq + 2] * inv, O[db][4 * rq + 3] * inv);
                    *(LAS u32x2*)(stg + t32e * OST + (db * 32 + 8 * rq + 4 * hie) * 2) = v; }
            LDS_WAIT();
            const int ch = le & 15;
#pragma unroll
            for (int i = 0; i < 8; ++i) { const int row = i * 4 + (le >> 4); const u32x4 v = *(const LAS u32x4*)(stg + row * OST + ch * 16);
                *(u32x4*)(o + (tok0 + row) * D + hd * 256 + dh * 128 + ch * 8) = v; }
            LDS_WAIT();
        }
#undef XA_VSTEP
    }
}


namespace xat2 {
#define XA2_NPARK 7
__device__ __forceinline__ int lane_now() { int l; asm volatile("v_mbcnt_lo_u32_b32 %0, -1, 0\n\tv_mbcnt_hi_u32_b32 %0, -1, %0" : "=v"(l)); return l; }
__device__ __forceinline__ void dma_kv(const char* src0, LAS unsigned char* lds, int w, unsigned gofs) {
#pragma unroll
    for (int i = 0; i < 16; ++i) __builtin_amdgcn_global_load_lds((const unsigned*)(src0 + gofs + (size_t)i * 16 * 4096), (LAS unsigned*)(lds + (w + 8 * i) * 1024), 16, 0, 0);
}
}
__device__ __forceinline__ void phase_xattn2(Frame& F) {
    using namespace xat;
    unsigned char* ws = F.ws; const bf16* q = (const bf16*)(ws + WS_Q); const bf16* kv = (const bf16*)(ws + WS_KV); bf16* o = (bf16*)(ws + WS_O);
    const int w = F.wave; LAS unsigned char* lds = F.lds;
#define XA2_GOFS(L) ((unsigned)(2 * w + ((L) >> 5)) * 4096u + 16u * (unsigned)(((L) & 31) ^ (((2 * (w & 1) + ((L) >> 5)) << 2) | ((w >> 1) & 3))))
    for (int cu = F.bx; cu < 256; cu += F.G) {
        const int bh = cu >> 2, qp = cu & 3, b = bh >> 2, hd = bh & 3;
        const char* kvb = (const char*)(kv + (size_t)b * MEML * 2048 + hd * 256);
        const size_t tokA = (size_t)b * SEQ + 512 * qp + 32 * w;
        int lane = xat2::lane_now();
        xat2::dma_kv(kvb, lds, w, XA2_GOFS(lane));
        lane = xat2::lane_now();
        const int t32 = lane & 31, hi = lane >> 5;
        const int kA = t32 * 512 + ((hi ^ (((t32 & 3) << 2) | ((t32 >> 2) & 3))) << 4);
        f16x8 PfA[8][2], PfB[8][2]; float invA = 0.f, invB = 0.f;
#define XA2_LOADQ(TOK0) { const bf16* qrow = q + ((TOK0) + t32) * D + hd * 256 + 8 * hi; _Pragma("unroll") for (int kk = 0; kk < 16; ++kk) qf[kk] = *(const f16x8*)(qrow + 16 * kk); }
#define XA2_QK(PF, INV) do { \
            float mt[4]; float m = -INFINITY, sum = 0.f; f32x16 S0, S1; _Pragma("unroll") for (int r = 0; r < 16; ++r) { S0[r] = 0.f; S1[r] = 0.f; } \
            XA2_QKT(PF, 0) XA2_QKT(PF, 1) XA2_QKT(PF, 2) XA2_QKT(PF, 3) \
            _Pragma("unroll") for (int t = 0; t < 3; ++t) { const _Float16 f = (_Float16)__builtin_amdgcn_exp2f(mt[t] - m); _Pragma("unroll") for (int sb = 0; sb < 2; ++sb) _Pragma("unroll") for (int sp = 0; sp < 2; ++sp) PF[2 * t + sb][sp] = PF[2 * t + sb][sp] * f; } \
            sum = xor32_sum(sum); INV = 1.0f / sum; } while (0)
#define XA2_RDB(G) { _Pragma("unroll") for (int j = 0; j < XA2_NB; ++j) { const int kk = (G) * XA2_NB + j; kb[(G) & XA2_PIPE][j][0] = *(const LAS f16x8*)(lds + (kAt ^ (32 * kk))); kb[(G) & XA2_PIPE][j][1] = *(const LAS f16x8*)(lds + ((kAt + 32 * 512) ^ (32 * kk))); } }
#define XA2_QKT(PF, T) { int kAt = kA + (64 * (T)) * 512; asm volatile("" : "+v"(kAt)); f16x8 kb[XA2_PIPE + 1][XA2_NB][2]; \
            if (XA2_PIPE) { XA2_RDB(0) } \
            _Pragma("unroll") for (int g = 0; g < 16 / XA2_NB; ++g) { \
                if (XA2_PIPE) { if (g + 1 < 16 / XA2_NB) { XA2_RDB(g + 1) } } else { XA2_RDB(g) } \
                __builtin_amdgcn_sched_barrier(0); \
                _Pragma("unroll") for (int j = 0; j < XA2_NB; ++j) { S0 = SB_MFMA(kb[g & XA2_PIPE][j][0], qf[g * XA2_NB + j], S0); S1 = SB_MFMA(kb[g & XA2_PIPE][j][1], qf[g * XA2_NB + j], S1); } \
                __builtin_amdgcn_sched_barrier(0); } \
            smax<T>(S0, S1, PF, mt, m, sum); __builtin_amdgcn_sched_barrier(0); }
        f16x8 qf[16];
        XA2_LOADQ(tokA);
        asm volatile("s_waitcnt vmcnt(0)" ::: "memory"); __syncthreads();
#define XA2_NB 4
#define XA2_PIPE 1
        XA2_QK(PfA, invA);
#undef XA2_NB
#undef XA2_PIPE
#define XA2_NB 2
#define XA2_PIPE 0
        XA2_LOADQ(tokA + 256);
        u32x4* pscr = (u32x4*)(ws + WS_QCV) + (size_t)cu * XA2_NPARK * NTHREADS + (w * 64 + xat2::lane_now());
#pragma unroll
        for (int i = 0; i < XA2_NPARK; ++i) pscr[i * NTHREADS] = __builtin_bit_cast(u32x4, PfA[i >> 1][i & 1]);
        XA2_QK(PfB, invB);
#undef XA2_NB
#undef XA2_PIPE
#undef XA2_RDB
#undef XA2_QK
#undef XA2_LOADQ
#undef XA2_QKT
        __syncthreads();
        { const int l2 = xat2::lane_now(); xat2::dma_kv(kvb + 2048, lds, w, XA2_GOFS(l2)); }
        asm volatile("s_waitcnt vmcnt(0)" ::: "memory"); __syncthreads();
        const int l3 = xat2::lane_now();
        const int i16 = l3 & 15, q4 = i16 >> 2, p4 = i16 & 3, dhalf = (l3 >> 4) & 1, hi3 = l3 >> 5;
        const int vA = (4 * hi3 + q4) * 512 + ((q4 << 6) | ((((dhalf << 1) | (p4 >> 1)) ^ hi3) << 4) | ((p4 & 1) << 3));
        LAS unsigned char* stg = lds + RING_BYTES + w * 2560;
#define XA2_PV(PF, INV, TOK0) do { _Pragma("unroll") for (int dh = 0; dh < 2; ++dh) { f32x16 O[4]; _Pragma("unroll") for (int db = 0; db < 4; ++db) _Pragma("unroll") for (int r = 0; r < 16; ++r) O[db][r] = 0.f; \
            _Pragma("unroll") for (int T = 0; T < 4; ++T) { int vAt = vA + 64 * T * 512; asm volatile("" : "+v"(vAt)); _Pragma("unroll") for (int db = 0; db < 4; ++db) _Pragma("unroll") for (int sb = 0; sb < 2; ++sb) _Pragma("unroll") for (int sp = 0; sp < 2; ++sp) { \
                const int rows0 = (32 * sb + 16 * sp) * 512, dx = (4 * dh + db) * 64; \
                const s16x4 lo = sbat::vtr(lds + ((vAt + rows0) ^ dx)), h4 = sbat::vtr(lds + ((vAt + rows0 + 8 * 512) ^ dx ^ 32)); \
                const bf16x8 vf = (bf16x8){lo[0], lo[1], lo[2], lo[3], h4[0], h4[1], h4[2], h4[3]}; \
                O[db] = SB_MFMA(__builtin_bit_cast(f16x8, vf), PF[2 * T + sb][sp], O[db]); if (sb == 1 && sp == 1) __builtin_amdgcn_sched_barrier(0); } } \
            const int le = xat2::lane_now(); const int t32e = le & 31, hie = le >> 5; \
            _Pragma("unroll") for (int db = 0; db < 4; ++db) { \
              if (F8_MO) { \
                _Pragma("unroll") for (int rq = 0; rq < 4; ++rq) *(LAS unsigned*)(stg + t32e * 48 + 8 * rq + 4 * hie) = f8x4(O[db][4 * rq] * ((INV) * F8_HSCALE), O[db][4 * rq + 1] * ((INV) * F8_HSCALE), O[db][4 * rq + 2] * ((INV) * F8_HSCALE), O[db][4 * rq + 3] * ((INV) * F8_HSCALE)); \
                LDS_WAIT(); \
                { const int row = le >> 1, hf = le & 1; const u32x4 v = *(const LAS u32x4*)(stg + row * 48 + hf * 16); \
                    *(u32x4*)((unsigned char*)o + ((TOK0) + row) * D + hd * 256 + (4 * dh + db) * 32 + hf * 16) = v; } \
                LDS_WAIT(); \
              } else { \
                _Pragma("unroll") for (int rq = 0; rq < 4; ++rq) { u32x2 v; v.x = pk2(O[db][4 * rq] * (INV), O[db][4 * rq + 1] * (INV)); v.y = pk2(O[db][4 * rq + 2] * (INV), O[db][4 * rq + 3] * (INV)); \
                    *(LAS u32x2*)(stg + t32e * 80 + (8 * rq + 4 * hie) * 2) = v; } \
                LDS_WAIT(); \
                _Pragma("unroll") for (int i = 0; i < 2; ++i) { const int row = (le >> 2) + 16 * i, ch = le & 3; const u32x4 v = *(const LAS u32x4*)(stg + row * 80 + ch * 16); \
                    *(u32x4*)(o + ((TOK0) + row) * D + hd * 256 + (4 * dh + db) * 32 + ch * 8) = v; } \
                LDS_WAIT(); } } } } while (0)
        XA2_PV(PfB, invB, tokA + 256);
#pragma unroll
        for (int i = 0; i < XA2_NPARK; ++i) PfA[i >> 1][i & 1] = __builtin_bit_cast(f16x8, pscr[i * NTHREADS]);
        XA2_PV(PfA, invA, tokA);
#undef XA2_PV
#undef XA2_GOFS
        __syncthreads();
    }
}

__device__ __forceinline__ void phase_gates(Frame& F) {
    unsigned char* ws = F.ws; const bf16* xbp = (const bf16*)(ws + WS_XB); const bf16* wg = (const bf16*)(ws + WS_WIN) + (size_t)NPROJ * D; const float* ssq = (const float*)(ws + WS_SSQ); float* gates = (float*)(ws + WS_GATES);
    const int tid = F.tid, lane = F.lane, w = F.wave, l16 = lane & 15, g = lane >> 4, tpb = NTOK / F.G; LAS unsigned char* lds = F.lds;
    constexpr int WST = 2064;
    for (int e = tid; e < 16 * 128; e += NTHREADS) { const int n = e >> 7, k8 = (e & 127) * 8; u32x4 o_ = (u32x4){0u, 0u, 0u, 0u}; if (n < 8) o_ = *(const u32x4*)(wg + (size_t)n * D + k8); *(LAS u32x4*)(lds + n * WST + k8 * 2) = o_; }
    __syncthreads();
    for (int t0 = w * 16; t0 < tpb; t0 += NWAVES * 16) { const int tokb = F.bx * tpb + t0;
        f32x4 acc = (f32x4){0.f, 0.f, 0.f, 0.f}; const bf16* xrow = xbp + (size_t)(tokb + l16) * D + 8 * g;
#pragma unroll
        for (int kb = 0; kb < 2; ++kb) { f16x8 af[16];
#pragma unroll
            for (int j = 0; j < 16; ++j) af[j] = *(const f16x8*)(xrow + 32 * (16 * kb + j));
#pragma unroll
            for (int j = 0; j < 16; ++j) { const int kk = 16 * kb + j; const f16x8 b0 = *(const LAS f16x8*)(lds + l16 * WST + (32 * kk + 8 * g) * 2); acc = ML_MFMA(af[j], b0, acc); } }
        if (l16 < 8) {
#pragma unroll
            for (int r = 0; r < 4; ++r) gates[(size_t)(tokb + 4 * g + r) * 8 + l16] = acc[r] * pg8::rstd_from_ssq(ssq, tokb + 4 * g + r); } }
    __syncthreads();
}

__device__ __forceinline__ void phase_router1(Frame& F, int l) {
    unsigned char* ws = F.ws; const bf16* xbp = (const bf16*)(ws + WS_XB); const float* wr = (const float*)(ws + WS_WR); const float* ssq = (const float*)(ws + WS_SSQ);
    u32x4* tokinfo = (u32x4*)(ws + WS_TOKINFO); int* cntb = (int*)(ws + WS_CNTB); unsigned char* xq8 = ws + WS_XQ8; const bool f8 = layer_f8(l);
    const int tid = F.tid, lane = F.lane, w = F.wave, l16 = lane & 15, g = lane >> 4, tpb = NTOK / F.G; LAS unsigned char* lds = F.lds;
    constexpr int WST = 2064;
    LAS int* clsL = (LAS int*)(lds + SCR_OFF); LAS float* fL = (LAS float*)(lds + SCR_OFF + 2048); LAS float* lgL = (LAS float*)(lds + 32 * WST) + w * 512;
    for (int e = tid; e < 32 * 128; e += NTHREADS) { const int n = e >> 7, k8 = (e & 127) * 8; u32x4 o_ = (u32x4){0u, 0u, 0u, 0u};
        if (n < 20) { const f32x4 a0 = *(const f32x4*)(wr + n * D + k8), a1 = *(const f32x4*)(wr + n * D + k8 + 4); o_.x = pk2(a0[0], a0[1]); o_.y = pk2(a0[2], a0[3]); o_.z = pk2(a1[0], a1[1]); o_.w = pk2(a1[2], a1[3]); }
        *(LAS u32x4*)(lds + n * WST + k8 * 2) = o_; }
    __syncthreads();
    for (int t0 = w * 16; t0 < tpb; t0 += NWAVES * 16) { const int tokb = F.bx * tpb + t0;
        f32x4 acc0 = (f32x4){0.f, 0.f, 0.f, 0.f}, acc1 = acc0; const bf16* xrow = xbp + (size_t)(tokb + l16) * D + 8 * g;
#pragma unroll
        for (int kb = 0; kb < 4; ++kb) { f16x8 af[8];
#pragma unroll
            for (int j = 0; j < 8; ++j) af[j] = *(const f16x8*)(xrow + 32 * (8 * kb + j));
            if (f8) {
#pragma unroll
                for (int j = 0; j < 8; ++j) { u32x2 o; o.x = f8x4((float)af[j][0], (float)af[j][1], (float)af[j][2], (float)af[j][3]); o.y = f8x4((float)af[j][4], (float)af[j][5], (float)af[j][6], (float)af[j][7]);
                    *(u32x2*)(xq8 + (size_t)(tokb + l16) * D + 32 * (8 * kb + j) + 8 * g) = o; } }
#pragma unroll
            for (int j = 0; j < 8; ++j) { const int kk = 8 * kb + j; const f16x8 b0 = *(const LAS f16x8*)(lds + l16 * WST + (32 * kk + 8 * g) * 2), b1 = *(const LAS f16x8*)(lds + (16 + l16) * WST + (32 * kk + 8 * g) * 2);
                acc0 = ML_MFMA(af[j], b0, acc0); acc1 = ML_MFMA(af[j], b1, acc1); } }
        const float bias0 = wr[20 * D + l16], bias1 = l16 < 4 ? wr[20 * D + 16 + l16] : 0.f;
#pragma unroll
        for (int r = 0; r < 4; ++r) { const float rs = pg8::rstd_from_ssq(ssq, tokb + 4 * g + r); lgL[(4 * g + r) * 32 + l16] = acc0[r] * rs + bias0; lgL[(4 * g + r) * 32 + 16 + l16] = acc1[r] * rs + bias1; }
        LDS_WAIT();
        if (lane < 16) { const LAS float* lp = lgL + lane * 32; const f32x4 lg = *(const LAS f32x4*)lp; const int tok = tokb + lane;
            int gs = 0; float gm = lg[0];
#pragma unroll
            for (int j = 1; j < 4; ++j) if (lg[j] > gm) { gm = lg[j]; gs = j; }
            float gsum = 0.f;
#pragma unroll
            for (int j = 0; j < 4; ++j) gsum += __expf(lg[j] - gm);
            const float psel = 1.f / gsum; const f32x4 es = *(const LAS f32x4*)(lp + 4 + 4 * gs);
            int i0 = 0; float m0 = es[0];
#pragma unroll
            for (int e = 1; e < 4; ++e) if (es[e] > m0) { m0 = es[e]; i0 = e; }
            int i1 = -1; float m1 = -INFINITY;
#pragma unroll
            for (int e = 0; e < 4; ++e) if (e != i0 && es[e] > m1) { m1 = es[e]; i1 = e; }
            const float e1 = __expf(m1 - m0); const float w0 = 1.f / (1.f + e1), w1 = e1 / (1.f + e1);
            const int ea = i0 < i1 ? i0 : i1, eb = i0 < i1 ? i1 : i0; const float ga = psel * (i0 < i1 ? w0 : w1), gb = psel * (i0 < i1 ? w1 : w0);
            const int lt = t0 + lane; clsL[lt] = gs * 6 + pair_index(ea, eb); fL[lt] = ga; fL[tpb + lt] = gb; fL[2 * tpb + lt] = pg8::rstd_from_ssq(ssq, tok); }
        LDS_WAIT(); }
    __syncthreads();
    if (F.tid < tpb) { const int c = clsL[F.tid]; int rank = 0; for (int t = 0; t < F.tid; ++t) rank += (clsL[t] == c) ? 1 : 0;
        tokinfo[F.bx * tpb + F.tid] = (u32x4){(unsigned)c | ((unsigned)rank << 8), __float_as_uint(fL[F.tid]), __float_as_uint(fL[tpb + F.tid]), __float_as_uint(fL[2 * tpb + F.tid])}; }
    if (F.tid >= 256 && F.tid < 256 + 32) { const int c = F.tid - 256; int n = 0; if (c < NCLS) for (int t = 0; t < tpb; ++t) n += (clsL[t] == c) ? 1 : 0; cntb[F.bx * 32 + c] = n; }
}
__device__ __forceinline__ void phase_router2(Frame& F, int l) {
    unsigned char* ws = F.ws; const u32x4* tokinfo = (const u32x4*)(ws + WS_TOKINFO); const int* cntb = (const int*)(ws + WS_CNTB);
    int* tokl = (int*)(ws + WS_SLOT); float* gwa = (float*)(ws + WS_SLOT + SLOT_ARR); float* gwb = (float*)(ws + WS_SLOT + 2 * SLOT_ARR); float* rsl = (float*)(ws + WS_SLOT + 3 * SLOT_ARR);
    const int tpb = NTOK / F.G; LAS int* baseL = (LAS int*)(F.lds + SCR_OFF);
    { const int c = F.tid & 31, part = F.tid >> 5; int acc = 0; for (int b2 = part; b2 < F.bx; b2 += 16) acc += cntb[b2 * 32 + c];
      ((LAS int*)(F.lds + SCR_OFF + 1024))[part * 32 + c] = acc; }
    __syncthreads();
    if (F.tid < 32) { int acc = 0;
#pragma unroll
        for (int part = 0; part < 16; ++part) acc += ((LAS int*)(F.lds + SCR_OFF + 1024))[part * 32 + F.tid]; baseL[F.tid] = acc;
        if (F.bx == F.G - 1 && F.tid < NCLS) F.ctl[CW_CNT + l * 32 + F.tid] = (unsigned)(acc + cntb[F.bx * 32 + F.tid]); }
    __syncthreads();
    if (F.tid < tpb) { const int tok = F.bx * tpb + F.tid; const u32x4 inf = tokinfo[tok]; const int cls = inf.x & 255, rank = inf.x >> 8;
        const size_t o = (size_t)cls * CLSCAP + baseL[cls] + rank; tokl[o] = tok; gwa[o] = __uint_as_float(inf.y); gwb[o] = __uint_as_float(inf.z); rsl[o] = __uint_as_float(inf.w); }
}

__device__ __forceinline__ const char* uni_ptr(const char* p) { const unsigned long long v = (unsigned long long)p; const unsigned lo = __builtin_amdgcn_readfirstlane((unsigned)v), hi = __builtin_amdgcn_readfirstlane((unsigned)(v >> 32)); return (const char*)(((unsigned long long)hi << 32) | lo); }
struct SchedMoe {
    const LAS int* tb; const unsigned* cnt; const char* A; const char* B; const int* tokl; int ncol, G, c, nwg; bool up; int eb;
    __device__ __forceinline__ bool next(int i, pg8::Unit& u) const {
        const long L = (long)i * G + c; if (L >= nwg) return false;
        const int id = pg8::xcd_remap((int)L, nwg); const int rt = id / ncol, ct = id % ncol;
        int cls = 0;
#pragma unroll 1
        for (int k = 1; k < NCLS; ++k) if (rt >= tb[k]) cls = k;
        const int slot0 = (rt - tb[cls]) * 256; const int g = cls / 6, pr = cls % 6;
        const int ea = pr < 3 ? 0 : (pr < 5 ? 1 : 2), eb = pr < 3 ? pr + 1 : (pr < 5 ? pr - 1 : 3);
        u.pm = rt; u.pn = ct; u.cls = cls; u.slot0 = slot0; u.nvalid = (int)cnt[cls] - slot0; u.rows = tokl + (size_t)cls * CLSCAP + slot0;
        if (up) { const int ge = g * 4 + (ct < 4 ? ea : eb); u.a = A; u.b = B + ((size_t)ge * 1024 + (ct & 3) * 256) * (size_t)(D * this->eb); }
        else { u.a = A + (size_t)rt * 256 * 1024 * this->eb; u.b = B + ((size_t)cls * 1024 + ct * 256) * (size_t)(1024 * this->eb); }
        u.a = uni_ptr(u.a); u.b = uni_ptr(u.b); u.rows = (const int*)uni_ptr((const char*)u.rows);
        u.pm = __builtin_amdgcn_readfirstlane(u.pm); u.pn = __builtin_amdgcn_readfirstlane(u.pn); u.cls = __builtin_amdgcn_readfirstlane(u.cls); u.slot0 = __builtin_amdgcn_readfirstlane(u.slot0); u.nvalid = __builtin_amdgcn_readfirstlane(u.nvalid);
        return true;
    }
};

__global__ void __launch_bounds__(NTHREADS, 2) hyb_fwd(Args args) {
    extern __shared__ __attribute__((aligned(16))) unsigned char lds[];
    Frame F;
    F.lds = (LAS unsigned char*)lds; F.MISC = (volatile LAS unsigned*)(F.lds + MISC_OFF);
    F.tid = threadIdx.x; F.lane = F.tid & 63; F.wave = __builtin_amdgcn_readfirstlane(F.tid >> 6); F.G = gridDim.x; F.bx = blockIdx.x;
    F.ws = args.ws; F.ctl = (unsigned*)(args.ws + WS_CTL); F.out = args.out;
    for (int u = F.tid; u < (PTAB_OFF - LDSCTL_OFF) / 4; u += NTHREADS) ((LAS unsigned*)(F.lds + LDSCTL_OFF))[u] = 0u;
    if (F.tid == 0) {
#pragma unroll
        for (int i = 0; i < 26; ++i) ((LAS unsigned long long*)(F.lds + PTAB_OFF))[i] = (unsigned long long)args.in[i]; }
    __syncthreads();
    XcdBarrier bar; bar.bar = F.ctl + CW_BAR; bar.x = 0; bar.st = nullptr;
    const bool one_launch = (args.ph_hi - args.ph_lo) > 1;
    if (one_launch) bar = xcd_barrier_post(F.ctl + CW_BAR, F.MISC + 8);
    const int wave0 = __builtin_amdgcn_readfirstlane((int)threadIdx.x >> 6);
    for (int ph = args.ph_lo; ph < args.ph_hi; ++ph) {
        {
          GAS unsigned char* w_ = (GAS unsigned char*)args.ws; asm volatile("" : "+s"(w_)); F.ws = (unsigned char*)w_; F.ctl = (unsigned*)(F.ws + WS_CTL);
          GAS float* o_ = (GAS float*)args.out; asm volatile("" : "+s"(o_)); F.out = (float*)o_;
          unsigned lb_ = 0; asm volatile("" : "+s"(lb_)); F.lds = (LAS unsigned char*)lds + lb_; F.MISC = (volatile LAS unsigned*)(F.lds + MISC_OFF);
          int g_ = gridDim.x, b_ = blockIdx.x; asm volatile("" : "+s"(g_), "+s"(b_)); F.G = g_; F.bx = b_; }
        unsigned char* ws = F.ws;
        bf16* xb = (bf16*)(ws + WS_XB); float* ssq = (float*)(ws + WS_SSQ);
        const int l = ph / PH_PER_LAYER, p = ph % PH_PER_LAYER;
#define PH_BEGIN() do { int wv_ = wave0; unsigned z_ = 0u; asm volatile("" : "+s"(wv_), "+s"(z_)); F.lane = (int)__builtin_amdgcn_mbcnt_hi(~0u, __builtin_amdgcn_mbcnt_lo(~0u, z_)); F.wave = wv_; F.tid = wv_ * 64 + F.lane; } while (0)
        if (ph == PH_FINAL) {
            PH_BEGIN();
            const float* g = F.in_(25); const int gw = F.bx * NWAVES + F.wave, NGW = F.G * NWAVES;
            for (int m = gw; m < NTOK; m += NGW) { const u32x4* xr = (const u32x4*)(xb + (size_t)m * D) + F.lane; float v[16]; float s_ = 0.f;
#pragma unroll
                for (int j = 0; j < 2; ++j) { const u32x4 q_ = xr[64 * j]; v[8 * j] = bflo(q_.x); v[8 * j + 1] = bfhi(q_.x); v[8 * j + 2] = bflo(q_.y); v[8 * j + 3] = bfhi(q_.y); v[8 * j + 4] = bflo(q_.z); v[8 * j + 5] = bfhi(q_.z); v[8 * j + 6] = bflo(q_.w); v[8 * j + 7] = bfhi(q_.w); }
#pragma unroll
                for (int e = 0; e < 16; ++e) s_ += v[e] * v[e];
                const float r = rsqrtf(wave_sum(s_) * (1.0f / D) + EPS);
#pragma unroll
                for (int j = 0; j < 2; ++j) { const f32x4 g0 = ((const f32x4*)g)[128 * j + 2 * F.lane], g1 = ((const f32x4*)g)[128 * j + 2 * F.lane + 1]; f32x4* op = (f32x4*)(F.out + (size_t)m * D) + 128 * j + 2 * F.lane;
                    op[0] = (f32x4){v[8 * j] * r * g0[0], v[8 * j + 1] * r * g0[1], v[8 * j + 2] * r * g0[2], v[8 * j + 3] * r * g0[3]}; op[1] = (f32x4){v[8 * j + 4] * r * g1[0], v[8 * j + 5] * r * g1[1], v[8 * j + 6] * r * g1[2], v[8 * j + 7] * r * g1[3]}; } }
        } else if (p == 0) {
            PH_BEGIN(); phase_convert(F, l);
        } else if (p == 1) {
            PH_BEGIN();
            if (l > 0) phase_gates(F);
            { pg8::SchedInKv S; S.A = (const char*)xb; S.B = (const char*)(ws + WS_WIN); S.A2 = (const char*)(ws + WS_MEMB); S.B2 = (const char*)(ws + WS_WMKV); S.G = F.G; S.c = F.bx; S.tstep = (size_t)256 * D * 2;
              S.ncol = l > 0 ? 14 : 15; S.nkv = l > 0 ? 0 : 128;
              pg8::EpiScaleBf16 E{(bf16*)(ws + WS_PROJ), NPROJ, ssq, nullptr, (float*)(ws + WS_GATES), 14, (bf16*)(ws + WS_KV), 2048, (const float*)(ws + WS_MEMR)};
              pg8::gemm_phase<pg8::EpiScaleBf16, pg8::SchedInKv, false>(F.lds, F.tid, D, S, E); }
        } else if (p == 2) {
            PH_BEGIN(); phase_mixer(F, l, l, args.mode);
        } else if (p == 3) {
            PH_BEGIN(); phase_ml_scan(F);
        } else if (p == 4) {
            PH_BEGIN();
            X3Pf pf; x3_load(F, F.bx, pf);
            for (int it = F.bx; it < 1024; it += F.G) { Frame G = F;
                { int t_ = F.wave * 64 + pg8::lane_fresh(); G.tid = t_; G.lane = t_ & 63; G.wave = __builtin_amdgcn_readfirstlane(t_ >> 6);
                  unsigned lb_ = 0; asm volatile("" : "+s"(lb_)); G.lds = F.lds + lb_;
                  GAS unsigned char* w_ = (GAS unsigned char*)F.ws; asm volatile("" : "+s"(w_)); G.ws = (unsigned char*)w_; }
                ml_x3(G, l, it, pf, (it + F.G < 1024) ? it + F.G : -1); }
        } else if (p == 5 || p == 8) {
            PH_BEGIN();
            if (p == 8 && F8_MO) { pg8::SchedDense S; S.init(ws + WS_O, ws + WS_WMO, NTOK, D, D / 2, F.G, F.bx);
                pg8::EpiRes<false, true> E{xb, ssq, args.mode == 2};
                pg8::gemm_phase<pg8::EpiRes<false, true>, pg8::SchedDense, false, true>(F.lds, F.tid, D / 2, S, E); }
            else { pg8::SchedDense S; S.init(p == 5 ? ws + WS_Y : ws + WS_O, p == 5 ? ws + WS_WOUT : ws + WS_WMO, NTOK, D, D, F.G, F.bx);
                pg8::EpiRes<false> E{xb, ssq, args.mode == 2, (p == 5 && F8_Q) ? ws + WS_XQ8 : nullptr};
                pg8::gemm_phase<pg8::EpiRes<false>, pg8::SchedDense, false>(F.lds, F.tid, D, S, E); }
        } else if (p == 6) {
            PH_BEGIN();
            if (F8_Q) { pg8::SchedDense S; S.init(ws + WS_XQ8, ws + WS_WMQ, NTOK, D, D / 2, F.G, F.bx);
                pg8::EpiScaleBf16 E{(bf16*)(ws + WS_Q), D, ssq, nullptr, nullptr, 1 << 30, nullptr, 0, nullptr, 1.0f / F8_WSCALE};
                pg8::gemm_phase<pg8::EpiScaleBf16, pg8::SchedDense, false, true>(F.lds, F.tid, D / 2, S, E); }
            else { pg8::SchedDense S; S.init(xb, ws + WS_WMQ, NTOK, D, D, F.G, F.bx);
                pg8::EpiScaleBf16 E{(bf16*)(ws + WS_Q), D, ssq, nullptr, nullptr, 1 << 30, nullptr, 0, nullptr};
                pg8::gemm_phase<pg8::EpiScaleBf16, pg8::SchedDense, false>(F.lds, F.tid, D, S, E); }
        } else if (p == 7) {
            PH_BEGIN(); phase_xattn2(F);
        } else if (p == 9) {
            PH_BEGIN(); phase_router1(F, l);
        } else if (p == 10) {
            PH_BEGIN(); phase_router2(F, l);
        } else {
            PH_BEGIN();
            LAS int* tb = (LAS int*)(F.lds + SCR_OFF); const unsigned* cnt = F.ctl + CW_CNT + l * 32;
            __syncthreads();
            if (F.tid == 0) { int acc = 0; for (int k = 0; k < NCLS; ++k) { tb[k] = acc; acc += ((int)__hip_atomic_load(cnt + k, RLX_AGENT) + 255) >> 8; } tb[NCLS] = acc; }
            __syncthreads();
            SchedMoe S; S.tb = tb; S.cnt = cnt; S.tokl = (const int*)(ws + WS_SLOT); S.G = F.G; S.c = F.bx; S.up = (p == 11);
            const bool f8 = layer_f8(l); S.eb = f8 ? 1 : 2;
            if (p == 11) { S.ncol = 8; S.nwg = tb[NCLS] * 8; S.A = f8 ? (const char*)(ws + WS_XQ8) : (const char*)xb; S.B = (const char*)(ws + WS_W13);
                if (f8) { pg8::EpiMoe1<true> E{(bf16*)(ws + WS_HID), (const float*)(ws + WS_SLOT + 3 * SLOT_ARR), (const float*)(ws + WS_SLOT + SLOT_ARR), (const float*)(ws + WS_SLOT + 2 * SLOT_ARR)};
                    pg8::gemm_phase<pg8::EpiMoe1<true>, SchedMoe, true, true>(F.lds, F.tid, D / 2, S, E); }
                else { pg8::EpiMoe1<false> E{(bf16*)(ws + WS_HID), (const float*)(ws + WS_SLOT + 3 * SLOT_ARR), (const float*)(ws + WS_SLOT + SLOT_ARR), (const float*)(ws + WS_SLOT + 2 * SLOT_ARR)};
                    pg8::gemm_phase<pg8::EpiMoe1<false>, SchedMoe, true, false>(F.lds, F.tid, D, S, E); } }
            else { S.ncol = 4; S.nwg = tb[NCLS] * 4; S.A = (const char*)(ws + WS_HID); S.B = (const char*)(ws + WS_W2C);
                if (f8) { pg8::EpiRes<true, true> E{xb, ssq, args.mode == 2}; pg8::gemm_phase<pg8::EpiRes<true, true>, SchedMoe, false, true>(F.lds, F.tid, 512, S, E); }
                else { pg8::EpiRes<true, false> E{xb, ssq, args.mode == 2}; pg8::gemm_phase<pg8::EpiRes<true, false>, SchedMoe, false, false>(F.lds, F.tid, 1024, S, E); }
                if (l + 1 < DEPTH) {
                    pg8::SchedKv K; K.A2 = (const char*)(ws + WS_MEMB8); K.B2 = (const char*)(ws + (((l + 1) & 1) ? WS_WMKV2 : WS_WMKV)); K.G = F.G; K.c = F.bx; K.tstep = (size_t)256 * D;
                    pg8::EpiScaleBf16 EK{nullptr, 0, ssq, nullptr, nullptr, 14, (bf16*)(ws + WS_KV), 2048, (const float*)(ws + WS_MEMR), 1.0f / F8_WSCALE};
                    int t2 = F.tid; asm volatile("" : "+v"(t2));
                    pg8::gemm_phase<pg8::EpiScaleBf16, pg8::SchedKv, false, true>(F.lds, t2, D / 2, K, EK); } }
            __syncthreads();
        }
        if (ph + 1 < args.ph_hi) xcd_barrier(bar);
    }
}

extern "C" void kernel_launch(void* const* d_in, const int* in_sizes, int n_in, void* d_out, int out_size, void* d_ws, size_t ws_size, hipStream_t stream) {
    static int grid = 0;
    if (grid == 0) {
        if (n_in != 26 || in_sizes[0] != NTOK * D || out_size != NTOK * D || ws_size < WS_END) { fprintf(stderr, "kernel_launch: unexpected shapes (n_in %d, in0 %d, out %d, ws %zu, need %zu); nothing launched\n", n_in, n_in > 0 ? in_sizes[0] : -1, out_size, ws_size, (size_t)WS_END); grid = -1; return; }
        int dev = 0, cus = 0;
        if (hipGetDevice(&dev) != hipSuccess || hipDeviceGetAttribute(&cus, hipDeviceAttributeMultiprocessorCount, dev) != hipSuccess) { grid = -1; return; }
        if (hipFuncSetAttribute((const void*)hyb_fwd, hipFuncAttributeMaxDynamicSharedMemorySize, LDS_BYTES) != hipSuccess) { fprintf(stderr, "kernel_launch: hipFuncSetAttribute failed\n"); grid = -1; return; }
        int per_cu = 0;
        if (hipOccupancyMaxActiveBlocksPerMultiprocessor(&per_cu, (const void*)hyb_fwd, NTHREADS, LDS_BYTES) != hipSuccess || per_cu < 1) fprintf(stderr, "kernel_launch: occupancy query reports %d\n", per_cu);
        (void)hipGetLastError();
        grid = cus >= 256 ? 256 : (cus >= 128 ? 128 : 64);
    }
    if (grid < 0) return;
    (void)hipMemsetAsync((char*)d_ws + WS_CTL, 0, CTL_ZERO_BYTES, stream);
    Args a{};
    for (int i = 0; i < 26; ++i) a.in[i] = (const float*)d_in[i];
    a.out = (float*)d_out; a.ws = (unsigned char*)d_ws;
#if MK_N_LAUNCHES == 1
    a.ph_lo = 0; a.ph_hi = N_PHASES;
    hipLaunchKernelGGL(hyb_fwd, dim3(grid), dim3(NTHREADS), LDS_BYTES, stream, a);
#else
    for (int ph = 0; ph < N_PHASES; ++ph) {
        a.ph_lo = ph; a.ph_hi = ph + 1; hipLaunchKernelGGL(hyb_fwd, dim3(grid), dim3(NTHREADS), LDS_BYTES, stream, a);
        if (MK_REPEAT_P >= 0 && ph != PH_FINAL && ph % PH_PER_LAYER == MK_REPEAT_P) {
            if (MK_REPEAT_P == 2) (void)hipMemsetD32Async((hipDeviceptr_t)((char*)d_ws + WS_CTL + (CW_Q + ph / PH_PER_LAYER) * 4), MK_PROBE_QSTART, 1, stream);
            a.mode = MK_PROBE_MODE; hipLaunchKernelGGL(hyb_fwd, dim3(grid), dim3(NTHREADS), LDS_BYTES, stream, a); a.mode = 0; } }
#endif
}
```

```cpp
#include <hip/hip_runtime.h>
#include <cstdio>
#include <cstdint>

#ifndef MK_N_LAUNCHES
#define MK_N_LAUNCHES 1
#endif

#ifndef MK_PROBE_QSTART
#define MK_PROBE_QSTART 0
#endif
#ifndef MK_PROBE_MODE
#define MK_PROBE_MODE 0
#endif
#ifndef MK_REPEAT_P
#define MK_REPEAT_P (-1)
#endif
#define LAS __attribute__((address_space(3)))
#define GAS __attribute__((address_space(1)))
typedef unsigned short bf16;
typedef short bf16x8 __attribute__((ext_vector_type(8)));
typedef float f32x4 __attribute__((ext_vector_type(4)));
typedef float f32x2 __attribute__((ext_vector_type(2)));
typedef unsigned u32x4 __attribute__((ext_vector_type(4)));
typedef unsigned u32x2 __attribute__((ext_vector_type(2)));

constexpr int D = 1024, BATCH = 16, SEQ = 2048, DEPTH = 4, NTOK = BATCH * SEQ, MEML = 256, NMEM = BATCH * MEML;
constexpr int MLH = 4, DH = 128, MLW = 512, DIN = 3592, NPROJ = 3584, NINP = 3840;
constexpr int XAH = 4, XAD = 256, NG = 4, NE = 4, DEXP = 512, NCLS = 24, CLSCAP = NTOK;
constexpr float EPS = 1e-6f;
constexpr int NWAVES = 8, NTHREADS = 512;
constexpr int PH_PER_LAYER = 13, PH_FINAL = DEPTH * PH_PER_LAYER, N_PHASES = PH_FINAL + 1;

constexpr size_t MiB = 1u << 20;
constexpr size_t WS_CTL = 0, CTL_ZERO_BYTES = 64 * 1024;
constexpr size_t WS_WR = 1 * MiB;
constexpr size_t WS_WIN = 2 * MiB;
constexpr size_t WS_WOUT = WS_WIN + (size_t)NINP * D * 2;
constexpr size_t WS_WMQ = WS_WOUT + 2 * MiB;
constexpr size_t WS_WMKV = WS_WMQ + 2 * MiB;
constexpr size_t WS_WMO = WS_WMKV + 4 * MiB;
constexpr size_t WS_W13 = WS_WMO + 2 * MiB;
constexpr size_t WS_W2C = WS_W13 + 32 * MiB;
constexpr size_t WS_XB = WS_W2C + 48 * MiB;
constexpr size_t WS_SSQ = WS_XB + 64 * MiB;
constexpr size_t WS_MEMB = WS_SSQ + 2 * MiB;
constexpr size_t WS_MEMR = WS_MEMB + 8 * MiB;
constexpr size_t WS_TOKINFO = WS_MEMR + 64 * 1024, WS_CNTB = WS_MEMR + 640 * 1024;
constexpr size_t WS_KV = WS_MEMR + 1 * MiB;
constexpr size_t WS_GATES = WS_KV + 16 * MiB;
constexpr size_t WS_Y = WS_GATES + 1 * MiB;
constexpr size_t WS_SLOT = WS_Y + 64 * MiB;
constexpr size_t SLOT_ARR = (size_t)NCLS * CLSCAP * 4;
constexpr size_t WS_PROJ = WS_SLOT + 4 * SLOT_ARR;
constexpr size_t WS_Q = WS_PROJ, WS_O = WS_PROJ + 64 * MiB, WS_HID = WS_PROJ + 128 * MiB;
constexpr size_t WS_QCV = WS_PROJ + (size_t)NTOK * NPROJ * 2;
constexpr size_t WS_KCV = WS_QCV + 32 * MiB, WS_DC = WS_KCV + 32 * MiB, WS_CPREV = WS_DC + 32 * MiB, WS_GBUF = WS_CPREV + 32 * MiB;
constexpr size_t WS_DN = WS_GBUF + 2 * MiB, WS_NPREV = WS_DN + 512 * 1024, WS_SCAL = WS_NPREV + 512 * 1024;
constexpr size_t WS_END = WS_SCAL + 64 * 1024;
constexpr size_t WS_WMKV2 = WS_W13 + 16 * MiB;
constexpr size_t WS_MEMB8 = WS_WMKV2 + 4 * MiB;
constexpr size_t WS_XQ8 = WS_QCV;
static_assert(WS_HID + (size_t)(128 + NCLS) * 256 * 1024 * 2 <= WS_END, "hidden overlay fits in proj");
constexpr int CW_TMO = 0, CW_CODE = 1, CW_BAR = 4096, CW_CNT = 8192, CW_Q = 8192 + 256;

constexpr int LDS_BYTES = 163840;
constexpr int RING_BYTES = 131072, SCR_OFF = RING_BYTES, LDSCTL_OFF = LDS_BYTES - 1024, MISC_OFF = LDSCTL_OFF + 320, PTAB_OFF = LDSCTL_OFF + 512;

#define RLX_AGENT __ATOMIC_RELAXED, __HIP_MEMORY_SCOPE_AGENT
typedef _Float16 f16x2 __attribute__((ext_vector_type(2)));
typedef _Float16 f16x8 __attribute__((ext_vector_type(8)));
__device__ __forceinline__ unsigned f2bf(float f) { return (unsigned)__builtin_bit_cast(unsigned short, (_Float16)f); }
__device__ __forceinline__ unsigned pk2(float lo, float hi) { const f32x2 v = {lo, hi}; return __builtin_bit_cast(unsigned, __builtin_convertvector(v, f16x2)); }
__device__ __forceinline__ float bf2f(unsigned short b) { return (float)__builtin_bit_cast(_Float16, b); }
__device__ __forceinline__ float bflo(unsigned w) { return (float)__builtin_bit_cast(_Float16, (unsigned short)(w & 0xffffu)); }
__device__ __forceinline__ float bfhi(unsigned w) { return (float)__builtin_bit_cast(_Float16, (unsigned short)(w >> 16)); }
#define DPPF(old_, src_, ctrl_, rm_) __builtin_bit_cast(float, __builtin_amdgcn_update_dpp(__builtin_bit_cast(int, (float)(old_)), __builtin_bit_cast(int, (float)(src_)), (ctrl_), (rm_), 0xF, false))
__device__ __forceinline__ float wave_sum(float v) {
    v += DPPF(0.f, v, 0xB1, 0xF); v += DPPF(0.f, v, 0x4E, 0xF); v += DPPF(0.f, v, 0x141, 0xF); v += DPPF(0.f, v, 0x140, 0xF);
    v += DPPF(0.f, v, 0x142, 0xA); v += DPPF(0.f, v, 0x143, 0xC);
    return __builtin_bit_cast(float, __builtin_amdgcn_readlane(__builtin_bit_cast(int, v), 63));
}
__device__ __forceinline__ float wave_max(float v) {
    v = fmaxf(v, DPPF(v, v, 0xB1, 0xF)); v = fmaxf(v, DPPF(v, v, 0x4E, 0xF)); v = fmaxf(v, DPPF(v, v, 0x141, 0xF)); v = fmaxf(v, DPPF(v, v, 0x140, 0xF));
    v = fmaxf(v, DPPF(v, v, 0x142, 0xA)); v = fmaxf(v, DPPF(v, v, 0x143, 0xC));
    return __builtin_bit_cast(float, __builtin_amdgcn_readlane(__builtin_bit_cast(int, v), 63));
}
__device__ __forceinline__ float xor16_sum(float x) { auto s = __builtin_amdgcn_permlane16_swap(__float_as_uint(x), __float_as_uint(x), false, false); return __uint_as_float(s[0]) + __uint_as_float(s[1]); }
__device__ __forceinline__ float xor32_sum(float x) { auto t = __builtin_amdgcn_permlane32_swap(__float_as_uint(x), __float_as_uint(x), false, false); return __uint_as_float(t[0]) + __uint_as_float(t[1]); }
__device__ __forceinline__ float bperm(int srclane, float v) { return __builtin_bit_cast(float, __builtin_amdgcn_ds_bpermute(srclane << 2, __builtin_bit_cast(int, v))); }
__device__ __forceinline__ float softplusf(float z) { return fmaxf(z, 0.f) + 0.6931471805599453f * __builtin_amdgcn_logf(1.0f + __builtin_amdgcn_exp2f(-1.4426950408889634f * fabsf(z))); }
__device__ __forceinline__ float siluf(float a) { return a * __builtin_amdgcn_rcpf(1.f + __builtin_amdgcn_exp2f(-1.4426950408889634f * a)); }
__device__ __forceinline__ float sigmf(float a) { return __builtin_amdgcn_rcpf(1.f + __builtin_amdgcn_exp2f(-1.4426950408889634f * a)); }

namespace pg8 {
constexpr int BM = 256, BK = 64, HALF = 128, HTB = HALF * BK * 2, STAGE_BYTES = 8 * HTB, NXCD = 8, WGM = 8;
__host__ __device__ __forceinline__ int lds_byte(int r, int c) { const int st = (r >> 4) * 2 + (c >> 5), rr = r & 15, cc = c & 31, ob = rr * 64 + cc * 2; return st * 1024 + (ob ^ (((ob >> 9) & 1) << 5)); }
__host__ __device__ __forceinline__ void stage_rc(int b, int& R, int& C) { const int st = b / 1024, sb = b % 1024, swz = sb ^ (((sb >> 9) & 1) << 5); R = (st >> 1) * 16 + swz / 64; C = (st & 1) * 32 + (swz % 64) / 2; }
__host__ __device__ __forceinline__ int perm32(int rho) { const int n = rho >> 4, i = rho & 15; return 8 * (i >> 2) + 4 * n + (i & 3); }

struct Unit { int pm, pn; const char* a; const char* b; const int* rows; int nvalid; int cls; int slot0; };

__device__ __forceinline__ unsigned cvt_pk_bf16(float lo, float hi) { return pk2(lo, hi); }
__device__ __forceinline__ int lane_fresh() { int l; asm volatile("v_mbcnt_lo_u32_b32 %0, -1, 0\n\tv_mbcnt_hi_u32_b32 %0, -1, %0" : "=v"(l)); return l; }
#ifndef FP8_FROM
#define FP8_FROM 0
#endif
#ifndef F8_MO
#define F8_MO 1
#endif
#ifndef F8_Q
#define F8_Q 1
#endif
static_assert(FP8_FROM == 0, "WS_WMKV2 lives in the half of WS_W13 that only the fp8 expert weights leave free");
constexpr float F8_WSCALE = 64.0f, F8_HSCALE = 16.0f;
__device__ __forceinline__ float f8clamp(float x) { return __builtin_amdgcn_fmed3f(x, -448.0f, 448.0f); }
__device__ __forceinline__ unsigned f8x4(float a, float b, float c, float d) { int v = __builtin_amdgcn_cvt_pk_fp8_f32(f8clamp(a), f8clamp(b), 0, false); v = __builtin_amdgcn_cvt_pk_fp8_f32(f8clamp(c), f8clamp(d), v, true); return (unsigned)v; }
__device__ __forceinline__ bool layer_f8(int l) { return FP8_FROM <= 0 ? true : (FP8_FROM >= DEPTH ? false : l >= FP8_FROM); }

__device__ __forceinline__ int xcd_remap(int L, int nwg) { const int q = nwg / NXCD, r = nwg % NXCD, xcd = L % NXCD, off = L / NXCD; return (xcd < r ? xcd * (q + 1) : r * (q + 1) + (xcd - r) * q) + off; }

struct SchedInKv {
    const char* A; const char* B; const char* A2; const char* B2; int G, c; size_t tstep; int ncol, nkv;
    __device__ __forceinline__ bool next(int i, Unit& u) const {
        const int nin = 128 * ncol;
        const long L = (long)i * G + c; if (L >= nin + nkv) return false;
        u.rows = nullptr; u.nvalid = 256; u.slot0 = 0;
        if (L < nin) { const int wgid = xcd_remap((int)L, nin); const int nig = WGM * ncol, gid = wgid / nig, fm = gid * WGM;
            u.pm = fm + ((wgid % nig) % WGM); u.pn = (wgid % nig) / WGM; u.a = A + (size_t)u.pm * tstep; u.b = B + (size_t)u.pn * tstep; u.cls = 0; }
        else { const int id = (int)L - nin; u.pm = id >> 3; u.pn = id & 7; u.a = A2 + (size_t)u.pm * tstep; u.b = B2 + (size_t)u.pn * tstep; u.cls = 1; }
        return true;
    }
};
struct SchedKv {
    const char* A2; const char* B2; int G, c; size_t tstep;
    __device__ __forceinline__ bool next(int i, Unit& u) const {
        const long L = (long)i * G + (G - 1 - c); if (L >= 128) return false;
        const int id = (int)L; u.pm = id >> 3; u.pn = id & 7; u.a = A2 + (size_t)u.pm * tstep; u.b = B2 + (size_t)u.pn * tstep; u.cls = 1; u.rows = nullptr; u.nvalid = 256; u.slot0 = 0; return true;
    }
};
struct SchedDense {
    const char* A; const char* B; int nM, nN, nwg, G, c; size_t tstep;
    __device__ void init(const void* A_, const void* B_, int M, int N, int K, int G_, int c_) { A = (const char*)A_; B = (const char*)B_; nM = M / BM; nN = N / BM; nwg = nM * nN; G = G_; c = c_; tstep = (size_t)BM * K * 2; }
    __device__ __forceinline__ bool next(int i, Unit& u) const {
        const long L = (long)i * G + c; if (L >= nwg) return false;
        const int wgid = xcd_remap((int)L, nwg);
        const int nig = WGM * nN, gid = wgid / nig, fm = gid * WGM, gsz = (nM - fm) < WGM ? (nM - fm) : WGM;
        u.pm = fm + ((wgid % nig) % gsz); u.pn = (wgid % nig) / gsz;
        u.a = A + (size_t)u.pm * tstep; u.b = B + (size_t)u.pn * tstep; u.rows = nullptr; u.nvalid = 256; u.cls = 0; u.slot0 = 0; return true;
    }
};

typedef int v8i_t __attribute__((ext_vector_type(8)));
typedef int i32x4_t __attribute__((ext_vector_type(4)));
template <class Epi, class Sched, bool GATHER, bool F8 = false>
__device__ __forceinline__ void gemm_phase(LAS unsigned char* lds, const int tid, const int K, const Sched& S, const Epi& E) {
    const int wid = __builtin_amdgcn_readfirstlane(tid >> 6), lane = tid & 63, wr = wid >> 2, wc = wid & 3, fr = lane & 15, fq = lane >> 4;
    const int nt = K / BK;
    unsigned voffB[2], va[2][2];
#pragma unroll
    for (int i = 0; i < 2; ++i) { int R, C; stage_rc(tid * 16 + i * 8192, R, C); const int Rb = Epi::PERM ? ((R & ~31) + perm32(R & 31)) : R;
        voffB[i] = (unsigned)(Rb * K + C) * 2u; va[0][i] = (unsigned)(R * K + C) * 2u; va[1][i] = (unsigned)((R + HALF) * K + C) * 2u; }
    const size_t kstep = (size_t)(BK * 2);
    const size_t hstep = (size_t)HALF * K * 2;
    const unsigned ldsw = (unsigned)wid * 1024u;
    const int aoff = lds_byte(wr * 64 + fr, fq * 8), boff = lds_byte(wc * 32 + fr, fq * 8);
#define PG8_SA(b, h) (((b) * 2 + (h)) * HTB)
#define PG8_SB(b, h) ((4 + (b) * 2 + (h)) * HTB)
#define PG8_STAGEB(bufoff, gbase) do { if constexpr (F8) { const __amdgpu_buffer_rsrc_t _r = __builtin_amdgcn_make_buffer_rsrc((void*)(gbase), 0, 0x7fffffff, 0x00020000); _Pragma("unroll") for (int _i = 0; _i < 2; ++_i) \
        __builtin_amdgcn_raw_ptr_buffer_load_lds(_r, (LAS void*)(lds + (bufoff) + ldsw + _i * 8192), 16, (int)voffB[_i], 0, 0, 0); } else { _Pragma("unroll") for (int _i = 0; _i < 2; ++_i) \
        __builtin_amdgcn_global_load_lds((const unsigned*)((const char*)(gbase) + voffB[_i]), (LAS unsigned*)(lds + (bufoff) + ldsw + _i * 8192), 16, 0, 0); } } while (0)
#define PG8_STAGEA(bufoff, gbase, h) do { if constexpr (F8) { const __amdgpu_buffer_rsrc_t _r = __builtin_amdgcn_make_buffer_rsrc((void*)(gbase), 0, 0x7fffffff, 0x00020000); _Pragma("unroll") for (int _i = 0; _i < 2; ++_i) \
        __builtin_amdgcn_raw_ptr_buffer_load_lds(_r, (LAS void*)(lds + (bufoff) + ldsw + _i * 8192), 16, (int)va[h][_i], 0, 0, 0); } else { _Pragma("unroll") for (int _i = 0; _i < 2; ++_i) \
        __builtin_amdgcn_global_load_lds((const unsigned*)((const char*)(gbase) + va[h][_i]), (LAS unsigned*)(lds + (bufoff) + ldsw + _i * 8192), 16, 0, 0); } } while (0)
#define PG8_LDA(dst, b, h) do { _Pragma("unroll") for (int m = 0; m < 4; ++m) _Pragma("unroll") for (int k = 0; k < 2; ++k) dst[m][k] = *(const LAS bf16x8*)(lds + PG8_SA(b, h) + aoff + m * 2048 + k * 1024); } while (0)
#define PG8_LDB(dst, b, h) do { _Pragma("unroll") for (int n = 0; n < 2; ++n) _Pragma("unroll") for (int k = 0; k < 2; ++k) dst[n][k] = *(const LAS bf16x8*)(lds + PG8_SB(b, h) + boff + n * 2048 + k * 1024); } while (0)
#define PG8_MMA(ai, bj, At, Bt) do { __builtin_amdgcn_s_setprio(1); _Pragma("unroll") for (int m = 0; m < 4; ++m) _Pragma("unroll") for (int n = 0; n < 2; ++n) { \
        if constexpr (F8) { const v8i_t fb = __builtin_shufflevector(__builtin_bit_cast(i32x4_t, Bt[n][0]), __builtin_bit_cast(i32x4_t, Bt[n][1]), 0, 1, 2, 3, 4, 5, 6, 7), fa = __builtin_shufflevector(__builtin_bit_cast(i32x4_t, At[m][0]), __builtin_bit_cast(i32x4_t, At[m][1]), 0, 1, 2, 3, 4, 5, 6, 7); \
            acc[ai][bj][m][n] = __builtin_amdgcn_mfma_scale_f32_16x16x128_f8f6f4(fb, fa, acc[ai][bj][m][n], 0, 0, 0, 0x7f7f7f7f, 0, 0x7f7f7f7f); } \
        else { _Pragma("unroll") for (int k = 0; k < 2; ++k) acc[ai][bj][m][n] = __builtin_amdgcn_mfma_f32_16x16x32_f16(__builtin_bit_cast(f16x8, Bt[n][k]), __builtin_bit_cast(f16x8, At[m][k]), acc[ai][bj][m][n], 0, 0, 0); } } \
        __builtin_amdgcn_s_setprio(0); } while (0)
#define PG8_LDA8(dst, b, h, m0) do { _Pragma("unroll") for (int m = 0; m < 2; ++m) _Pragma("unroll") for (int k = 0; k < 2; ++k) dst[m][k] = *(const LAS bf16x8*)(lds + PG8_SA(b, h) + aoff + ((m0) + m) * 2048 + k * 1024); } while (0)
#define PG8_MMA8(ai, mm, Am, B0_, B1_) do { _Pragma("unroll") for (int bj = 0; bj < 2; ++bj) _Pragma("unroll") for (int n = 0; n < 2; ++n) { \
        const v8i_t fb = bj ? __builtin_shufflevector(__builtin_bit_cast(i32x4_t, B1_[n][0]), __builtin_bit_cast(i32x4_t, B1_[n][1]), 0, 1, 2, 3, 4, 5, 6, 7) : __builtin_shufflevector(__builtin_bit_cast(i32x4_t, B0_[n][0]), __builtin_bit_cast(i32x4_t, B0_[n][1]), 0, 1, 2, 3, 4, 5, 6, 7); \
        const v8i_t fa = __builtin_shufflevector(__builtin_bit_cast(i32x4_t, Am[0]), __builtin_bit_cast(i32x4_t, Am[1]), 0, 1, 2, 3, 4, 5, 6, 7); \
        acc[ai][bj][mm][n] = __builtin_amdgcn_mfma_scale_f32_16x16x128_f8f6f4(fb, fa, acc[ai][bj][mm][n], 0, 0, 0, 0x7f7f7f7f, 0, 0x7f7f7f7f); } } while (0)
#define PG8_PHASE8(ai, b, h) do { PG8_WAIT_L(0); PG8_BAR; __builtin_amdgcn_s_setprio(1); PG8_MMA8(ai, 0, At[0], B0, B1); PG8_SCHED; { _Pragma("unroll") for (int k = 0; k < 2; ++k) At[0][k] = *(const LAS bf16x8*)(lds + PG8_SA(b, h) + aoff + 2 * 2048 + k * 1024); } PG8_SCHED; \
        PG8_MMA8(ai, 1, At[1], B0, B1); PG8_SCHED; { _Pragma("unroll") for (int k = 0; k < 2; ++k) At[1][k] = *(const LAS bf16x8*)(lds + PG8_SA(b, h) + aoff + 3 * 2048 + k * 1024); } PG8_SCHED; \
        PG8_MMA8(ai, 2, At[0], B0, B1); PG8_MMA8(ai, 3, At[1], B0, B1); __builtin_amdgcn_s_setprio(0); PG8_WAIT_L(0); PG8_BAR; PG8_SCHED; } while (0)
#define PG8_WAIT_V(n) asm volatile("s_waitcnt vmcnt(" #n ")" ::: "memory")
#define PG8_WAIT_L(n) asm volatile("s_waitcnt lgkmcnt(" #n ")" ::: "memory")
#define PG8_BAR __builtin_amdgcn_s_barrier()
#define PG8_SCHED __builtin_amdgcn_sched_barrier(0)
#define PG8_LOADVA(u, dst) do { int _t = tid; asm volatile("" : "+v"(_t)); _Pragma("unroll") for (int _i = 0; _i < 2; ++_i) { int _R, _C; stage_rc(_t * 16 + _i * 8192, _R, _C); \
        _Pragma("unroll") for (int _h = 0; _h < 2; ++_h) { const int _s = _h * HALF + _R; \
        const int _r = (_s < (u).nvalid) ? (u).rows[_s] : 0; dst[_h][_i] = (unsigned)(_r * K + _C) * 2u; } } } while (0)
    Unit cur, nxt; int ui = 0;
    if (!S.next(0, cur)) return;
    f32x4 acc[2][2][4][2];
#pragma unroll
    for (int a = 0; a < 2; ++a)
#pragma unroll
        for (int b = 0; b < 2; ++b)
#pragma unroll
            for (int m = 0; m < 4; ++m)
#pragma unroll
                for (int n = 0; n < 2; ++n) acc[a][b][m][n] = (f32x4){0.f, 0.f, 0.f, 0.f};
    bf16x8 At[F8 ? 2 : 4][2], B0[2][2], B1[2][2];
    const char* cA = cur.a; const char* cB = cur.b;
    if constexpr (GATHER) { PG8_LOADVA(cur, va); }
    PG8_STAGEB(PG8_SB(0, 0), cB); PG8_STAGEB(PG8_SB(0, 1), cB + hstep); PG8_STAGEA(PG8_SA(0, 0), cA, 0); PG8_STAGEA(PG8_SA(0, 1), cA, 1);
    if (wr == 1) PG8_BAR;
    PG8_WAIT_V(2); PG8_BAR;
    PG8_STAGEB(PG8_SB(1, 0), cB + kstep); PG8_STAGEA(PG8_SA(1, 0), cA + kstep, 0); PG8_STAGEB(PG8_SB(1, 1), cB + hstep + kstep);
    PG8_WAIT_V(6); PG8_BAR;
    for (;;) {
        const bool has_next = S.next(ui + 1, nxt);
        const char* nA = has_next ? nxt.a : cA; const char* nB = has_next ? nxt.b : cB;
#pragma unroll 1
        for (int t = 0; t < nt; t += 2) {
            const bool last = (t == nt - 2);
            const char* a1 = cA + (size_t)(t + 1) * kstep;
            const char* a2 = last ? nA : cA + (size_t)(t + 2) * kstep; const char* b2 = last ? nB : cB + (size_t)(t + 2) * kstep;
            const char* a3 = a2 + kstep; const char* b3 = b2 + kstep;
            if constexpr (F8) {
            PG8_LDB(B0, 0, 0); PG8_LDB(B1, 0, 1); PG8_SCHED; PG8_LDA8(At, 0, 0, 0); PG8_STAGEA(PG8_SA(1, 1), a1, 1);
            if constexpr (GATHER) { if (last && has_next) { PG8_LOADVA(nxt, va); } }
            PG8_WAIT_V(8); PG8_PHASE8(0, 0, 0);
            PG8_LDA8(At, 0, 1, 0); PG8_STAGEB(PG8_SB(0, 0), b2); PG8_STAGEB(PG8_SB(0, 1), b2 + hstep); PG8_STAGEA(PG8_SA(0, 0), a2, 0);
            PG8_WAIT_V(8); PG8_PHASE8(1, 0, 1);
            PG8_LDB(B0, 1, 0); PG8_LDB(B1, 1, 1); PG8_SCHED; PG8_LDA8(At, 1, 0, 0); PG8_STAGEA(PG8_SA(0, 1), a2, 1);
            PG8_WAIT_V(8); PG8_PHASE8(0, 1, 0);
            PG8_LDA8(At, 1, 1, 0); PG8_STAGEB(PG8_SB(1, 0), b3); PG8_STAGEB(PG8_SB(1, 1), b3 + hstep); PG8_STAGEA(PG8_SA(1, 0), a3, 0);
            PG8_WAIT_V(8); PG8_PHASE8(1, 1, 1);
            } else {
            PG8_LDB(B0, 0, 0); PG8_LDB(B1, 0, 1); PG8_SCHED; PG8_LDA(At, 0, 0); PG8_STAGEA(PG8_SA(1, 1), a1, 1);
            if constexpr (GATHER) { if (last && has_next) { PG8_LOADVA(nxt, va); } }
            PG8_WAIT_V(8); PG8_WAIT_L(0); PG8_BAR; PG8_MMA(0, 0, At, B0); PG8_MMA(0, 1, At, B1); PG8_BAR; PG8_SCHED;
            PG8_LDA(At, 0, 1); PG8_STAGEB(PG8_SB(0, 0), b2); PG8_STAGEB(PG8_SB(0, 1), b2 + hstep); PG8_STAGEA(PG8_SA(0, 0), a2, 0);
            PG8_WAIT_V(8); PG8_WAIT_L(0); PG8_BAR; PG8_MMA(1, 0, At, B0); PG8_MMA(1, 1, At, B1); PG8_BAR; PG8_SCHED;
            PG8_LDB(B0, 1, 0); PG8_LDB(B1, 1, 1); PG8_SCHED; PG8_LDA(At, 1, 0); PG8_STAGEA(PG8_SA(0, 1), a2, 1);
            PG8_WAIT_V(8); PG8_WAIT_L(0); PG8_BAR; PG8_MMA(0, 0, At, B0); PG8_MMA(0, 1, At, B1); PG8_BAR; PG8_SCHED;
            PG8_LDA(At, 1, 1); PG8_STAGEB(PG8_SB(1, 0), b3); PG8_STAGEB(PG8_SB(1, 1), b3 + hstep); PG8_STAGEA(PG8_SA(1, 0), a3, 0);
            PG8_WAIT_V(8); PG8_WAIT_L(0); PG8_BAR; PG8_MMA(1, 0, At, B0); PG8_MMA(1, 1, At, B1); PG8_BAR; PG8_SCHED;
            }
        }
        if (wr == 0) PG8_BAR;
        { Unit ce = cur; ce.pm = __builtin_amdgcn_readfirstlane(cur.pm); ce.pn = __builtin_amdgcn_readfirstlane(cur.pn); ce.cls = __builtin_amdgcn_readfirstlane(cur.cls); ce.slot0 = __builtin_amdgcn_readfirstlane(cur.slot0); ce.nvalid = __builtin_amdgcn_readfirstlane(cur.nvalid);
          asm volatile("" : "+s"(ce.pm), "+s"(ce.pn), "+s"(ce.cls), "+s"(ce.slot0), "+s"(ce.nvalid));
          E(acc, ce, wr, wc, fr, fq); }
        if (!has_next) break;
#pragma unroll
        for (int a = 0; a < 2; ++a)
#pragma unroll
            for (int b = 0; b < 2; ++b)
#pragma unroll
                for (int m = 0; m < 4; ++m)
#pragma unroll
                    for (int n = 0; n < 2; ++n) acc[a][b][m][n] = (f32x4){0.f, 0.f, 0.f, 0.f};
        cur = nxt; cA = nA; cB = nB; ++ui;
        if (wr == 1) PG8_BAR;
    }
    PG8_WAIT_V(0);
    PG8_BAR;
#undef PG8_SA
#undef PG8_SB
#undef PG8_STAGEA
#undef PG8_STAGEB
#undef PG8_LDA
#undef PG8_LDB
#undef PG8_MMA
#undef PG8_WAIT_V
#undef PG8_LDA8
#undef PG8_MMA8
#undef PG8_PHASE8
#undef PG8_WAIT_L
#undef PG8_BAR
#undef PG8_SCHED
#undef PG8_LOADVA
}

__device__ __forceinline__ float rstd_from_ssq(const float* ssq, int row) {
    const f32x4* p = (const f32x4*)(ssq + (size_t)row * 16); const f32x4 a = p[0], b = p[1], c = p[2], d = p[3];
    const float s = ((a[0] + a[1]) + (a[2] + a[3])) + ((b[0] + b[1]) + (b[2] + b[3])) + ((c[0] + c[1]) + (c[2] + c[3])) + ((d[0] + d[1]) + (d[2] + d[3]));
    return rsqrtf(s * (1.0f / D) + EPS);
}
struct EpiScaleBf16 {
    static constexpr bool PERM = true;
    bf16* O; int ldc; const float* ssq; const float* rtab; float* gates; int gate_pn; bf16* O2; int ldc2; const float* rtab2;
    float osc = 1.0f;
    __device__ __forceinline__ void operator()(const f32x4 (&acc)[2][2][4][2], const Unit& u, int wr, int wc, int fr, int fq) const {
        { const int ln_ = lane_fresh(); fr = ln_ & 15; fq = ln_ >> 4; }
        const int row0 = u.pm * BM + wr * 64 + fr; const int col0 = u.pn * BM + wc * 32 + 8 * fq;
        if (u.cls == 1) {
#pragma unroll
            for (int ai = 0; ai < 2; ++ai)
#pragma unroll
                for (int m = 0; m < 4; ++m) { const int row = row0 + ai * HALF + m * 16; const float rs = rtab2[row] * osc; bf16* rowp = O2 + (size_t)row * ldc2 + col0;
#pragma unroll
                    for (int bj = 0; bj < 2; ++bj) { const f32x4 v0 = acc[ai][bj][m][0] * rs, v1 = acc[ai][bj][m][1] * rs; u32x4 w; w.x = cvt_pk_bf16(v0[0], v0[1]); w.y = cvt_pk_bf16(v0[2], v0[3]); w.z = cvt_pk_bf16(v1[0], v1[1]); w.w = cvt_pk_bf16(v1[2], v1[3]);
                        *(u32x4*)(rowp + bj * HALF) = w; } }
            return; }
#pragma unroll
        for (int ai = 0; ai < 2; ++ai)
#pragma unroll
            for (int m = 0; m < 4; ++m) { const int row = row0 + ai * HALF + m * 16; const float rs = (rtab ? rtab[row] : rstd_from_ssq(ssq, row)) * osc;
                if (u.pn < gate_pn) { bf16* rowp = O + (size_t)row * ldc + col0;
#pragma unroll
                    for (int bj = 0; bj < 2; ++bj) { const f32x4 v0 = acc[ai][bj][m][0] * rs, v1 = acc[ai][bj][m][1] * rs; u32x4 w; w.x = cvt_pk_bf16(v0[0], v0[1]); w.y = cvt_pk_bf16(v0[2], v0[3]); w.z = cvt_pk_bf16(v1[0], v1[1]); w.w = cvt_pk_bf16(v1[2], v1[3]);
                        *(u32x4*)(rowp + bj * HALF) = w; } }
                else if (wc == 0 && fq == 0) { *(f32x4*)(gates + (size_t)row * 8) = acc[ai][0][m][0] * rs; *(f32x4*)(gates + (size_t)row * 8 + 4) = acc[ai][0][m][1] * rs; } }
    }
};
template <bool SCATTER, bool F8 = false> struct EpiRes {
    static constexpr bool PERM = true;
    bf16* xb; float* ssq; int probe; unsigned char* x8 = nullptr;
    __device__ __forceinline__ void operator()(const f32x4 (&acc)[2][2][4][2], const Unit& u, int wr, int wc, int fr, int fq) const {
        { const int ln_ = lane_fresh(); fr = ln_ & 15; fq = ln_ >> 4; }
        const int col0 = u.pn * BM + wc * 32 + 8 * fq;
#pragma unroll
        for (int ai = 0; ai < 2; ++ai)
#pragma unroll
            for (int m = 0; m < 4; ++m) { const int lr = wr * 64 + fr + ai * HALF + m * 16; int row; bool ok = true;
                if constexpr (SCATTER) { ok = lr < u.nvalid; row = ok ? u.rows[lr] : 0; } else row = u.pm * BM + lr;
                float ss = 0.f; bf16* rowp = xb + (size_t)row * D + col0;
#pragma unroll
                for (int bj = 0; bj < 2; ++bj) { const u32x4 v = *(const u32x4*)(rowp + bj * HALF); constexpr float ASC = F8 ? 1.0f / (F8_WSCALE * F8_HSCALE) : 1.0f; const f32x4 a0 = acc[ai][bj][m][0] * ASC, a1 = acc[ai][bj][m][1] * ASC;
                    float o[8] = {bflo(v.x), bfhi(v.x), bflo(v.y), bfhi(v.y), bflo(v.z), bfhi(v.z), bflo(v.w), bfhi(v.w)};
                    if (!probe) { o[0] += a0[0]; o[1] += a0[1]; o[2] += a0[2]; o[3] += a0[3]; o[4] += a1[0]; o[5] += a1[1]; o[6] += a1[2]; o[7] += a1[3]; }
                    ss += (o[0] * o[0] + o[1] * o[1]) + (o[2] * o[2] + o[3] * o[3]) + (o[4] * o[4] + o[5] * o[5]) + (o[6] * o[6] + o[7] * o[7]);
                    u32x4 w; w.x = cvt_pk_bf16(o[0], o[1]); w.y = cvt_pk_bf16(o[2], o[3]); w.z = cvt_pk_bf16(o[4], o[5]); w.w = cvt_pk_bf16(o[6], o[7]);
                    if (ok) *(u32x4*)(rowp + bj * HALF) = w;
                    if constexpr (!SCATTER) { if (x8) { u32x2 w8; w8.x = f8x4(o[0], o[1], o[2], o[3]); w8.y = f8x4(o[4], o[5], o[6], o[7]); *(u32x2*)(x8 + (size_t)row * D + col0 + bj * HALF) = w8; } } }
                ss = xor16_sum(ss); ss = xor32_sum(ss);
                if (fq == 0 && ok) ssq[(size_t)row * 16 + u.pn * 4 + wc] = ss; }
    }
};
template <bool F8 = false> struct EpiMoe1 {
    static constexpr bool PERM = true;
    bf16* hid; const float* rs; const float* gwa; const float* gwb;
    __device__ __forceinline__ void operator()(const f32x4 (&acc)[2][2][4][2], const Unit& u, int wr, int wc, int fr, int fq) const {
        { const int ln_ = lane_fresh(); fr = ln_ & 15; fq = ln_ >> 4; }
        const float* gw = (u.pn < 4 ? gwa : gwb) + (size_t)u.cls * CLSCAP + u.slot0; const float* rsp = rs + (size_t)u.cls * CLSCAP + u.slot0;
        const int col0 = (u.pn >> 2) * 512 + (u.pn & 3) * 128 + wc * 32 + 8 * fq;
#pragma unroll
        for (int ai = 0; ai < 2; ++ai)
#pragma unroll
            for (int m = 0; m < 4; ++m) { const int lr = wr * 64 + fr + ai * HALF + m * 16; const float r = rsp[lr] * (F8 ? 1.0f / F8_WSCALE : 1.0f), ru = F8 ? r * F8_HSCALE : r, g = gw[lr]; float h[8];
#pragma unroll
                for (int n = 0; n < 2; ++n)
#pragma unroll
                    for (int j = 0; j < 4; ++j) { const float a = acc[ai][0][m][n][j] * r, uu = acc[ai][1][m][n][j] * ru; h[n * 4 + j] = siluf(a) * uu * g; }
                u32x4 w; w.x = cvt_pk_bf16(h[0], h[1]); w.y = cvt_pk_bf16(h[2], h[3]); w.z = cvt_pk_bf16(h[4], h[5]); w.w = cvt_pk_bf16(h[6], h[7]);
                if constexpr (F8) { u32x2 w8; w8.x = f8x4(h[0], h[1], h[2], h[3]); w8.y = f8x4(h[4], h[5], h[6], h[7]); *(u32x2*)((unsigned char*)hid + ((size_t)u.pm * BM + lr) * 1024 + col0) = w8; }
                else *(u32x4*)(hid + ((size_t)u.pm * BM + lr) * 1024 + col0) = w; }
    }
};
}
using pg8::f8x4; using pg8::layer_f8; using pg8::F8_WSCALE; using pg8::F8_HSCALE;

#define XB_TMO      128
#define XB_XCNT(j)  (256  + 64 * (j))
#define XB_XSUB(j)  (1280 + 64 * (j))
#define XB_XGEN(j)  (2304 + 64 * (j))
#define XB_TOP      3328
#define XB_TOPGEN   3392
#define XCD_BAR_WORDS 3456
#define XB_SPIN_CAP (1u << 20)
__device__ __forceinline__ unsigned xb_ld(unsigned* p)              { return __hip_atomic_load(p, __ATOMIC_RELAXED, __HIP_MEMORY_SCOPE_AGENT); }
__device__ __forceinline__ unsigned xb_add(unsigned* p, unsigned v) { return __hip_atomic_fetch_add(p, v, __ATOMIC_RELAXED, __HIP_MEMORY_SCOPE_AGENT); }
__device__ __forceinline__ unsigned xb_xcc_id() { return (unsigned)__builtin_amdgcn_s_getreg((3 << 11) | 20) & 0xFu; }
#define XB_SPIN(cond, bar) do { unsigned _sp = 0; while (cond) { __builtin_amdgcn_s_sleep(1); \
    if ((++_sp & 255u) == 0u) { if (xb_ld(&(bar)[XB_TMO])) break; if (_sp > XB_SPIN_CAP) { atomicAdd(&(bar)[XB_TMO], 1u); break; } } } } while (0)
struct XcdBarrier { unsigned* bar; unsigned x; volatile LAS unsigned* st; };
__device__ __forceinline__ XcdBarrier xcd_barrier_post(unsigned* bar, volatile LAS unsigned* st) {
    XcdBarrier b; b.bar = bar; b.x = xb_xcc_id(); b.st = st;
    if (threadIdx.x == 0) (void)xb_add(&bar[XB_XCNT(b.x)], 1u);
    return b;
}
__device__ __forceinline__ void xcd_barrier_complete(unsigned* bar, unsigned x, unsigned& nloc, unsigned& nx) {
    const unsigned G = gridDim.x * gridDim.y * gridDim.z;
    unsigned sum, cnt, mine, sp = 0u;
    for (;;) {
        sum = 0u; cnt = 0u; mine = 0u;
#pragma unroll 1
        for (unsigned j = 0; j < 16; ++j) { const unsigned c = xb_ld(&bar[XB_XCNT(j)]); sum += c; cnt += (c > 0u) ? 1u : 0u; mine = (j == x) ? c : mine; }
        if (sum == G) break;
        __builtin_amdgcn_s_sleep(1);
        if ((++sp & 255u) == 0u) { if (xb_ld(&bar[XB_TMO])) break; if (sp > XB_SPIN_CAP) { atomicAdd(&bar[XB_TMO], 1u); break; } }
    }
    nloc = mine > 0u ? mine : 1u; nx = cnt > 0u ? cnt : 1u;
}
__device__ __forceinline__ void xcd_barrier(const XcdBarrier& b) {
    asm volatile("s_waitcnt vmcnt(0)" ::: "memory");
    __syncthreads();
    if (threadIdx.x == 0) {
        unsigned* bar = b.bar; asm volatile("" : "+s"(bar));
        __builtin_amdgcn_s_waitcnt(0);
        unsigned nloc = b.st[0], nx = b.st[1];
        if (nloc == 0u) { xcd_barrier_complete(bar, b.x, nloc, nx); b.st[0] = nloc; b.st[1] = nx; }
        const unsigned old = xb_add(&bar[XB_XSUB(b.x)], 1u);
        const unsigned gen = old / nloc;
        if (old + 1u == (gen + 1u) * nloc) {
            __builtin_amdgcn_fence(__ATOMIC_RELEASE, "agent");
            asm volatile("s_waitcnt vmcnt(0)" ::: "memory");
            const unsigned og = xb_add(&bar[XB_TOP], 1u);
            const unsigned tg = og / nx;
            __builtin_amdgcn_fence(__ATOMIC_ACQUIRE, "agent");
            if (og + 1u != (tg + 1u) * nx) XB_SPIN(xb_ld(&bar[XB_TOP]) < (tg + 1u) * nx, bar);
            xb_add(&bar[XB_XGEN(b.x)], 1u);
            asm volatile("s_waitcnt vmcnt(0)" ::: "memory");
        } else {
            __builtin_amdgcn_fence(__ATOMIC_ACQUIRE, "agent");
            XB_SPIN(xb_ld(&bar[XB_XGEN(b.x)]) == gen, bar);
            asm volatile("s_waitcnt vmcnt(0)" ::: "memory");
        }
    }
    __syncthreads();
}

struct Args { const float* in[26]; float* out; unsigned char* ws; int ph_lo, ph_hi, mode, pad; };
struct Frame {
    LAS unsigned char* lds; volatile LAS unsigned* MISC; unsigned* ctl; unsigned char* ws;
    int tid, lane, wave, G, bx;
    float* out;
    __device__ __forceinline__ const float* in_(int i) const { const LAS unsigned* t = (const LAS unsigned*)(lds + PTAB_OFF); const unsigned lo = __builtin_amdgcn_readfirstlane(t[2 * i]), hi = __builtin_amdgcn_readfirstlane(t[2 * i + 1]); return (const float*)(const GAS float*)(((unsigned long long)hi << 32) | lo); }
};
#define LDS_WAIT() asm volatile("s_waitcnt lgkmcnt(0)" ::: "memory")

__device__ __forceinline__ void tr_item(const float* W, int ldw, int k0, int n0, int ncols, const float* g, float cs, bf16* dst0, bf16* dst1, bf16* dst2, int ldd, LAS float* scr, int lane) {
    const int nl = lane & 31;
#pragma unroll 8
    for (int i = 0; i < 32; ++i) { const int kk = 2 * i + (lane >> 5); float v = 0.f; if (nl < ncols) v = W[(size_t)(k0 + kk) * ldw + n0 + nl] * (g ? g[k0 + kk] * cs : cs); scr[kk * 33 + nl] = v; }
    LDS_WAIT(); asm volatile("" ::: "memory");
    const int c = lane & 7;
#pragma unroll
    for (int j = 0; j < 4; ++j) { const int n = (lane >> 3) + 8 * j; const LAS float* s = scr + (8 * c) * 33 + n;
        u32x4 o; o.x = pk2(s[0 * 33], s[1 * 33]); o.y = pk2(s[2 * 33], s[3 * 33]); o.z = pk2(s[4 * 33], s[5 * 33]); o.w = pk2(s[6 * 33], s[7 * 33]);
        if (n < ncols) { *(u32x4*)(dst0 + (size_t)n * ldd + 8 * c) = o; if (dst1) *(u32x4*)(dst1 + (size_t)n * ldd + 8 * c) = o; if (dst2) *(u32x4*)(dst2 + (size_t)n * ldd + 8 * c) = o; } }
    LDS_WAIT(); asm volatile("" ::: "memory");
}
__device__ __forceinline__ void tr_item64(const float* W, int ldw, int k0, int n0, const float* g, float cs, bf16* dst0, bf16* dst1, bf16* dst2, int ldd, LAS float* scr, int lane) {
    const int r4 = lane >> 4, c4 = (lane & 15) * 4;
#pragma unroll 4
    for (int i = 0; i < 16; ++i) { const int kk = 4 * i + r4; f32x4 v = __builtin_nontemporal_load((const f32x4*)(W + (size_t)(k0 + kk) * ldw + n0 + c4));   const float sc = g ? g[k0 + kk] * cs : cs; v = v * sc; *(LAS f32x4*)(scr + kk * 68 + c4) = v; }
    LDS_WAIT(); asm volatile("" ::: "memory");
    const int c = lane & 7;
#pragma unroll
    for (int j = 0; j < 8; ++j) { const int n = (lane >> 3) + 8 * j; const LAS float* s_ = scr + (8 * c) * 68 + n;
        u32x4 o; o.x = pk2(s_[0 * 68], s_[1 * 68]); o.y = pk2(s_[2 * 68], s_[3 * 68]); o.z = pk2(s_[4 * 68], s_[5 * 68]); o.w = pk2(s_[6 * 68], s_[7 * 68]);
        *(u32x4*)(dst0 + (size_t)n * ldd + 8 * c) = o; if (dst1) *(u32x4*)(dst1 + (size_t)n * ldd + 8 * c) = o; if (dst2) *(u32x4*)(dst2 + (size_t)n * ldd + 8 * c) = o; }
    LDS_WAIT(); asm volatile("" ::: "memory");
}
__device__ __forceinline__ void tr_item64_f8(const float* W, int ldw, int k0, int n0, const float* g, float cs, unsigned char* dst0, unsigned char* dst1, unsigned char* dst2, int ldd, LAS float* scr, int lane) {
    const int r4 = lane >> 4, c4 = (lane & 15) * 4;
#pragma unroll 4
    for (int i = 0; i < 16; ++i) { const int kk = 4 * i + r4; f32x4 v = __builtin_nontemporal_load((const f32x4*)(W + (size_t)(k0 + kk) * ldw + n0 + c4)); const float sc = g ? g[k0 + kk] * cs : cs; v = v * sc; *(LAS f32x4*)(scr + kk * 68 + c4) = v; }
    LDS_WAIT(); asm volatile("" ::: "memory");
    const int c = lane & 7;
#pragma unroll
    for (int j = 0; j < 8; ++j) { const int n = (lane >> 3) + 8 * j; const LAS float* s_ = scr + (8 * c) * 68 + n;
        u32x2 o; o.x = f8x4(s_[0 * 68], s_[1 * 68], s_[2 * 68], s_[3 * 68]); o.y = f8x4(s_[4 * 68], s_[5 * 68], s_[6 * 68], s_[7 * 68]);
        *(u32x2*)(dst0 + (size_t)n * ldd + 8 * c) = o; if (dst1) *(u32x2*)(dst1 + (size_t)n * ldd + 8 * c) = o; if (dst2) *(u32x2*)(dst2 + (size_t)n * ldd + 8 * c) = o; }
    LDS_WAIT(); asm volatile("" ::: "memory");
}
__device__ __forceinline__ int pair_index(int a, int b) { return a == 0 ? (b - 1) : (a == 1 ? (b + 1) : 5); }

__device__ __forceinline__ void phase_convert(Frame& F, int l) {
    LAS float* scr = (LAS float*)(F.lds + F.wave * (64 * 68 * 4));
    const int gw = F.bx * NWAVES + F.wave, NGW = F.G * NWAVES, lane = F.lane;
    unsigned char* ws = F.ws;
    bf16* Win = (bf16*)(ws + WS_WIN); bf16* Wout = (bf16*)(ws + WS_WOUT); bf16* Wmq = (bf16*)(ws + WS_WMQ); bf16* Wmkv = (bf16*)(ws + WS_WMKV); bf16* Wmo = (bf16*)(ws + WS_WMO);
    bf16* W13 = (bf16*)(ws + WS_W13); bf16* W2c = (bf16*)(ws + WS_W2C);
    const float* w_in = F.in_(3) + (size_t)l * D * DIN; const float* ln_mix = F.in_(2) + l * D;
    const float* w_out = F.in_(10) + (size_t)l * D * D;
    const float* ln_mem = F.in_(11) + l * D; const float* ln_memkv = F.in_(12) + l * D;
    const float* w_mq = F.in_(13) + (size_t)l * D * D; const float* w_mk = F.in_(14) + (size_t)l * D * D; const float* w_mv = F.in_(15) + (size_t)l * D * D; const float* w_mo = F.in_(16) + (size_t)l * D * D;
    const float* ln_ffn = F.in_(17) + l * D;
    const float* w_e1 = F.in_(22) + (size_t)l * 16 * D * DEXP; const float* w_e3 = F.in_(23) + (size_t)l * 16 * D * DEXP; const float* w_e2 = F.in_(24) + (size_t)l * 16 * DEXP * D;
    constexpr int I_SEG = 128;
    constexpr int I_IN = 7 * I_SEG, I_GATE = 16, I_SQ = 256, I_E13 = 32 * I_SEG, I_E2 = 16 * 128;
    const int kvp = (l == 0) ? 2 : (l + 1 < DEPTH ? 1 : 0); const int I_SQS = (3 + 2 * kvp) * I_SQ;
    const int NITEMS = I_IN + I_GATE + I_SQS + I_E13 + I_E2;
    for (int it = gw; it < NITEMS; it += NGW) {
        int r = it;
        if (r < I_IN) { const int seg = r / I_SEG, q = r % I_SEG, kb = q / 8, nb = q % 8;
            const int srcc = seg < 4 ? seg * 512 : 2056 + (seg - 4) * 512; const int dstr = seg * 512; const float cs = (seg == 4) ? (0.08838834764831845f * 1.4426950408889634f) : 1.0f;
            tr_item64(w_in, DIN, kb * 64, srcc + nb * 64, ln_mix, cs, Win + (size_t)(dstr + nb * 64) * D + kb * 64, nullptr, nullptr, D, scr, lane); continue; }
        r -= I_IN;
        if (r < I_GATE) { tr_item(w_in, DIN, r * 64, 2048, 8, ln_mix, 1.0f, Win + (size_t)NPROJ * D + r * 64, nullptr, nullptr, D, scr, lane); continue; }
        r -= I_GATE;
        if (r < I_SQS) { const int m5 = r / I_SQ, q = r % I_SQ, kb = q / 16, nb = q % 16;
            const int mat = m5 < 3 ? (m5 == 2 ? 4 : m5) : 2 + ((m5 - 3) & 1);
            const int lk = m5 < 3 ? l : ((l == 0) ? ((m5 - 3) >> 1) : l + 1);
            const float* W = mat == 0 ? w_out : mat == 1 ? w_mq : mat == 2 ? F.in_(14) + (size_t)lk * D * D : mat == 3 ? F.in_(15) + (size_t)lk * D * D : w_mo;
            const float* g = mat == 1 ? ln_mem : (mat == 2 || mat == 3) ? F.in_(12) + lk * D : nullptr;
            const float cs = (mat == 1) ? (0.0625f * 1.4426950408889634f) : 1.0f;
            bf16* Wkv = (lk & 1) ? (bf16*)(ws + WS_WMKV2) : Wmkv;
            bf16* dst = mat == 0 ? Wout : mat == 1 ? Wmq : mat == 2 ? Wkv : mat == 3 ? (Wkv + (size_t)1024 * D) : Wmo;
            if ((mat == 1 && F8_Q) || (mat == 4 && F8_MO) || (mat == 2 || mat == 3)) tr_item64_f8(W, D, kb * 64, nb * 64, g, cs * F8_WSCALE, (mat == 3 ? (unsigned char*)Wkv + (size_t)1024 * D : (unsigned char*)dst) + (size_t)(nb * 64) * D + kb * 64, nullptr, nullptr, D, scr, lane);
            else tr_item64(W, D, kb * 64, nb * 64, g, cs, dst + (size_t)(nb * 64) * D + kb * 64, nullptr, nullptr, D, scr, lane);
            continue; }
        r -= I_SQS;
        if (r < I_E13) { const int mat = r / I_SEG, q = r % I_SEG, kb = q / 8, nb = q % 8; const int ge = mat >> 1, which = mat & 1;
            const float* W = (which ? w_e3 : w_e1) + (size_t)ge * D * DEXP; const int c0 = nb * 64;
            bf16* dst = W13 + ((size_t)ge * 1024 + (c0 >> 7) * 256 + which * 128 + (c0 & 127)) * D + kb * 64;
            if (layer_f8(l)) tr_item64_f8(W, DEXP, kb * 64, c0, ln_ffn, F8_WSCALE, (unsigned char*)W13 + ((size_t)ge * 1024 + (c0 >> 7) * 256 + which * 128 + (c0 & 127)) * D + kb * 64, nullptr, nullptr, D, scr, lane);
            else tr_item64(W, DEXP, kb * 64, c0, ln_ffn, 1.0f, dst, nullptr, nullptr, D, scr, lane);
            continue; }
        r -= I_E13;
        { const int ge = r / 128, q = r % 128, kb = q / 16, nb = q % 16; const int g = ge >> 2, e = ge & 3;
            const float* W = w_e2 + (size_t)ge * DEXP * D; bf16* dd[3];
#pragma unroll
            for (int j = 0; j < 3; ++j) { const int o = (e + 1 + j) & 3; const int a = o < e ? o : e, b = o < e ? e : o; const int cls = g * 6 + pair_index(a, b); const int pos = (e == b) ? 1 : 0;
                dd[j] = W2c + ((size_t)cls * 1024 + nb * 64) * 1024 + pos * 512 + kb * 64; }
            if (layer_f8(l)) { unsigned char* d8[3];
#pragma unroll
                for (int j = 0; j < 3; ++j) d8[j] = (unsigned char*)W2c + (size_t)(dd[j] - W2c);
                tr_item64_f8(W, D, kb * 64, nb * 64, nullptr, F8_WSCALE, d8[0], d8[1], d8[2], 1024, scr, lane); }
            else tr_item64(W, D, kb * 64, nb * 64, nullptr, 1.0f, dd[0], dd[1], dd[2], 1024, scr, lane); }
    }
    { float* wr = (float*)(ws + WS_WR); const float* w_rg = F.in_(18) + (size_t)l * D * NG; const float* w_re = F.in_(20) + (size_t)l * D * 16;
      const float* b_rg = F.in_(19) + l * NG; const float* b_re = F.in_(21) + l * 16;
      const int gt = F.bx * NTHREADS + F.tid, NT = F.G * NTHREADS;
      for (int e = gt; e < 20 * D; e += NT) { const int j = e / D, k = e % D; wr[e] = ln_ffn[k] * (j < 4 ? w_rg[k * NG + j] : w_re[k * 16 + (j - 4)]); }
      if (gt < 20) wr[20 * D + gt] = gt < 4 ? b_rg[gt] : b_re[gt - 4]; }
    if (l == 0) {
        const float* x = F.in_(0); const float* mem = F.in_(1); bf16* xb = (bf16*)(ws + WS_XB); float* ssq = (float*)(ws + WS_SSQ); bf16* memb = (bf16*)(ws + WS_MEMB); float* memr = (float*)(ws + WS_MEMR);
        for (int m = gw; m < NTOK + NMEM; m += NGW) { const bool ism = m >= NTOK; const int row = ism ? m - NTOK : m;
            const f32x4* xr = (const f32x4*)((ism ? mem : x) + (size_t)row * D) + lane; unsigned long long* o8 = (unsigned long long*)((ism ? memb : xb) + (size_t)row * D) + lane;
            float s = 0.f;
#pragma unroll
            for (int j = 0; j < 4; ++j) { const f32x4 v = xr[64 * j]; s += (v[0] * v[0] + v[1] * v[1]) + (v[2] * v[2] + v[3] * v[3]); o8[64 * j] = (unsigned long long)pk2(v[0], v[1]) | ((unsigned long long)pk2(v[2], v[3]) << 32);
                if (ism) ((unsigned*)(ws + WS_MEMB8 + (size_t)row * D))[lane + 64 * j] = f8x4(v[0], v[1], v[2], v[3]); }
            s = wave_sum(s);
            if (ism) { if (lane == 0) memr[row] = rsqrtf(s * (1.0f / D) + EPS); }
            else if (lane < 16) ssq[(size_t)row * 16 + lane] = lane == 0 ? s : 0.f; }
    }
}

typedef float f32x16 __attribute__((ext_vector_type(16)));
typedef short s16x4 __attribute__((ext_vector_type(4)));
namespace sbat {
constexpr int KST = 272, VST = 320, KBUF = 64 * KST, VBUF = 64 * VST, STG = KBUF + VBUF, OST = 272;
__device__ __forceinline__ f16x8 cvt8(float a, float b, float c, float d, float e, float f, float g, float h) { u32x4 w; w.x = pk2(a, b); w.y = pk2(c, d); w.z = pk2(e, f); w.w = pk2(g, h); return __builtin_bit_cast(f16x8, w); }
typedef short v4i16_t __attribute__((ext_vector_type(4)));
__device__ __forceinline__ s16x4 vtr(const LAS unsigned char* p) { return __builtin_bit_cast(s16x4, __builtin_amdgcn_ds_read_tr16_b64_v4i16((LAS v4i16_t*)p)); }
#define SB_MFMA(a, b, c) __builtin_amdgcn_mfma_f32_32x32x16_f16((a), (b), (c), 0, 0, 0)
}
__device__ __forceinline__ void sb_unit(Frame& F, int l, const int bh, const int qb) {
    using namespace sbat;
    unsigned char* ws = F.ws; const bf16* proj = (const bf16*)(ws + WS_PROJ); bf16* y = (bf16*)(ws + WS_Y); const float* sg = F.in_(9) + l * 512;
    const int tid = F.tid, lane = F.lane, w = F.wave, t32 = lane & 31, hi = lane >> 5;
    LAS unsigned char* lds = F.lds;
    f16x8 tri0, tri1, ones;
#pragma unroll
    for (int j = 0; j < 8; ++j) { const int k0 = 8 * (j >> 2) + 4 * hi + (j & 3); tri0[j] = (k0 > t32) ? (_Float16)1.0f : (_Float16)0.0f; tri1[j] = (16 + k0 > t32) ? (_Float16)1.0f : (_Float16)0.0f; ones[j] = (_Float16)1.0f; }
    {
        const int b = bh >> 2, hh = bh & 3;
        const size_t tokb = (size_t)b * SEQ; const int q0 = qb * 256, t0w = q0 + 32 * w, tg = t0w + t32;
        f16x8 qf[8];
        { const bf16* qrow = proj + (tokb + tg) * NPROJ + 2048 + hh * 128 + 8 * hi;
#pragma unroll
          for (int kk = 0; kk < 8; ++kk) qf[kk] = *(const f16x8*)(qrow + 16 * kk); }
        f32x16 O[4]; f32x16 Rv;
#pragma unroll
        for (int r = 0; r < 16; ++r) { O[0][r] = 0.f; O[1][r] = 0.f; O[2][r] = 0.f; O[3][r] = 0.f; Rv[r] = 0.f; }
        const int njt = 4 * qb + 4;
        LAS float* rmaxL = (LAS float*)(lds + 2 * STG);
        const int rowL = tid >> 4, chunk = tid & 15;
        const bf16* kg = proj + (tokb + rowL) * NPROJ + 2560 + hh * 128 + chunk * 8; const bf16* vg = kg + 512;
        const int kdst = rowL * KST + chunk * 16, vdst = KBUF + rowL * VST + chunk * 16;
        u32x4 kr0, kr1, vr0, vr1;
        { const size_t o = (size_t)(64 * (njt - 1)) * NPROJ; kr0 = *(const u32x4*)(kg + o); kr1 = *(const u32x4*)(kg + o + 32 * NPROJ); vr0 = *(const u32x4*)(vg + o); vr1 = *(const u32x4*)(vg + o + 32 * NPROJ); }
        *(LAS u32x4*)(lds + kdst) = kr0; *(LAS u32x4*)(lds + kdst + 32 * KST) = kr1; *(LAS u32x4*)(lds + vdst) = vr0; *(LAS u32x4*)(lds + vdst + 32 * VST) = vr1;
        __syncthreads();
        int cur = 0;
        for (int jt = njt - 1; jt >= 0; --jt) {
            const bool act = (64 * jt <= t0w);
            const LAS unsigned char* Kb = lds + cur * STG; const LAS unsigned char* Vb = Kb + KBUF;
            f16x8 Af[2][2];
            if (act) {
                f32x16 p0, p1;
#pragma unroll
                for (int r = 0; r < 16; ++r) { p0[r] = 0.f; p1[r] = 0.f; }
#pragma unroll
                for (int kk = 0; kk < 8; ++kk) { const f16x8 k0 = *(const LAS f16x8*)(Kb + t32 * KST + 32 * kk + 16 * hi); const f16x8 k1 = *(const LAS f16x8*)(Kb + (t32 + 32) * KST + 32 * kk + 16 * hi);
                    p0 = SB_MFMA(k0, qf[kk], p0); p1 = SB_MFMA(k1, qf[kk], p1); }
                const bool diag = (64 * jt + 63 >= t0w);
                float L0[16], L1[16];
#pragma unroll
                for (int r = 0; r < 16; ++r) { const int sl = 64 * jt + (r & 3) + 8 * (r >> 2) + 4 * hi;
                    { const float z = fminf(p0[r], 115.f); const float lg = __builtin_amdgcn_logf(1.0f + __builtin_amdgcn_exp2f(z)); float Lv = -lg, lb = z - lg; if (diag && !(sl < tg)) { Lv = 0.f; lb = -1e30f; } L0[r] = Lv; p0[r] = lb; }
                    { const float z = fminf(p1[r], 115.f); const float lg = __builtin_amdgcn_logf(1.0f + __builtin_amdgcn_exp2f(z)); float Lv = -lg, lb = z - lg; if (diag && !(sl + 32 < tg)) { Lv = 0.f; lb = -1e30f; } L1[r] = Lv; p1[r] = lb; } }
                const f16x8 X0a = cvt8(L0[0], L0[1], L0[2], L0[3], L0[4], L0[5], L0[6], L0[7]), X0b = cvt8(L0[8], L0[9], L0[10], L0[11], L0[12], L0[13], L0[14], L0[15]);
                const f16x8 X1a = cvt8(L1[0], L1[1], L1[2], L1[3], L1[4], L1[5], L1[6], L1[7]), X1b = cvt8(L1[8], L1[9], L1[10], L1[11], L1[12], L1[13], L1[14], L1[15]);
                f32x16 Y1 = SB_MFMA(tri0, X1a, Rv); Y1 = SB_MFMA(tri1, X1b, Y1);
                f32x16 U = SB_MFMA(ones, X1a, Rv); U = SB_MFMA(ones, X1b, U);
                f32x16 Y0 = SB_MFMA(tri0, X0a, U); Y0 = SB_MFMA(tri1, X0b, Y0);
                Rv = SB_MFMA(ones, X0a, U); Rv = SB_MFMA(ones, X0b, Rv);
#pragma unroll
                for (int r = 0; r < 16; ++r) { p0[r] = __builtin_amdgcn_exp2f(p0[r] + Y0[r]); p1[r] = __builtin_amdgcn_exp2f(p1[r] + Y1[r]); }
                Af[0][0] = cvt8(p0[0], p0[1], p0[2], p0[3], p0[4], p0[5], p0[6], p0[7]); Af[0][1] = cvt8(p0[8], p0[9], p0[10], p0[11], p0[12], p0[13], p0[14], p0[15]);
                Af[1][0] = cvt8(p1[0], p1[1], p1[2], p1[3], p1[4], p1[5], p1[6], p1[7]); Af[1][1] = cvt8(p1[8], p1[9], p1[10], p1[11], p1[12], p1[13], p1[14], p1[15]);
            }
            if (jt > 0) { const size_t o = (size_t)(64 * (jt - 1)) * NPROJ; kr0 = *(const u32x4*)(kg + o); kr1 = *(const u32x4*)(kg + o + 32 * NPROJ); vr0 = *(const u32x4*)(vg + o); vr1 = *(const u32x4*)(vg + o + 32 * NPROJ); }
            if (act) {
                const int i16 = lane & 15, dhalf = (lane >> 4) & 1;
                const LAS unsigned char* va = Vb + (4 * hi + (i16 >> 2)) * VST + (dhalf * 16 + 4 * (i16 & 3)) * 2;
#pragma unroll
                for (int dblk = 0; dblk < 4; ++dblk)
#pragma unroll
                    for (int sb = 0; sb < 2; ++sb)
#pragma unroll
                        for (int sp = 0; sp < 2; ++sp) { const LAS unsigned char* pp = va + (32 * sb + 16 * sp) * VST + dblk * 64; const s16x4 lo = vtr(pp), h4 = vtr(pp + 8 * VST);
                            const bf16x8 vf = (bf16x8){lo[0], lo[1], lo[2], lo[3], h4[0], h4[1], h4[2], h4[3]};
                            O[dblk] = SB_MFMA(__builtin_bit_cast(f16x8, vf), Af[sb][sp], O[dblk]); }
            }
            if (jt > 0) { const int nb = (cur ^ 1) * STG; *(LAS u32x4*)(lds + nb + kdst) = kr0; *(LAS u32x4*)(lds + nb + kdst + 32 * KST) = kr1; *(LAS u32x4*)(lds + nb + vdst) = vr0; *(LAS u32x4*)(lds + nb + vdst + 32 * VST) = vr1; }
            { const float rw = wave_max(Rv[0]); if (lane == 0) rmaxL[(jt & 1) * 8 + w] = rw; }
            __syncthreads(); cur ^= 1;
            { const f32x4 ra = *(const LAS f32x4*)(rmaxL + (jt & 1) * 8), rb = *(const LAS f32x4*)(rmaxL + (jt & 1) * 8 + 4);
              const float rm = fmaxf(fmaxf(fmaxf(ra[0], ra[1]), fmaxf(ra[2], ra[3])), fmaxf(fmaxf(rb[0], rb[1]), fmaxf(rb[2], rb[3])));
              if (rm < -27.0f) break; }
        }
        { float ss = 0.f;
#pragma unroll
          for (int dblk = 0; dblk < 4; ++dblk)
#pragma unroll
              for (int r = 0; r < 16; ++r) ss += O[dblk][r] * O[dblk][r];
          ss = xor32_sum(ss); const float rr = rsqrtf(ss * (1.0f / 128) + EPS);
          LAS unsigned char* st = lds + w * (32 * OST);
#pragma unroll
          for (int dblk = 0; dblk < 4; ++dblk)
#pragma unroll
              for (int rq = 0; rq < 4; ++rq) { u32x2 v; v.x = pk2(O[dblk][4 * rq] * rr, O[dblk][4 * rq + 1] * rr); v.y = pk2(O[dblk][4 * rq + 2] * rr, O[dblk][4 * rq + 3] * rr);
                  *(LAS u32x2*)(st + t32 * OST + (dblk * 32 + 8 * rq + 4 * hi) * 2) = v; }
          LDS_WAIT();
          int le = lane; asm volatile("" : "+v"(le));
          const int ch = le & 15; const f32x4 g0 = *(const f32x4*)(sg + hh * 128 + ch * 8), g1 = *(const f32x4*)(sg + hh * 128 + ch * 8 + 4);
#pragma unroll
          for (int i = 0; i < 8; ++i) { const int row = i * 4 + (le >> 4); const u32x4 v = *(const LAS u32x4*)(st + row * OST + ch * 16); u32x4 o;
              o.x = pk2(bflo(v.x) * g0[0], bfhi(v.x) * g0[1]); o.y = pk2(bflo(v.y) * g0[2], bfhi(v.y) * g0[3]); o.z = pk2(bflo(v.z) * g1[0], bfhi(v.z) * g1[1]); o.w = pk2(bflo(v.w) * g1[2], bfhi(v.w) * g1[3]);
              *(u32x4*)(y + (tokb + t0w + row) * D + 512 + hh * 128 + ch * 8) = o; }
        }
        __syncthreads();
    }
}


namespace mls {
constexpr int ST = 272, KC = 0, VC = 128 * ST, CT = 2 * 128 * ST, QC = 3 * 128 * ST, GB = 4 * 128 * ST;
static_assert(GB + 2560 <= LDSCTL_OFF, "mLSTM LDS map");
#define ML_MFMA(a, b, c) __builtin_amdgcn_mfma_f32_16x16x32_f16((a), (b), (c), 0, 0, 0)
__device__ __forceinline__ f16x8 tr8(const LAS unsigned char* p, int second_off) { const s16x4 lo = sbat::vtr(p), h4 = sbat::vtr(p + second_off); const bf16x8 v = (bf16x8){lo[0], lo[1], lo[2], lo[3], h4[0], h4[1], h4[2], h4[3]}; return __builtin_bit_cast(f16x8, v); }
}
__device__ __forceinline__ void ml_x1(Frame& F, int l, const int item) {
    using namespace mls;
    unsigned char* ws = F.ws; const bf16* proj = (const bf16*)(ws + WS_PROJ); const float* gates = (const float*)(ws + WS_GATES);
    const int tid = F.tid, lane = F.lane, w = F.wave, l16 = lane & 15, g = lane >> 4; LAS unsigned char* lds = F.lds;
    const int chain = item >> 4, c = item & 15, b = chain >> 2, h = chain & 3;
    const float* convw = F.in_(4) + (size_t)l * 4 * 1024; const float* convb = F.in_(5) + l * 1024; const float ib = F.in_(6)[l * 4 + h], fb = F.in_(7)[l * 4 + h];
    bf16* qcv = (bf16*)(ws + WS_QCV) + (size_t)item * 16384; bf16* kcv = (bf16*)(ws + WS_KCV) + (size_t)item * 16384; bf16* dC = (bf16*)(ws + WS_DC) + (size_t)item * 16384;
    float* gbuf = (float*)(ws + WS_GBUF) + (size_t)item * 384; float* dn = (float*)(ws + WS_DN) + (size_t)item * 128; float* scal = (float*)(ws + WS_SCAL) + (size_t)item * 4;
    LAS float* gL = (LAS float*)(lds + GB) + 128; LAS _Float16* wS = (LAS _Float16*)(lds + GB + 2048);
    const int ts0 = c * 128; const size_t tokc = (size_t)b * SEQ + ts0; const int q4 = l16 >> 2, p4 = l16 & 3;
    { const int cg = tid & 15, r0 = 4 * (tid >> 4);
#pragma unroll
      for (int qk = 0; qk < 2; ++qk) { const int ch = qk * 512 + h * 128 + cg * 8; u32x4 raw[7];
#pragma unroll
          for (int j = 0; j < 7; ++j) { const int tt = ts0 + r0 - 3 + j; const int ttc = tt < 0 ? 0 : tt; u32x4 r_ = *(const u32x4*)(proj + ((size_t)b * SEQ + ttc) * NPROJ + ch);
              if (tt < 0) r_ = (u32x4){0u, 0u, 0u, 0u}; raw[j] = r_; }
          float wv[4][8], bv[8];
#pragma unroll
          for (int e4 = 0; e4 < 2; ++e4) { const f32x4 t_ = *(const f32x4*)(convb + ch + 4 * e4); bv[4 * e4] = t_[0]; bv[4 * e4 + 1] = t_[1]; bv[4 * e4 + 2] = t_[2]; bv[4 * e4 + 3] = t_[3];
#pragma unroll
              for (int tap = 0; tap < 4; ++tap) { const f32x4 u_ = *(const f32x4*)(convw + tap * 1024 + ch + 4 * e4); wv[tap][4 * e4] = u_[0]; wv[tap][4 * e4 + 1] = u_[1]; wv[tap][4 * e4 + 2] = u_[2]; wv[tap][4 * e4 + 3] = u_[3]; } }
          const float sc = qk ? 0.08838834764831845f : 1.0f;
#pragma unroll
          for (int r = 0; r < 4; ++r) { float a[8];
#pragma unroll
              for (int e = 0; e < 8; ++e) a[e] = bv[e];
#pragma unroll
              for (int tap = 0; tap < 4; ++tap) { const u32x4 r_ = raw[r + tap];
                  a[0] += wv[tap][0] * bflo(r_.x); a[1] += wv[tap][1] * bfhi(r_.x); a[2] += wv[tap][2] * bflo(r_.y); a[3] += wv[tap][3] * bfhi(r_.y);
                  a[4] += wv[tap][4] * bflo(r_.z); a[5] += wv[tap][5] * bfhi(r_.z); a[6] += wv[tap][6] * bflo(r_.w); a[7] += wv[tap][7] * bfhi(r_.w); }
              u32x4 o_; o_.x = pk2(siluf(a[0]) * sc, siluf(a[1]) * sc); o_.y = pk2(siluf(a[2]) * sc, siluf(a[3]) * sc); o_.z = pk2(siluf(a[4]) * sc, siluf(a[5]) * sc); o_.w = pk2(siluf(a[6]) * sc, siluf(a[7]) * sc);
              *(u32x4*)((qk ? kcv : qcv) + (r0 + r) * 128 + cg * 8) = o_;
              if (qk) *(LAS u32x4*)(lds + KC + (r0 + r) * ST + cg * 16) = o_; } }
#pragma unroll
      for (int r = 0; r < 4; ++r) *(LAS u32x4*)(lds + VC + (r0 + r) * ST + cg * 16) = *(const u32x4*)(proj + (tokc + r0 + r) * NPROJ + 1024 + h * 128 + cg * 8); }
    if (w == 0) { const int t0 = 2 * lane; const float* gp = gates + (tokc + t0) * 8;
        const float i0 = gp[h] + ib, f0 = gp[4 + h] + fb, i1 = gp[8 + h] + ib, f1 = gp[12 + h] + fb;
        const float lf0 = -softplusf(-f0), lf1 = -softplusf(-f1); const float s2 = lf0 + lf1; float incl = s2;
        incl += DPPF(0.f, incl, 0x111, 0xF); incl += DPPF(0.f, incl, 0x112, 0xF); incl += DPPF(0.f, incl, 0x114, 0xF); incl += DPPF(0.f, incl, 0x118, 0xF);
        incl += DPPF(0.f, incl, 0x142, 0xA); incl += DPPF(0.f, incl, 0x143, 0xC);
        const float b0 = incl - s2 + lf0, b1 = b0 + lf1; const float g0 = i0 - b0, g1 = i1 - b1; float pm = fmaxf(g0, g1);
        pm = fmaxf(pm, DPPF(-INFINITY, pm, 0x111, 0xF)); pm = fmaxf(pm, DPPF(-INFINITY, pm, 0x112, 0xF)); pm = fmaxf(pm, DPPF(-INFINITY, pm, 0x114, 0xF)); pm = fmaxf(pm, DPPF(-INFINITY, pm, 0x118, 0xF));
        pm = fmaxf(pm, DPPF(-INFINITY, pm, 0x142, 0xA)); pm = fmaxf(pm, DPPF(-INFINITY, pm, 0x143, 0xC));
        const float pe = DPPF(-INFINITY, pm, 0x138, 0xF);
        const float G0 = fmaxf(pe, g0), G1 = fmaxf(G0, g1);
        const float Gmax = __builtin_bit_cast(float, __builtin_amdgcn_readlane(__builtin_bit_cast(int, G1), 63)), blast = __builtin_bit_cast(float, __builtin_amdgcn_readlane(__builtin_bit_cast(int, b1), 63));
        *(f32x2*)(gbuf + t0) = (f32x2){b0, b1}; *(f32x2*)(gbuf + 128 + t0) = (f32x2){g0, g1}; *(f32x2*)(gbuf + 256 + t0) = (f32x2){G0, G1};
        wS[t0] = (_Float16)__expf(g0 - Gmax); wS[t0 + 1] = (_Float16)__expf(g1 - Gmax);
        if (lane == 0) { scal[0] = blast; scal[1] = Gmax; } }
    __syncthreads();
    { f32x4 Cacc[8]; f32x4 Cn = (f32x4){0.f, 0.f, 0.f, 0.f};
#pragma unroll
      for (int vt = 0; vt < 8; ++vt) Cacc[vt] = (f32x4){0.f, 0.f, 0.f, 0.f};
#pragma unroll
      for (int ks = 0; ks < 4; ++ks) { const f16x8 kb = tr8(lds + KC + (32 * ks + 4 * g + q4) * ST + (16 * w + 4 * p4) * 2, 16 * ST);
          const u32x2 wa = *(const LAS u32x2*)(wS + 32 * ks + 4 * g), wb = *(const LAS u32x2*)(wS + 32 * ks + 16 + 4 * g); const u32x4 w4 = (u32x4){wa.x, wa.y, wb.x, wb.y}; const f16x8 wf = __builtin_bit_cast(f16x8, w4);
          Cn = ML_MFMA(wf, kb, Cn);
          f16x8 vfb[8];
#pragma unroll
          for (int vt = 0; vt < 8; ++vt) vfb[vt] = tr8(lds + VC + (32 * ks + 4 * g + q4) * ST + (16 * vt + 4 * p4) * 2, 16 * ST);
          __builtin_amdgcn_sched_barrier(0);
#pragma unroll
          for (int vt = 0; vt < 8; ++vt) Cacc[vt] = ML_MFMA(vfb[vt] * wf, kb, Cacc[vt]);
          __builtin_amdgcn_sched_barrier(0); }
#pragma unroll
      for (int vt = 0; vt < 8; ++vt) { u32x2 o_; o_.x = pk2(Cacc[vt][0], Cacc[vt][1]); o_.y = pk2(Cacc[vt][2], Cacc[vt][3]); *(u32x2*)(dC + (16 * w + l16) * 128 + 16 * vt + 4 * g) = o_; }
      if (g == 0) dn[16 * w + l16] = Cn[0]; }
    __syncthreads();
}
__device__ __forceinline__ void phase_ml_scan(Frame& F) {
    unsigned char* ws = F.ws; const int tid = F.tid;
    for (int u = F.bx; u < 256; u += F.G) { const int chain = u >> 2, qtr = u & 3; const size_t e0 = (size_t)qtr * 4096 + tid * 8;
        const bf16* dC = (const bf16*)(ws + WS_DC) + (size_t)chain * 16 * 16384 + e0; bf16* Cp = (bf16*)(ws + WS_CPREV) + (size_t)chain * 16 * 16384 + e0;
        const float* dn = (const float*)(ws + WS_DN) + (size_t)chain * 16 * 128; float* np = (float*)(ws + WS_NPREV) + (size_t)chain * 16 * 128; float* scal = (float*)(ws + WS_SCAL) + (size_t)chain * 16 * 4;
        float z0 = 0.f; asm volatile("" : "+v"(z0));
        float C[8] = {z0, z0, z0, z0, z0, z0, z0, z0}; float nn = z0; float m = z0; const bool don = (qtr == 0 && tid < 128);
        u32x4 dall[16]; float dnall[16]; f32x2 scall[16];
#pragma unroll
        for (int c = 0; c < 16; ++c) { dall[c] = *(const u32x4*)(dC + (size_t)c * 16384); dnall[c] = don ? dn[c * 128 + tid] : z0; scall[c] = *(const f32x2*)(scal + c * 4); }
#pragma unroll
        for (int c = 0; c < 16; ++c) { const u32x4 dcur = dall[c]; const float dncur = dnall[c]; const f32x2 sc = scall[c];
            u32x4 o_; o_.x = pk2(C[0], C[1]); o_.y = pk2(C[2], C[3]); o_.z = pk2(C[4], C[5]); o_.w = pk2(C[6], C[7]); *(u32x4*)(Cp + (size_t)c * 16384) = o_;
            if (don) np[c * 128 + tid] = nn;
            if (qtr == 0 && tid == 0) scal[c * 4 + 2] = m;
            const float Mlast = fmaxf(m, sc[1]), wold = __expf(m - Mlast), wloc = __expf(sc[1] - Mlast);
            C[0] = wold * C[0] + wloc * bflo(dcur.x); C[1] = wold * C[1] + wloc * bfhi(dcur.x); C[2] = wold * C[2] + wloc * bflo(dcur.y); C[3] = wold * C[3] + wloc * bfhi(dcur.y);
            C[4] = wold * C[4] + wloc * bflo(dcur.z); C[5] = wold * C[5] + wloc * bfhi(dcur.z); C[6] = wold * C[6] + wloc * bflo(dcur.w); C[7] = wold * C[7] + wloc * bfhi(dcur.w);
            nn = wold * nn + wloc * dncur; m = sc[0] + Mlast; } }
}
struct X3Pf { u32x4 q[4], k[4], c[4], v[4]; f32x4 g; float mp; };
__device__ __forceinline__ void x3_load(Frame& F, const int item, X3Pf& pf) {
    unsigned char* ws = F.ws; const bf16* proj = (const bf16*)(ws + WS_PROJ); const int tid = F.wave * 64 + pg8::lane_fresh();
    const int chain = item >> 4, c = item & 15, b = chain >> 2, h = chain & 3; const size_t tokc = (size_t)b * SEQ + c * 128;
    const bf16* qcv = (const bf16*)(ws + WS_QCV) + (size_t)item * 16384; const bf16* kcv = (const bf16*)(ws + WS_KCV) + (size_t)item * 16384; const bf16* Cp = (const bf16*)(ws + WS_CPREV) + (size_t)item * 16384;
    const float* gbuf = (const float*)(ws + WS_GBUF) + (size_t)item * 384; const float* np = (const float*)(ws + WS_NPREV) + (size_t)item * 128; const float* scal = (const float*)(ws + WS_SCAL) + (size_t)item * 4;
    const int cg = tid & 15, r0 = tid >> 4;
#pragma unroll
    for (int i = 0; i < 4; ++i) { const int row = r0 + 32 * i;
        pf.q[i] = *(const u32x4*)(qcv + row * 128 + cg * 8); pf.k[i] = *(const u32x4*)(kcv + row * 128 + cg * 8);
        pf.c[i] = *(const u32x4*)(Cp + row * 128 + cg * 8); pf.v[i] = *(const u32x4*)(proj + (tokc + row) * NPROJ + 1024 + h * 128 + cg * 8); }
    pf.g = (f32x4){0.f, 0.f, 0.f, 0.f};
    if (tid < 96) pf.g = *(const f32x4*)(gbuf + 4 * tid); else if (tid < 128) pf.g = *(const f32x4*)(np + 4 * (tid - 96));
    pf.mp = scal[2];
}
__device__ __forceinline__ void ml_x3(Frame& F, int l, const int item, X3Pf& pf, const int next_item) {
    using namespace mls;
    unsigned char* ws = F.ws; const bf16* proj = (const bf16*)(ws + WS_PROJ); bf16* y = (bf16*)(ws + WS_Y);
    const int tid = F.tid, lane = F.lane, w = F.wave, l16 = lane & 15, g = lane >> 4; LAS unsigned char* lds = F.lds;
    const int chain = item >> 4, c = item & 15, b = chain >> 2, h = chain & 3;
    const float* hg = F.in_(8) + l * 512 + h * 128;
    const bf16* qcv = (const bf16*)(ws + WS_QCV) + (size_t)item * 16384; const bf16* kcv = (const bf16*)(ws + WS_KCV) + (size_t)item * 16384; const bf16* Cp = (const bf16*)(ws + WS_CPREV) + (size_t)item * 16384;
    const float* gbuf = (const float*)(ws + WS_GBUF) + (size_t)item * 384; const float* np = (const float*)(ws + WS_NPREV) + (size_t)item * 128; const float* scal = (const float*)(ws + WS_SCAL) + (size_t)item * 4;
    LAS float* bL = (LAS float*)(lds + GB); LAS float* gL = bL + 128; LAS float* GL = bL + 256; LAS float* nL = bL + 384;
    const size_t tokc = (size_t)b * SEQ + c * 128; const int q4 = l16 >> 2, p4 = l16 & 3;
    { const int cg = tid & 15, r0 = tid >> 4;
#pragma unroll
      for (int i = 0; i < 4; ++i) { const int row = r0 + 32 * i;
          *(LAS u32x4*)(lds + QC + row * ST + cg * 16) = pf.q[i]; *(LAS u32x4*)(lds + KC + row * ST + cg * 16) = pf.k[i];
          *(LAS u32x4*)(lds + CT + row * ST + cg * 16) = pf.c[i]; *(LAS u32x4*)(lds + VC + row * ST + cg * 16) = pf.v[i]; }
      if (tid < 96) *(LAS f32x4*)(bL + 4 * tid) = pf.g;
      else if (tid < 128) *(LAS f32x4*)(nL + 4 * (tid - 96)) = pf.g; }
    const float mp = pf.mp;
    __syncthreads();
    if (next_item >= 0) x3_load(F, next_item, pf);
    { const int t = 16 * w + l16; const size_t tok = tokc + t; const float Mt = fmaxf(mp, GL[t]), bt = bL[t]; const float wi = __expf(mp - Mt);
      u32x2 mo8[8];
#pragma unroll
      for (int vt = 0; vt < 8; ++vt) mo8[vt] = *(const u32x2*)(proj + tok * NPROJ + 1536 + h * 128 + 16 * vt + 4 * g);
      f16x8 qf[4], qs[4];
#pragma unroll
      for (int kk = 0; kk < 4; ++kk) { qf[kk] = *(const LAS f16x8*)(lds + QC + (16 * w + l16) * ST + (32 * kk + 8 * g) * 2); qs[kk] = qf[kk] * (_Float16)wi; }
      f32x4 sa[8];
#pragma unroll
      for (int st = 0; st < 8; ++st) { sa[st] = (f32x4){0.f, 0.f, 0.f, 0.f};
          if (st <= w) { f16x8 kf[4];
#pragma unroll
              for (int kk = 0; kk < 4; ++kk) kf[kk] = *(const LAS f16x8*)(lds + KC + (16 * st + l16) * ST + (32 * kk + 8 * g) * 2);
              __builtin_amdgcn_sched_barrier(0);
#pragma unroll
              for (int kk = 0; kk < 4; ++kk) sa[st] = ML_MFMA(kf[kk], qf[kk], sa[st]);
              __builtin_amdgcn_sched_barrier(0); } }
      float den = 0.f;
#pragma unroll
      for (int st = 0; st < 8; ++st) { const f32x4 gv = *(const LAS f32x4*)(gL + 16 * st + 4 * g);
#pragma unroll
          for (int r = 0; r < 4; ++r) { const int s_ = 16 * st + 4 * g + r; const float p = (s_ <= t) ? sa[st][r] * __expf(gv[r] - Mt) : 0.f; den += p; sa[st][r] = p; } }
      f16x8 Pf[4];
#pragma unroll
      for (int ks = 0; ks < 4; ++ks) Pf[ks] = sbat::cvt8(sa[2 * ks][0], sa[2 * ks][1], sa[2 * ks][2], sa[2 * ks][3], sa[2 * ks + 1][0], sa[2 * ks + 1][1], sa[2 * ks + 1][2], sa[2 * ks + 1][3]);
      f32x4 nt[8];
#pragma unroll
      for (int vt = 0; vt < 8; ++vt) { nt[vt] = (f32x4){0.f, 0.f, 0.f, 0.f}; f16x8 vf[4], cf[4];
#pragma unroll
          for (int ks = 0; ks < 4; ++ks) if (32 * ks <= 16 * w + 15) vf[ks] = tr8(lds + VC + (32 * ks + 4 * g + q4) * ST + (16 * vt + 4 * p4) * 2, 16 * ST);
#pragma unroll
          for (int kk = 0; kk < 4; ++kk) cf[kk] = tr8(lds + CT + (32 * kk + 8 * g + q4) * ST + (16 * vt + 4 * p4) * 2, 4 * ST);
          __builtin_amdgcn_sched_barrier(0);
#pragma unroll
          for (int ks = 0; ks < 4; ++ks) if (32 * ks <= 16 * w + 15) nt[vt] = ML_MFMA(vf[ks], Pf[ks], nt[vt]);
#pragma unroll
          for (int kk = 0; kk < 4; ++kk) nt[vt] = ML_MFMA(cf[kk], qs[kk], nt[vt]);
          __builtin_amdgcn_sched_barrier(0); }
      den = xor16_sum(den); den = xor32_sum(den);
      float nq = 0.f;
#pragma unroll
      for (int kk = 0; kk < 4; ++kk) { const f32x4 n0 = *(const LAS f32x4*)(nL + 32 * kk + 8 * g), n1 = *(const LAS f32x4*)(nL + 32 * kk + 8 * g + 4);
          nq += n0[0] * (float)qf[kk][0] + n0[1] * (float)qf[kk][1] + n0[2] * (float)qf[kk][2] + n0[3] * (float)qf[kk][3] + n1[0] * (float)qf[kk][4] + n1[1] * (float)qf[kk][5] + n1[2] * (float)qf[kk][6] + n1[3] * (float)qf[kk][7]; }
      nq = xor16_sum(nq); nq = xor32_sum(nq);
      den += wi * nq;
      const float dn_ = __builtin_amdgcn_rcpf(fmaxf(fabsf(den), __expf(-(bt + Mt)))); float ss = 0.f;
#pragma unroll
      for (int vt = 0; vt < 8; ++vt)
#pragma unroll
          for (int r = 0; r < 4; ++r) { nt[vt][r] *= dn_; ss += nt[vt][r] * nt[vt][r]; }
      ss = xor16_sum(ss); ss = xor32_sum(ss); const float rr = rsqrtf(ss * (1.0f / 128) + EPS);
#pragma unroll
      for (int vt = 0; vt < 8; ++vt) { const int v0 = 16 * vt + 4 * g; const u32x2 mo = mo8[vt]; const f32x4 gg = *(const f32x4*)(hg + v0);
          u32x2 o_; o_.x = pk2(sigmf(bflo(mo.x)) * nt[vt][0] * rr * gg[0], sigmf(bfhi(mo.x)) * nt[vt][1] * rr * gg[1]); o_.y = pk2(sigmf(bflo(mo.y)) * nt[vt][2] * rr * gg[2], sigmf(bfhi(mo.y)) * nt[vt][3] * rr * gg[3]);
          *(u32x2*)(y + tok * D + h * 128 + v0) = o_; } }
    __syncthreads();
}

__device__ __forceinline__ void phase_mixer(Frame& F, int l, int qidx, int mode) {
    volatile LAS int* qs = (volatile LAS int*)(F.lds + MISC_OFF + 64); unsigned* qc = F.ctl + CW_Q + qidx;
    int ahead = 0; if (F.tid == 0) ahead = (int)atomicAdd(qc, 1u);
    for (;;) {
        if (F.tid == 0) *qs = ahead;
        __syncthreads();
        const int it = __builtin_amdgcn_readfirstlane(*qs);
        __syncthreads();
        if (it >= 512 + 1024) break;
        if (F.tid == 0) ahead = (int)atomicAdd(qc, 1u);
        if (mode == 1 && it < 512) continue;
        if (mode == 3 && it >= 512) break;
        Frame G = F;
        { int t_ = F.tid; asm volatile("" : "+v"(t_)); G.tid = t_; G.lane = t_ & 63; G.wave = __builtin_amdgcn_readfirstlane(t_ >> 6);
          unsigned lb_ = 0; asm volatile("" : "+s"(lb_)); G.lds = F.lds + lb_;
          GAS unsigned char* w_ = (GAS unsigned char*)F.ws; asm volatile("" : "+s"(w_)); G.ws = (unsigned char*)w_; }
        if (it >= 512) ml_x1(G, l, it - 512);
        else sb_unit(G, l, it & 63, 7 - (it >> 6));
    }
}

namespace xat {
constexpr int KST = 272, VST = 320, BUFB = 64 * VST, OST = 272;
typedef __amdgpu_buffer_rsrc_t rsrc_t;
__device__ __forceinline__ float xor32_max(float x) { auto t = __builtin_amdgcn_permlane32_swap(__float_as_uint(x), __float_as_uint(x), false, false); return fmaxf(__uint_as_float(t[0]), __uint_as_float(t[1])); }
template <int S> struct Step { static constexpr int isV = S >= 8, tile = isV ? ((S - 8) & 3) : (S >> 1), dh = isV ? ((S - 8) >> 2) : (S & 1), buf = S % 3; };
template <int S> __device__ __forceinline__ void ld(u32x4 (&r)[2], rsrc_t kvr, unsigned loff) {
    if constexpr (S < 16) {
#pragma unroll
        for (int i = 0; i < 2; ++i) r[i] = __builtin_bit_cast(u32x4, __builtin_amdgcn_raw_buffer_load_b128(kvr, loff, ((64 * Step<S>::tile + 32 * i) * 2048 + Step<S>::isV * 1024 + Step<S>::dh * 128) * 2, 0)); }
}
template <int S> __device__ __forceinline__ void st(const u32x4 (&r)[2], LAS unsigned char* lds, unsigned lk, unsigned lv) {
    if constexpr (S < 16) { constexpr int ST = Step<S>::isV ? VST : KST;
#pragma unroll
        for (int i = 0; i < 2; ++i) *(LAS u32x4*)(lds + (Step<S>::isV ? lv : lk) + Step<S>::buf * BUFB + 32 * i * ST) = r[i]; }
}
template <int S> __device__ __forceinline__ void qk(f32x16& S0, f32x16& S1, const f16x8 (&qf)[16], const LAS unsigned char* lds, int t32, int hi) {
#pragma unroll
    for (int kk = 0; kk < 8; ++kk) { const f16x8 k0 = *(const LAS f16x8*)(lds + Step<S>::buf * BUFB + t32 * KST + 32 * kk + 16 * hi); const f16x8 k1 = *(const LAS f16x8*)(lds + Step<S>::buf * BUFB + (32 + t32) * KST + 32 * kk + 16 * hi);
        S0 = SB_MFMA(k0, qf[8 * Step<S>::dh + kk], S0); S1 = SB_MFMA(k1, qf[8 * Step<S>::dh + kk], S1); }
}
template <int TILE> __device__ __forceinline__ void smax(f32x16& S0, f32x16& S1, f16x8 (&Pf)[8][2], float (&mt)[4], float& m, float& sum) {
    float tm = fmaxf(S0[0], S1[0]);
#pragma unroll
    for (int r = 1; r < 16; ++r) tm = fmaxf(tm, fmaxf(S0[r], S1[r]));
    tm = xor32_max(tm);
    const float mn = fmaxf(m, tm); sum *= __builtin_amdgcn_exp2f(m - mn); m = mn; mt[TILE] = mn;
    float ps = 0.f;
#pragma unroll
    for (int r = 0; r < 16; ++r) { S0[r] = __builtin_amdgcn_exp2f(S0[r] - mn); S1[r] = __builtin_amdgcn_exp2f(S1[r] - mn); ps += S0[r] + S1[r]; }
    sum += ps;
    Pf[2 * TILE][0] = sbat::cvt8(S0[0], S0[1], S0[2], S0[3], S0[4], S0[5], S0[6], S0[7]); Pf[2 * TILE][1] = sbat::cvt8(S0[8], S0[9], S0[10], S0[11], S0[12], S0[13], S0[14], S0[15]);
    Pf[2 * TILE + 1][0] = sbat::cvt8(S1[0], S1[1], S1[2], S1[3], S1[4], S1[5], S1[6], S1[7]); Pf[2 * TILE + 1][1] = sbat::cvt8(S1[8], S1[9], S1[10], S1[11], S1[12], S1[13], S1[14], S1[15]);
#pragma unroll
    for (int r = 0; r < 16; ++r) { S0[r] = 0.f; S1[r] = 0.f; }
}
template <int S> __device__ __forceinline__ void pv(f32x16 (&O)[4], const f16x8 (&Pf)[8][2], const LAS unsigned char* lds, int lane, int hi) {
    const int i16 = lane & 15, dhalf = (lane >> 4) & 1;
    const LAS unsigned char* va = lds + Step<S>::buf * BUFB + (4 * hi + (i16 >> 2)) * VST + (dhalf * 16 + 4 * (i16 & 3)) * 2;
#pragma unroll
    for (int dblk = 0; dblk < 4; ++dblk)
#pragma unroll
        for (int sb = 0; sb < 2; ++sb)
#pragma unroll
            for (int sp = 0; sp < 2; ++sp) { const LAS unsigned char* pp = va + (32 * sb + 16 * sp) * VST + dblk * 64; const s16x4 lo = sbat::vtr(pp), h4 = sbat::vtr(pp + 8 * VST);
                const bf16x8 vf = (bf16x8){lo[0], lo[1], lo[2], lo[3], h4[0], h4[1], h4[2], h4[3]};
                O[dblk] = SB_MFMA(__builtin_bit_cast(f16x8, vf), Pf[2 * Step<S>::tile + sb][sp], O[dblk]); }
}
}
__device__ __forceinline__ void phase_xattn(Frame& F) {
    using namespace xat;
    unsigned char* ws = F.ws; const bf16* q = (const bf16*)(ws + WS_Q); const bf16* kv = (const bf16*)(ws + WS_KV); bf16* o = (bf16*)(ws + WS_O);
    const int tid = F.tid, lane = F.lane, w = F.wave, t32 = lane & 31, hi = lane >> 5; LAS unsigned char* lds = F.lds;
    const unsigned loff = (unsigned)((tid >> 4) * 2048 + (tid & 15) * 8) * 2u, lk = (unsigned)((tid >> 4) * KST + (tid & 15) * 16), lv = (unsigned)((tid >> 4) * VST + (tid & 15) * 16);
    for (int unit = F.bx; unit < 512; unit += F.G) {
        const int bh = (unit & 255) >> 2, qblk = ((unit & 3) << 1) | (unit >> 8), b = bh >> 2, hd = bh & 3;
        const size_t tok0 = (size_t)b * SEQ + qblk * 256 + 32 * w;
        const bf16* kvb = kv + (size_t)b * MEML * 2048 + hd * 256;
        const rsrc_t kvr = __builtin_amdgcn_make_buffer_rsrc((void*)kvb, 0, 0x7fffffff, 0x00020000);
        f16x8 qf[16];
        { const bf16* qrow = q + (tok0 + t32) * D + hd * 256 + 8 * hi;
#pragma unroll
          for (int kk = 0; kk < 16; ++kk) qf[kk] = *(const f16x8*)(qrow + 16 * kk); }
        f16x8 Pf[8][2]; float mt[4]; float m = -INFINITY, sum = 0.f;
        f32x16 S0, S1;
#pragma unroll
        for (int r = 0; r < 16; ++r) { S0[r] = 0.f; S1[r] = 0.f; }
        u32x4 rA[2], rB[2];
        ld<0>(rA, kvr, loff); st<0>(rA, lds, lk, lv); ld<1>(rB, kvr, loff); __syncthreads();
#define XA_KSTEP(S_, RL, RS) ld<S_ + 2>(RL, kvr, loff); qk<S_>(S0, S1, qf, lds, t32, hi); if ((S_) & 1) smax<((S_) / 2)>(S0, S1, Pf, mt, m, sum); st<S_ + 1>(RS, lds, lk, lv); __syncthreads();
        XA_KSTEP(0, rA, rB) XA_KSTEP(1, rB, rA) XA_KSTEP(2, rA, rB) XA_KSTEP(3, rB, rA) XA_KSTEP(4, rA, rB) XA_KSTEP(5, rB, rA) XA_KSTEP(6, rA, rB) XA_KSTEP(7, rB, rA)
#undef XA_KSTEP
#pragma unroll
        for (int t = 0; t < 3; ++t) { const _Float16 f = (_Float16)__builtin_amdgcn_exp2f(mt[t] - m);
#pragma unroll
            for (int sb = 0; sb < 2; ++sb)
#pragma unroll
                for (int sp = 0; sp < 2; ++sp) Pf[2 * t + sb][sp] = Pf[2 * t + sb][sp] * f; }
        sum = xor32_sum(sum); const float inv = 1.0f / sum;
        LAS unsigned char* stg = lds + 3 * BUFB + w * (32 * OST);
#define XA_VSTEP(S_, RL, RS) ld<S_ + 2>(RL, kvr, loff); pv<S_>(O, Pf, lds, lane, hi); st<S_ + 1>(RS, lds, lk, lv); __syncthreads();
#pragma unroll
        for (int dh = 0; dh < 2; ++dh) {
            f32x16 O[4];
#pragma unroll
            for (int dblk = 0; dblk < 4; ++dblk)
#pragma unroll
                for (int r = 0; r < 16; ++r) O[dblk][r] = 0.f;
            if (dh == 0) { XA_VSTEP(8, rA, rB) XA_VSTEP(9, rB, rA) XA_VSTEP(10, rA, rB) XA_VSTEP(11, rB, rA) }
            else         { XA_VSTEP(12, rA, rB) XA_VSTEP(13, rB, rA) XA_VSTEP(14, rA, rB) XA_VSTEP(15, rB, rA) }
            int le = lane; asm volatile("" : "+v"(le));
            const int t32e = le & 31, hie = le >> 5;
#pragma unroll
            for (int db = 0; db < 4; ++db)
#pragma unroll
                for (int rq = 0; rq < 4; ++rq) { u32x2 v; v.x = pk2(O[db][4 * rq] * inv, O[db][4 * rq + 1] * inv); v.y = pk2(O[db][4 * rq + 2] * inv, O[db][4 * rq + 3] * inv);
                    *(LAS u32x2*)(stg + t32e * OST + (db * 32 + 8 * rq + 4 * hie) * 2) = v; }
            LDS_WAIT();
            const int ch = le & 15;
#pragma unroll
            for (int i = 0; i < 8; ++i) { const int row = i * 4 + (le >> 4); const u32x4 v = *(const LAS u32x4*)(stg + row * OST + ch * 16);
                *(u32x4*)(o + (tok0 + row) * D + hd * 256 + dh * 128 + ch * 8) = v; }
            LDS_WAIT();
        }
#undef XA_VSTEP
    }
}


namespace xat2 {
#define XA2_NPARK 7
__device__ __forceinline__ int lane_now() { int l; asm volatile("v_mbcnt_lo_u32_b32 %0, -1, 0\n\tv_mbcnt_hi_u32_b32 %0, -1, %0" : "=v"(l)); return l; }
__device__ __forceinline__ void dma_kv(const char* src0, LAS unsigned char* lds, int w, unsigned gofs) {
#pragma unroll
    for (int i = 0; i < 16; ++i) __builtin_amdgcn_global_load_lds((const unsigned*)(src0 + gofs + (size_t)i * 16 * 4096), (LAS unsigned*)(lds + (w + 8 * i) * 1024), 16, 0, 0);
}
}
__device__ __forceinline__ void phase_xattn2(Frame& F) {
    using namespace xat;
    unsigned char* ws = F.ws; const bf16* q = (const bf16*)(ws + WS_Q); const bf16* kv = (const bf16*)(ws + WS_KV); bf16* o = (bf16*)(ws + WS_O);
    const int w = F.wave; LAS unsigned char* lds = F.lds;
#define XA2_GOFS(L) ((unsigned)(2 * w + ((L) >> 5)) * 4096u + 16u * (unsigned)(((L) & 31) ^ (((2 * (w & 1) + ((L) >> 5)) << 2) | ((w >> 1) & 3))))
    for (int cu = F.bx; cu < 256; cu += F.G) {
        const int bh = cu >> 2, qp = cu & 3, b = bh >> 2, hd = bh & 3;
        const char* kvb = (const char*)(kv + (size_t)b * MEML * 2048 + hd * 256);
        const size_t tokA = (size_t)b * SEQ + 512 * qp + 32 * w;
        int lane = xat2::lane_now();
        xat2::dma_kv(kvb, lds, w, XA2_GOFS(lane));
        lane = xat2::lane_now();
        const int t32 = lane & 31, hi = lane >> 5;
        const int kA = t32 * 512 + ((hi ^ (((t32 & 3) << 2) | ((t32 >> 2) & 3))) << 4);
        f16x8 PfA[8][2], PfB[8][2]; float invA = 0.f, invB = 0.f;
#define XA2_LOADQ(TOK0) { const bf16* qrow = q + ((TOK0) + t32) * D + hd * 256 + 8 * hi; _Pragma("unroll") for (int kk = 0; kk < 16; ++kk) qf[kk] = *(const f16x8*)(qrow + 16 * kk); }
#define XA2_QK(PF, INV) do { \
            float mt[4]; float m = -INFINITY, sum = 0.f; f32x16 S0, S1; _Pragma("unroll") for (int r = 0; r < 16; ++r) { S0[r] = 0.f; S1[r] = 0.f; } \
            XA2_QKT(PF, 0) XA2_QKT(PF, 1) XA2_QKT(PF, 2) XA2_QKT(PF, 3) \
            _Pragma("unroll") for (int t = 0; t < 3; ++t) { const _Float16 f = (_Float16)__builtin_amdgcn_exp2f(mt[t] - m); _Pragma("unroll") for (int sb = 0; sb < 2; ++sb) _Pragma("unroll") for (int sp = 0; sp < 2; ++sp) PF[2 * t + sb][sp] = PF[2 * t + sb][sp] * f; } \
            sum = xor32_sum(sum); INV = 1.0f / sum; } while (0)
#define XA2_RDB(G) { _Pragma("unroll") for (int j = 0; j < XA2_NB; ++j) { const int kk = (G) * XA2_NB + j; kb[(G) & XA2_PIPE][j][0] = *(const LAS f16x8*)(lds + (kAt ^ (32 * kk))); kb[(G) & XA2_PIPE][j][1] = *(const LAS f16x8*)(lds + ((kAt + 32 * 512) ^ (32 * kk))); } }
#define XA2_QKT(PF, T) { int kAt = kA + (64 * (T)) * 512; asm volatile("" : "+v"(kAt)); f16x8 kb[XA2_PIPE + 1][XA2_NB][2]; \
            if (XA2_PIPE) { XA2_RDB(0) } \
            _Pragma("unroll") for (int g = 0; g < 16 / XA2_NB; ++g) { \
                if (XA2_PIPE) { if (g + 1 < 16 / XA2_NB) { XA2_RDB(g + 1) } } else { XA2_RDB(g) } \
                __builtin_amdgcn_sched_barrier(0); \
                _Pragma("unroll") for (int j = 0; j < XA2_NB; ++j) { S0 = SB_MFMA(kb[g & XA2_PIPE][j][0], qf[g * XA2_NB + j], S0); S1 = SB_MFMA(kb[g & XA2_PIPE][j][1], qf[g * XA2_NB + j], S1); } \
                __builtin_amdgcn_sched_barrier(0); } \
            smax<T>(S0, S1, PF, mt, m, sum); __builtin_amdgcn_sched_barrier(0); }
        f16x8 qf[16];
        XA2_LOADQ(tokA);
        asm volatile("s_waitcnt vmcnt(0)" ::: "memory"); __syncthreads();
#define XA2_NB 4
#define XA2_PIPE 1
        XA2_QK(PfA, invA);
#undef XA2_NB
#undef XA2_PIPE
#define XA2_NB 2
#define XA2_PIPE 0
        XA2_LOADQ(tokA + 256);
        u32x4* pscr = (u32x4*)(ws + WS_QCV) + (size_t)cu * XA2_NPARK * NTHREADS + (w * 64 + xat2::lane_now());
#pragma unroll
        for (int i = 0; i < XA2_NPARK; ++i) pscr[i * NTHREADS] = __builtin_bit_cast(u32x4, PfA[i >> 1][i & 1]);
        XA2_QK(PfB, invB);
#undef XA2_NB
#undef XA2_PIPE
#undef XA2_RDB
#undef XA2_QK
#undef XA2_LOADQ
#undef XA2_QKT
        __syncthreads();
        { const int l2 = xat2::lane_now(); xat2::dma_kv(kvb + 2048, lds, w, XA2_GOFS(l2)); }
        asm volatile("s_waitcnt vmcnt(0)" ::: "memory"); __syncthreads();
        const int l3 = xat2::lane_now();
        const int i16 = l3 & 15, q4 = i16 >> 2, p4 = i16 & 3, dhalf = (l3 >> 4) & 1, hi3 = l3 >> 5;
        const int vA = (4 * hi3 + q4) * 512 + ((q4 << 6) | ((((dhalf << 1) | (p4 >> 1)) ^ hi3) << 4) | ((p4 & 1) << 3));
        LAS unsigned char* stg = lds + RING_BYTES + w * 2560;
#define XA2_PV(PF, INV, TOK0) do { _Pragma("unroll") for (int dh = 0; dh < 2; ++dh) { f32x16 O[4]; _Pragma("unroll") for (int db = 0; db < 4; ++db) _Pragma("unroll") for (int r = 0; r < 16; ++r) O[db][r] = 0.f; \
            _Pragma("unroll") for (int T = 0; T < 4; ++T) { int vAt = vA + 64 * T * 512; asm volatile("" : "+v"(vAt)); _Pragma("unroll") for (int db = 0; db < 4; ++db) _Pragma("unroll") for (int sb = 0; sb < 2; ++sb) _Pragma("unroll") for (int sp = 0; sp < 2; ++sp) { \
                const int rows0 = (32 * sb + 16 * sp) * 512, dx = (4 * dh + db) * 64; \
                const s16x4 lo = sbat::vtr(lds + ((vAt + rows0) ^ dx)), h4 = sbat::vtr(lds + ((vAt + rows0 + 8 * 512) ^ dx ^ 32)); \
                const bf16x8 vf = (bf16x8){lo[0], lo[1], lo[2], lo[3], h4[0], h4[1], h4[2], h4[3]}; \
                O[db] = SB_MFMA(__builtin_bit_cast(f16x8, vf), PF[2 * T + sb][sp], O[db]); if (sb == 1 && sp == 1) __builtin_amdgcn_sched_barrier(0); } } \
            const int le = xat2::lane_now(); const int t32e = le & 31, hie = le >> 5; \
            _Pragma("unroll") for (int db = 0; db < 4; ++db) { \
              if (F8_MO) { \
                _Pragma("unroll") for (int rq = 0; rq < 4; ++rq) *(LAS unsigned*)(stg + t32e * 48 + 8 * rq + 4 * hie) = f8x4(O[db][4 * rq] * ((INV) * F8_HSCALE), O[db][4 * rq + 1] * ((INV) * F8_HSCALE), O[db][4 * rq + 2] * ((INV) * F8_HSCALE), O[db][4 * rq + 3] * ((INV) * F8_HSCALE)); \
                LDS_WAIT(); \
                { const int row = le >> 1, hf = le & 1; const u32x4 v = *(const LAS u32x4*)(stg + row * 48 + hf * 16); \
                    *(u32x4*)((unsigned char*)o + ((TOK0) + row) * D + hd * 256 + (4 * dh + db) * 32 + hf * 16) = v; } \
                LDS_WAIT(); \
              } else { \
                _Pragma("unroll") for (int rq = 0; rq < 4; ++rq) { u32x2 v; v.x = pk2(O[db][4 * rq] * (INV), O[db][4 * rq + 1] * (INV)); v.y = pk2(O[db][4 * rq + 2] * (INV), O[db][4 * rq + 3] * (INV)); \
                    *(LAS u32x2*)(stg + t32e * 80 + (8 * rq + 4 * hie) * 2) = v; } \
                LDS_WAIT(); \
                _Pragma("unroll") for (int i = 0; i < 2; ++i) { const int row = (le >> 2) + 16 * i, ch = le & 3; const u32x4 v = *(const LAS u32x4*)(stg + row * 80 + ch * 16); \
                    *(u32x4*)(o + ((TOK0) + row) * D + hd * 256 + (4 * dh + db) * 32 + ch * 8) = v; } \
                LDS_WAIT(); } } } } while (0)
        XA2_PV(PfB, invB, tokA + 256);
#pragma unroll
        for (int i = 0; i < XA2_NPARK; ++i) PfA[i >> 1][i & 1] = __builtin_bit_cast(f16x8, pscr[i * NTHREADS]);
        XA2_PV(PfA, invA, tokA);
#undef XA2_PV
#undef XA2_GOFS
        __syncthreads();
    }
}

__device__ __forceinline__ void phase_gates(Frame& F) {
    unsigned char* ws = F.ws; const bf16* xbp = (const bf16*)(ws + WS_XB); const bf16* wg = (const bf16*)(ws + WS_WIN) + (size_t)NPROJ * D; const float* ssq = (const float*)(ws + WS_SSQ); float* gates = (float*)(ws + WS_GATES);
    const int tid = F.tid, lane = F.lane, w = F.wave, l16 = lane & 15, g = lane >> 4, tpb = NTOK / F.G; LAS unsigned char* lds = F.lds;
    constexpr int WST = 2064;
    for (int e = tid; e < 16 * 128; e += NTHREADS) { const int n = e >> 7, k8 = (e & 127) * 8; u32x4 o_ = (u32x4){0u, 0u, 0u, 0u}; if (n < 8) o_ = *(const u32x4*)(wg + (size_t)n * D + k8); *(LAS u32x4*)(lds + n * WST + k8 * 2) = o_; }
    __syncthreads();
    for (int t0 = w * 16; t0 < tpb; t0 += NWAVES * 16) { const int tokb = F.bx * tpb + t0;
        f32x4 acc = (f32x4){0.f, 0.f, 0.f, 0.f}; const bf16* xrow = xbp + (size_t)(tokb + l16) * D + 8 * g;
#pragma unroll
        for (int kb = 0; kb < 2; ++kb) { f16x8 af[16];
#pragma unroll
            for (int j = 0; j < 16; ++j) af[j] = *(const f16x8*)(xrow + 32 * (16 * kb + j));
#pragma unroll
            for (int j = 0; j < 16; ++j) { const int kk = 16 * kb + j; const f16x8 b0 = *(const LAS f16x8*)(lds + l16 * WST + (32 * kk + 8 * g) * 2); acc = ML_MFMA(af[j], b0, acc); } }
        if (l16 < 8) {
#pragma unroll
            for (int r = 0; r < 4; ++r) gates[(size_t)(tokb + 4 * g + r) * 8 + l16] = acc[r] * pg8::rstd_from_ssq(ssq, tokb + 4 * g + r); } }
    __syncthreads();
}

__device__ __forceinline__ void phase_router1(Frame& F, int l) {
    unsigned char* ws = F.ws; const bf16* xbp = (const bf16*)(ws + WS_XB); const float* wr = (const float*)(ws + WS_WR); const float* ssq = (const float*)(ws + WS_SSQ);
    u32x4* tokinfo = (u32x4*)(ws + WS_TOKINFO); int* cntb = (int*)(ws + WS_CNTB); unsigned char* xq8 = ws + WS_XQ8; const bool f8 = layer_f8(l);
    const int tid = F.tid, lane = F.lane, w = F.wave, l16 = lane & 15, g = lane >> 4, tpb = NTOK / F.G; LAS unsigned char* lds = F.lds;
    constexpr int WST = 2064;
    LAS int* clsL = (LAS int*)(lds + SCR_OFF); LAS float* fL = (LAS float*)(lds + SCR_OFF + 2048); LAS float* lgL = (LAS float*)(lds + 32 * WST) + w * 512;
    for (int e = tid; e < 32 * 128; e += NTHREADS) { const int n = e >> 7, k8 = (e & 127) * 8; u32x4 o_ = (u32x4){0u, 0u, 0u, 0u};
        if (n < 20) { const f32x4 a0 = *(const f32x4*)(wr + n * D + k8), a1 = *(const f32x4*)(wr + n * D + k8 + 4); o_.x = pk2(a0[0], a0[1]); o_.y = pk2(a0[2], a0[3]); o_.z = pk2(a1[0], a1[1]); o_.w = pk2(a1[2], a1[3]); }
        *(LAS u32x4*)(lds + n * WST + k8 * 2) = o_; }
    __syncthreads();
    for (int t0 = w * 16; t0 < tpb; t0 += NWAVES * 16) { const int tokb = F.bx * tpb + t0;
        f32x4 acc0 = (f32x4){0.f, 0.f, 0.f, 0.f}, acc1 = acc0; const bf16* xrow = xbp + (size_t)(tokb + l16) * D + 8 * g;
#pragma unroll
        for (int kb = 0; kb < 4; ++kb) { f16x8 af[8];
#pragma unroll
            for (int j = 0; j < 8; ++j) af[j] = *(const f16x8*)(xrow + 32 * (8 * kb + j));
            if (f8) {
#pragma unroll
                for (int j = 0; j < 8; ++j) { u32x2 o; o.x = f8x4((float)af[j][0], (float)af[j][1], (float)af[j][2], (float)af[j][3]); o.y = f8x4((float)af[j][4], (float)af[j][5], (float)af[j][6], (float)af[j][7]);
                    *(u32x2*)(xq8 + (size_t)(tokb + l16) * D + 32 * (8 * kb + j) + 8 * g) = o; } }
#pragma unroll
            for (int j = 0; j < 8; ++j) { const int kk = 8 * kb + j; const f16x8 b0 = *(const LAS f16x8*)(lds + l16 * WST + (32 * kk + 8 * g) * 2), b1 = *(const LAS f16x8*)(lds + (16 + l16) * WST + (32 * kk + 8 * g) * 2);
                acc0 = ML_MFMA(af[j], b0, acc0); acc1 = ML_MFMA(af[j], b1, acc1); } }
        const float bias0 = wr[20 * D + l16], bias1 = l16 < 4 ? wr[20 * D + 16 + l16] : 0.f;
#pragma unroll
        for (int r = 0; r < 4; ++r) { const float rs = pg8::rstd_from_ssq(ssq, tokb + 4 * g + r); lgL[(4 * g + r) * 32 + l16] = acc0[r] * rs + bias0; lgL[(4 * g + r) * 32 + 16 + l16] = acc1[r] * rs + bias1; }
        LDS_WAIT();
        if (lane < 16) { const LAS float* lp = lgL + lane * 32; const f32x4 lg = *(const LAS f32x4*)lp; const int tok = tokb + lane;
            int gs = 0; float gm = lg[0];
#pragma unroll
            for (int j = 1; j < 4; ++j) if (lg[j] > gm) { gm = lg[j]; gs = j; }
            float gsum = 0.f;
#pragma unroll
            for (int j = 0; j < 4; ++j) gsum += __expf(lg[j] - gm);
            const float psel = 1.f / gsum; const f32x4 es = *(const LAS f32x4*)(lp + 4 + 4 * gs);
            int i0 = 0; float m0 = es[0];
#pragma unroll
            for (int e = 1; e < 4; ++e) if (es[e] > m0) { m0 = es[e]; i0 = e; }
            int i1 = -1; float m1 = -INFINITY;
#pragma unroll
            for (int e = 0; e < 4; ++e) if (e != i0 && es[e] > m1) { m1 = es[e]; i1 = e; }
            const float e1 = __expf(m1 - m0); const float w0 = 1.f / (1.f + e1), w1 = e1 / (1.f + e1);
            const int ea = i0 < i1 ? i0 : i1, eb = i0 < i1 ? i1 : i0; const float ga = psel * (i0 < i1 ? w0 : w1), gb = psel * (i0 < i1 ? w1 : w0);
            const int lt = t0 + lane; clsL[lt] = gs * 6 + pair_index(ea, eb); fL[lt] = ga; fL[tpb + lt] = gb; fL[2 * tpb + lt] = pg8::rstd_from_ssq(ssq, tok); }
        LDS_WAIT(); }
    __syncthreads();
    if (F.tid < tpb) { const int c = clsL[F.tid]; int rank = 0; for (int t = 0; t < F.tid; ++t) rank += (clsL[t] == c) ? 1 : 0;
        tokinfo[F.bx * tpb + F.tid] = (u32x4){(unsigned)c | ((unsigned)rank << 8), __float_as_uint(fL[F.tid]), __float_as_uint(fL[tpb + F.tid]), __float_as_uint(fL[2 * tpb + F.tid])}; }
    if (F.tid >= 256 && F.tid < 256 + 32) { const int c = F.tid - 256; int n = 0; if (c < NCLS) for (int t = 0; t < tpb; ++t) n += (clsL[t] == c) ? 1 : 0; cntb[F.bx * 32 + c] = n; }
}
__device__ __forceinline__ void phase_router2(Frame& F, int l) {
    unsigned char* ws = F.ws; const u32x4* tokinfo = (const u32x4*)(ws + WS_TOKINFO); const int* cntb = (const int*)(ws + WS_CNTB);
    int* tokl = (int*)(ws + WS_SLOT); float* gwa = (float*)(ws + WS_SLOT + SLOT_ARR); float* gwb = (float*)(ws + WS_SLOT + 2 * SLOT_ARR); float* rsl = (float*)(ws + WS_SLOT + 3 * SLOT_ARR);
    const int tpb = NTOK / F.G; LAS int* baseL = (LAS int*)(F.lds + SCR_OFF);
    { const int c = F.tid & 31, part = F.tid >> 5; int acc = 0; for (int b2 = part; b2 < F.bx; b2 += 16) acc += cntb[b2 * 32 + c];
      ((LAS int*)(F.lds + SCR_OFF + 1024))[part * 32 + c] = acc; }
    __syncthreads();
    if (F.tid < 32) { int acc = 0;
#pragma unroll
        for (int part = 0; part < 16; ++part) acc += ((LAS int*)(F.lds + SCR_OFF + 1024))[part * 32 + F.tid]; baseL[F.tid] = acc;
        if (F.bx == F.G - 1 && F.tid < NCLS) F.ctl[CW_CNT + l * 32 + F.tid] = (unsigned)(acc + cntb[F.bx * 32 + F.tid]); }
    __syncthreads();
    if (F.tid < tpb) { const int tok = F.bx * tpb + F.tid; const u32x4 inf = tokinfo[tok]; const int cls = inf.x & 255, rank = inf.x >> 8;
        const size_t o = (size_t)cls * CLSCAP + baseL[cls] + rank; tokl[o] = tok; gwa[o] = __uint_as_float(inf.y); gwb[o] = __uint_as_float(inf.z); rsl[o] = __uint_as_float(inf.w); }
}

__device__ __forceinline__ const char* uni_ptr(const char* p) { const unsigned long long v = (unsigned long long)p; const unsigned lo = __builtin_amdgcn_readfirstlane((unsigned)v), hi = __builtin_amdgcn_readfirstlane((unsigned)(v >> 32)); return (const char*)(((unsigned long long)hi << 32) | lo); }
struct SchedMoe {
    const LAS int* tb; const unsigned* cnt; const char* A; const char* B; const int* tokl; int ncol, G, c, nwg; bool up; int eb;
    __device__ __forceinline__ bool next(int i, pg8::Unit& u) const {
        const long L = (long)i * G + c; if (L >= nwg) return false;
        const int id = pg8::xcd_remap((int)L, nwg); const int rt = id / ncol, ct = id % ncol;
        int cls = 0;
#pragma unroll 1
        for (int k = 1; k < NCLS; ++k) if (rt >= tb[k]) cls = k;
        const int slot0 = (rt - tb[cls]) * 256; const int g = cls / 6, pr = cls % 6;
        const int ea = pr < 3 ? 0 : (pr < 5 ? 1 : 2), eb = pr < 3 ? pr + 1 : (pr < 5 ? pr - 1 : 3);
        u.pm = rt; u.pn = ct; u.cls = cls; u.slot0 = slot0; u.nvalid = (int)cnt[cls] - slot0; u.rows = tokl + (size_t)cls * CLSCAP + slot0;
        if (up) { const int ge = g * 4 + (ct < 4 ? ea : eb); u.a = A; u.b = B + ((size_t)ge * 1024 + (ct & 3) * 256) * (size_t)(D * this->eb); }
        else { u.a = A + (size_t)rt * 256 * 1024 * this->eb; u.b = B + ((size_t)cls * 1024 + ct * 256) * (size_t)(1024 * this->eb); }
        u.a = uni_ptr(u.a); u.b = uni_ptr(u.b); u.rows = (const int*)uni_ptr((const char*)u.rows);
        u.pm = __builtin_amdgcn_readfirstlane(u.pm); u.pn = __builtin_amdgcn_readfirstlane(u.pn); u.cls = __builtin_amdgcn_readfirstlane(u.cls); u.slot0 = __builtin_amdgcn_readfirstlane(u.slot0); u.nvalid = __builtin_amdgcn_readfirstlane(u.nvalid);
        return true;
    }
};

__global__ void __launch_bounds__(NTHREADS, 2) hyb_fwd(Args args) {
    extern __shared__ __attribute__((aligned(16))) unsigned char lds[];
    Frame F;
    F.lds = (LAS unsigned char*)lds; F.MISC = (volatile LAS unsigned*)(F.lds + MISC_OFF);
    F.tid = threadIdx.x; F.lane = F.tid & 63; F.wave = __builtin_amdgcn_readfirstlane(F.tid >> 6); F.G = gridDim.x; F.bx = blockIdx.x;
    F.ws = args.ws; F.ctl = (unsigned*)(args.ws + WS_CTL); F.out = args.out;
    for (int u = F.tid; u < (PTAB_OFF - LDSCTL_OFF) / 4; u += NTHREADS) ((LAS unsigned*)(F.lds + LDSCTL_OFF))[u] = 0u;
    if (F.tid == 0) {
#pragma unroll
        for (int i = 0; i < 26; ++i) ((LAS unsigned long long*)(F.lds + PTAB_OFF))[i] = (unsigned long long)args.in[i]; }
    __syncthreads();
    XcdBarrier bar; bar.bar = F.ctl + CW_BAR; bar.x = 0; bar.st = nullptr;
    const bool one_launch = (args.ph_hi - args.ph_lo) > 1;
    if (one_launch) bar = xcd_barrier_post(F.ctl + CW_BAR, F.MISC + 8);
    const int wave0 = __builtin_amdgcn_readfirstlane((int)threadIdx.x >> 6);
    for (int ph = args.ph_lo; ph < args.ph_hi; ++ph) {
        {
          GAS unsigned char* w_ = (GAS unsigned char*)args.ws; asm volatile("" : "+s"(w_)); F.ws = (unsigned char*)w_; F.ctl = (unsigned*)(F.ws + WS_CTL);
          GAS float* o_ = (GAS float*)args.out; asm volatile("" : "+s"(o_)); F.out = (float*)o_;
          unsigned lb_ = 0; asm volatile("" : "+s"(lb_)); F.lds = (LAS unsigned char*)lds + lb_; F.MISC = (volatile LAS unsigned*)(F.lds + MISC_OFF);
          int g_ = gridDim.x, b_ = blockIdx.x; asm volatile("" : "+s"(g_), "+s"(b_)); F.G = g_; F.bx = b_; }
        unsigned char* ws = F.ws;
        bf16* xb = (bf16*)(ws + WS_XB); float* ssq = (float*)(ws + WS_SSQ);
        const int l = ph / PH_PER_LAYER, p = ph % PH_PER_LAYER;
#define PH_BEGIN() do { int wv_ = wave0; unsigned z_ = 0u; asm volatile("" : "+s"(wv_), "+s"(z_)); F.lane = (int)__builtin_amdgcn_mbcnt_hi(~0u, __builtin_amdgcn_mbcnt_lo(~0u, z_)); F.wave = wv_; F.tid = wv_ * 64 + F.lane; } while (0)
        if (ph != PH_FINAL && ((p == 12 && l + 1 < DEPTH) || (p == 2 && l == 0))) {
            PH_BEGIN();
            const int lk = (p == 12) ? l + 1 : 0;
            pg8::SchedKv K; K.A2 = (const char*)(ws + WS_MEMB8); K.B2 = (const char*)(ws + ((lk & 1) ? WS_WMKV2 : WS_WMKV)); K.G = F.G; K.c = F.bx; K.tstep = (size_t)256 * D;
            pg8::EpiScaleBf16 EK{nullptr, 0, ssq, nullptr, nullptr, 14, (bf16*)(ws + WS_KV), 2048, (const float*)(ws + WS_MEMR), 1.0f / F8_WSCALE};
            pg8::gemm_phase<pg8::EpiScaleBf16, pg8::SchedKv, false, true>(F.lds, F.tid, D / 2, K, EK);
            __syncthreads();
        }
        if (ph == PH_FINAL) {
            PH_BEGIN();
            const float* g = F.in_(25); const int gw = F.bx * NWAVES + F.wave, NGW = F.G * NWAVES;
            for (int m = gw; m < NTOK; m += NGW) { const u32x4* xr = (const u32x4*)(xb + (size_t)m * D) + F.lane; float v[16]; float s_ = 0.f;
#pragma unroll
                for (int j = 0; j < 2; ++j) { const u32x4 q_ = xr[64 * j]; v[8 * j] = bflo(q_.x); v[8 * j + 1] = bfhi(q_.x); v[8 * j + 2] = bflo(q_.y); v[8 * j + 3] = bfhi(q_.y); v[8 * j + 4] = bflo(q_.z); v[8 * j + 5] = bfhi(q_.z); v[8 * j + 6] = bflo(q_.w); v[8 * j + 7] = bfhi(q_.w); }
#pragma unroll
                for (int e = 0; e < 16; ++e) s_ += v[e] * v[e];
                const float r = rsqrtf(wave_sum(s_) * (1.0f / D) + EPS);
#pragma unroll
                for (int j = 0; j < 2; ++j) { const f32x4 g0 = ((const f32x4*)g)[128 * j + 2 * F.lane], g1 = ((const f32x4*)g)[128 * j + 2 * F.lane + 1]; f32x4* op = (f32x4*)(F.out + (size_t)m * D) + 128 * j + 2 * F.lane;
                    op[0] = (f32x4){v[8 * j] * r * g0[0], v[8 * j + 1] * r * g0[1], v[8 * j + 2] * r * g0[2], v[8 * j + 3] * r * g0[3]}; op[1] = (f32x4){v[8 * j + 4] * r * g1[0], v[8 * j + 5] * r * g1[1], v[8 * j + 6] * r * g1[2], v[8 * j + 7] * r * g1[3]}; } }
        } else if (p == 0) {
            PH_BEGIN(); phase_convert(F, l);
        } else if (p == 1) {
            PH_BEGIN();
            phase_gates(F);
            { pg8::SchedInKv S; S.A = (const char*)xb; S.B = (const char*)(ws + WS_WIN); S.A2 = (const char*)(ws + WS_MEMB); S.B2 = (const char*)(ws + WS_WMKV); S.G = F.G; S.c = F.bx; S.tstep = (size_t)256 * D * 2;
              S.ncol = 14; S.nkv = 0;
              pg8::EpiScaleBf16 E{(bf16*)(ws + WS_PROJ), NPROJ, ssq, nullptr, (float*)(ws + WS_GATES), 14, (bf16*)(ws + WS_KV), 2048, (const float*)(ws + WS_MEMR)};
              pg8::gemm_phase<pg8::EpiScaleBf16, pg8::SchedInKv, false>(F.lds, F.tid, D, S, E); }
        } else if (p == 2) {
            PH_BEGIN(); phase_mixer(F, l, l, args.mode);
        } else if (p == 3) {
            PH_BEGIN(); phase_ml_scan(F);
        } else if (p == 4) {
            PH_BEGIN();
            X3Pf pf; x3_load(F, F.bx, pf);
            for (int it = F.bx; it < 1024; it += F.G) { Frame G = F;
                { int t_ = F.wave * 64 + pg8::lane_fresh(); G.tid = t_; G.lane = t_ & 63; G.wave = __builtin_amdgcn_readfirstlane(t_ >> 6);
                  unsigned lb_ = 0; asm volatile("" : "+s"(lb_)); G.lds = F.lds + lb_;
                  GAS unsigned char* w_ = (GAS unsigned char*)F.ws; asm volatile("" : "+s"(w_)); G.ws = (unsigned char*)w_; }
                ml_x3(G, l, it, pf, (it + F.G < 1024) ? it + F.G : -1); }
        } else if (p == 5 || p == 8) {
            PH_BEGIN();
            if (p == 8 && F8_MO) { pg8::SchedDense S; S.init(ws + WS_O, ws + WS_WMO, NTOK, D, D / 2, F.G, F.bx);
                pg8::EpiRes<false, true> E{xb, ssq, args.mode == 2};
                pg8::gemm_phase<pg8::EpiRes<false, true>, pg8::SchedDense, false, true>(F.lds, F.tid, D / 2, S, E); }
            else { pg8::SchedDense S; S.init(p == 5 ? ws + WS_Y : ws + WS_O, p == 5 ? ws + WS_WOUT : ws + WS_WMO, NTOK, D, D, F.G, F.bx);
                pg8::EpiRes<false> E{xb, ssq, args.mode == 2, (p == 5 && F8_Q) ? ws + WS_XQ8 : nullptr};
                pg8::gemm_phase<pg8::EpiRes<false>, pg8::SchedDense, false>(F.lds, F.tid, D, S, E); }
        } else if (p == 6) {
            PH_BEGIN();
            if (F8_Q) { pg8::SchedDense S; S.init(ws + WS_XQ8, ws + WS_WMQ, NTOK, D, D / 2, F.G, F.bx);
                pg8::EpiScaleBf16 E{(bf16*)(ws + WS_Q), D, ssq, nullptr, nullptr, 1 << 30, nullptr, 0, nullptr, 1.0f / F8_WSCALE};
                pg8::gemm_phase<pg8::EpiScaleBf16, pg8::SchedDense, false, true>(F.lds, F.tid, D / 2, S, E); }
            else { pg8::SchedDense S; S.init(xb, ws + WS_WMQ, NTOK, D, D, F.G, F.bx);
                pg8::EpiScaleBf16 E{(bf16*)(ws + WS_Q), D, ssq, nullptr, nullptr, 1 << 30, nullptr, 0, nullptr};
                pg8::gemm_phase<pg8::EpiScaleBf16, pg8::SchedDense, false>(F.lds, F.tid, D, S, E); }
        } else if (p == 7) {
            PH_BEGIN(); phase_xattn2(F);
        } else if (p == 9) {
            PH_BEGIN(); phase_router1(F, l);
        } else if (p == 10) {
            PH_BEGIN(); phase_router2(F, l);
        } else {
            PH_BEGIN();
            LAS int* tb = (LAS int*)(F.lds + SCR_OFF); const unsigned* cnt = F.ctl + CW_CNT + l * 32;
            __syncthreads();
            if (F.tid == 0) { int acc = 0; for (int k = 0; k < NCLS; ++k) { tb[k] = acc; acc += ((int)__hip_atomic_load(cnt + k, RLX_AGENT) + 255) >> 8; } tb[NCLS] = acc; }
            __syncthreads();
            SchedMoe S; S.tb = tb; S.cnt = cnt; S.tokl = (const int*)(ws + WS_SLOT); S.G = F.G; S.c = F.bx; S.up = (p == 11);
            const bool f8 = layer_f8(l); S.eb = f8 ? 1 : 2;
            if (p == 11) { S.ncol = 8; S.nwg = tb[NCLS] * 8; S.A = f8 ? (const char*)(ws + WS_XQ8) : (const char*)xb; S.B = (const char*)(ws + WS_W13);
                if (f8) { pg8::EpiMoe1<true> E{(bf16*)(ws + WS_HID), (const float*)(ws + WS_SLOT + 3 * SLOT_ARR), (const float*)(ws + WS_SLOT + SLOT_ARR), (const float*)(ws + WS_SLOT + 2 * SLOT_ARR)};
                    pg8::gemm_phase<pg8::EpiMoe1<true>, SchedMoe, true, true>(F.lds, F.tid, D / 2, S, E); }
                else { pg8::EpiMoe1<false> E{(bf16*)(ws + WS_HID), (const float*)(ws + WS_SLOT + 3 * SLOT_ARR), (const float*)(ws + WS_SLOT + SLOT_ARR), (const float*)(ws + WS_SLOT + 2 * SLOT_ARR)};
                    pg8::gemm_phase<pg8::EpiMoe1<false>, SchedMoe, true, false>(F.lds, F.tid, D, S, E); } }
            else { S.ncol = 4; S.nwg = tb[NCLS] * 4; S.A = (const char*)(ws + WS_HID); S.B = (const char*)(ws + WS_W2C);
                if (f8) { pg8::EpiRes<true, true> E{xb, ssq, args.mode == 2}; pg8::gemm_phase<pg8::EpiRes<true, true>, SchedMoe, false, true>(F.lds, F.tid, 512, S, E); }
                else { pg8::EpiRes<true, false> E{xb, ssq, args.mode == 2}; pg8::gemm_phase<pg8::EpiRes<true, false>, SchedMoe, false, false>(F.lds, F.tid, 1024, S, E); }
 }
            __syncthreads();
        }
        if (ph + 1 < args.ph_hi) xcd_barrier(bar);
    }
}

extern "C" void kernel_launch(void* const* d_in, const int* in_sizes, int n_in, void* d_out, int out_size, void* d_ws, size_t ws_size, hipStream_t stream) {
    static int grid = 0;
    if (grid == 0) {
        if (n_in != 26 || in_sizes[0] != NTOK * D || out_size != NTOK * D || ws_size < WS_END) { fprintf(stderr, "kernel_launch: unexpected shapes (n_in %d, in0 %d, out %d, ws %zu, need %zu); nothing launched\n", n_in, n_in > 0 ? in_sizes[0] : -1, out_size, ws_size, (size_t)WS_END); grid = -1; return; }
        int dev = 0, cus = 0;
        if (hipGetDevice(&dev) != hipSuccess || hipDeviceGetAttribute(&cus, hipDeviceAttributeMultiprocessorCount, dev) != hipSuccess) { grid = -1; return; }
        if (hipFuncSetAttribute((const void*)hyb_fwd, hipFuncAttributeMaxDynamicSharedMemorySize, LDS_BYTES) != hipSuccess) { fprintf(stderr, "kernel_launch: hipFuncSetAttribute failed\n"); grid = -1; return; }
        int per_cu = 0;
        if (hipOccupancyMaxActiveBlocksPerMultiprocessor(&per_cu, (const void*)hyb_fwd, NTHREADS, LDS_BYTES) != hipSuccess || per_cu < 1) fprintf(stderr, "kernel_launch: occupancy query reports %d\n", per_cu);
        (void)hipGetLastError();
        grid = cus >= 256 ? 256 : (cus >= 128 ? 128 : 64);
    }
    if (grid < 0) return;
    (void)hipMemsetAsync((char*)d_ws + WS_CTL, 0, CTL_ZERO_BYTES, stream);
    Args a{};
    for (int i = 0; i < 26; ++i) a.in[i] = (const float*)d_in[i];
    a.out = (float*)d_out; a.ws = (unsigned char*)d_ws;
#if MK_N_LAUNCHES == 1
    a.ph_lo = 0; a.ph_hi = N_PHASES;
    hipLaunchKernelGGL(hyb_fwd, dim3(grid), dim3(NTHREADS), LDS_BYTES, stream, a);
#else
    for (int ph = 0; ph < N_PHASES; ++ph) {
        a.ph_lo = ph; a.ph_hi = ph + 1; hipLaunchKernelGGL(hyb_fwd, dim3(grid), dim3(NTHREADS), LDS_BYTES, stream, a);
        if (MK_REPEAT_P >= 0 && ph != PH_FINAL && ph % PH_PER_LAYER == MK_REPEAT_P) {
            if (MK_REPEAT_P == 2) (void)hipMemsetD32Async((hipDeviceptr_t)((char*)d_ws + WS_CTL + (CW_Q + ph / PH_PER_LAYER) * 4), MK_PROBE_QSTART, 1, stream);
            a.mode = MK_PROBE_MODE; hipLaunchKernelGGL(hyb_fwd, dim3(grid), dim3(NTHREADS), LDS_BYTES, stream, a); a.mode = 0; } }
#endif
}
```

```cpp
#include <hip/hip_runtime.h>
#include <cstdio>
#include <cstdint>

#ifndef MK_N_LAUNCHES
#define MK_N_LAUNCHES 1
#endif

#ifndef MK_PROBE_QSTART
#define MK_PROBE_QSTART 0
#endif
#ifndef MK_PROBE_MODE
#define MK_PROBE_MODE 0
#endif
#ifndef MK_REPEAT_P
#define MK_REPEAT_P (-1)
#endif
#define LAS __attribute__((address_space(3)))
#define GAS __attribute__((address_space(1)))
typedef unsigned short bf16;
typedef short bf16x8 __attribute__((ext_vector_type(8)));
typedef float f32x4 __attribute__((ext_vector_type(4)));
typedef float f32x2 __attribute__((ext_vector_type(2)));
typedef unsigned u32x4 __attribute__((ext_vector_type(4)));
typedef unsigned u32x2 __attribute__((ext_vector_type(2)));

constexpr int D = 1024, BATCH = 16, SEQ = 2048, DEPTH = 4, NTOK = BATCH * SEQ, MEML = 256, NMEM = BATCH * MEML;
constexpr int MLH = 4, DH = 128, MLW = 512, DIN = 3592, NPROJ = 3584, NINP = 3840;
constexpr int XAH = 4, XAD = 256, NG = 4, NE = 4, DEXP = 512, NCLS = 24, CLSCAP = NTOK;
constexpr float EPS = 1e-6f;
constexpr int NWAVES = 8, NTHREADS = 512;
constexpr int PH_PER_LAYER = 13, PH_FINAL = DEPTH * PH_PER_LAYER, N_PHASES = PH_FINAL + 1;

constexpr size_t MiB = 1u << 20;
constexpr size_t WS_CTL = 0, CTL_ZERO_BYTES = 64 * 1024;
constexpr size_t WS_WR = 1 * MiB;
constexpr size_t WS_WIN = 2 * MiB;
constexpr size_t WS_WOUT = WS_WIN + (size_t)NINP * D * 2;
constexpr size_t WS_WMQ = WS_WOUT + 2 * MiB;
constexpr size_t WS_WMKV = WS_WMQ + 2 * MiB;
constexpr size_t WS_WMO = WS_WMKV + 4 * MiB;
constexpr size_t WS_W13 = WS_WMO + 2 * MiB;
constexpr size_t WS_W2C = WS_W13 + 32 * MiB;
constexpr size_t WS_XB = WS_W2C + 48 * MiB;
constexpr size_t WS_SSQ = WS_XB + 64 * MiB;
constexpr size_t WS_MEMB = WS_SSQ + 2 * MiB;
constexpr size_t WS_MEMR = WS_MEMB + 8 * MiB;
constexpr size_t WS_TOKINFO = WS_MEMR + 64 * 1024, WS_CNTB = WS_MEMR + 640 * 1024;
constexpr size_t WS_KV = WS_MEMR + 1 * MiB;
constexpr size_t WS_GATES = WS_KV + 16 * MiB;
constexpr size_t WS_Y = WS_GATES + 1 * MiB;
constexpr size_t WS_SLOT = WS_Y + 64 * MiB;
constexpr size_t SLOT_ARR = (size_t)NCLS * CLSCAP * 4;
constexpr size_t WS_PROJ = WS_SLOT + 4 * SLOT_ARR;
constexpr size_t WS_Q = WS_PROJ, WS_O = WS_PROJ + 64 * MiB, WS_HID = WS_PROJ + 128 * MiB;
constexpr size_t WS_QCV = WS_PROJ + (size_t)NTOK * NPROJ * 2;
constexpr size_t WS_KCV = WS_QCV + 32 * MiB, WS_DC = WS_KCV + 32 * MiB, WS_CPREV = WS_DC + 32 * MiB, WS_GBUF = WS_CPREV + 32 * MiB;
constexpr size_t WS_DN = WS_GBUF + 2 * MiB, WS_NPREV = WS_DN + 512 * 1024, WS_SCAL = WS_NPREV + 512 * 1024;
constexpr size_t WS_END = WS_SCAL + 64 * 1024;
constexpr size_t WS_WMKV2 = WS_W13 + 16 * MiB;
constexpr size_t WS_MEMB8 = WS_WMKV2 + 4 * MiB;
constexpr size_t WS_XQ8 = WS_QCV;
static_assert(WS_HID + (size_t)(128 + NCLS) * 256 * 1024 * 2 <= WS_END, "hidden overlay fits in proj");
constexpr int CW_TMO = 0, CW_CODE = 1, CW_BAR = 4096, CW_CNT = 8192, CW_Q = 8192 + 256;

constexpr int LDS_BYTES = 163840;
constexpr int RING_BYTES = 131072, SCR_OFF = RING_BYTES, LDSCTL_OFF = LDS_BYTES - 1024, MISC_OFF = LDSCTL_OFF + 320, PTAB_OFF = LDSCTL_OFF + 512;

#define RLX_AGENT __ATOMIC_RELAXED, __HIP_MEMORY_SCOPE_AGENT
typedef _Float16 f16x2 __attribute__((ext_vector_type(2)));
typedef _Float16 f16x8 __attribute__((ext_vector_type(8)));
__device__ __forceinline__ unsigned f2bf(float f) { return (unsigned)__builtin_bit_cast(unsigned short, (_Float16)f); }
__device__ __forceinline__ unsigned pk2(float lo, float hi) { const f32x2 v = {lo, hi}; return __builtin_bit_cast(unsigned, __builtin_convertvector(v, f16x2)); }
__device__ __forceinline__ float bf2f(unsigned short b) { return (float)__builtin_bit_cast(_Float16, b); }
__device__ __forceinline__ float bflo(unsigned w) { return (float)__builtin_bit_cast(_Float16, (unsigned short)(w & 0xffffu)); }
__device__ __forceinline__ float bfhi(unsigned w) { return (float)__builtin_bit_cast(_Float16, (unsigned short)(w >> 16)); }
#define DPPF(old_, src_, ctrl_, rm_) __builtin_bit_cast(float, __builtin_amdgcn_update_dpp(__builtin_bit_cast(int, (float)(old_)), __builtin_bit_cast(int, (float)(src_)), (ctrl_), (rm_), 0xF, false))
__device__ __forceinline__ float wave_sum(float v) {
    v += DPPF(0.f, v, 0xB1, 0xF); v += DPPF(0.f, v, 0x4E, 0xF); v += DPPF(0.f, v, 0x141, 0xF); v += DPPF(0.f, v, 0x140, 0xF);
    v += DPPF(0.f, v, 0x142, 0xA); v += DPPF(0.f, v, 0x143, 0xC);
    return __builtin_bit_cast(float, __builtin_amdgcn_readlane(__builtin_bit_cast(int, v), 63));
}
__device__ __forceinline__ float wave_max(float v) {
    v = fmaxf(v, DPPF(v, v, 0xB1, 0xF)); v = fmaxf(v, DPPF(v, v, 0x4E, 0xF)); v = fmaxf(v, DPPF(v, v, 0x141, 0xF)); v = fmaxf(v, DPPF(v, v, 0x140, 0xF));
    v = fmaxf(v, DPPF(v, v, 0x142, 0xA)); v = fmaxf(v, DPPF(v, v, 0x143, 0xC));
    return __builtin_bit_cast(float, __builtin_amdgcn_readlane(__builtin_bit_cast(int, v), 63));
}
__device__ __forceinline__ float xor16_sum(float x) { auto s = __builtin_amdgcn_permlane16_swap(__float_as_uint(x), __float_as_uint(x), false, false); return __uint_as_float(s[0]) + __uint_as_float(s[1]); }
__device__ __forceinline__ float xor32_sum(float x) { auto t = __builtin_amdgcn_permlane32_swap(__float_as_uint(x), __float_as_uint(x), false, false); return __uint_as_float(t[0]) + __uint_as_float(t[1]); }
__device__ __forceinline__ float bperm(int srclane, float v) { return __builtin_bit_cast(float, __builtin_amdgcn_ds_bpermute(srclane << 2, __builtin_bit_cast(int, v))); }
__device__ __forceinline__ float softplusf(float z) { return fmaxf(z, 0.f) + 0.6931471805599453f * __builtin_amdgcn_logf(1.0f + __builtin_amdgcn_exp2f(-1.4426950408889634f * fabsf(z))); }
__device__ __forceinline__ float siluf(float a) { return a * __builtin_amdgcn_rcpf(1.f + __builtin_amdgcn_exp2f(-1.4426950408889634f * a)); }
__device__ __forceinline__ float sigmf(float a) { return __builtin_amdgcn_rcpf(1.f + __builtin_amdgcn_exp2f(-1.4426950408889634f * a)); }

namespace pg8 {
constexpr int BM = 256, BK = 64, HALF = 128, HTB = HALF * BK * 2, STAGE_BYTES = 8 * HTB, NXCD = 8, WGM = 8;
__host__ __device__ __forceinline__ int lds_byte(int r, int c) { const int st = (r >> 4) * 2 + (c >> 5), rr = r & 15, cc = c & 31, ob = rr * 64 + cc * 2; return st * 1024 + (ob ^ (((ob >> 9) & 1) << 5)); }
__host__ __device__ __forceinline__ void stage_rc(int b, int& R, int& C) { const int st = b / 1024, sb = b % 1024, swz = sb ^ (((sb >> 9) & 1) << 5); R = (st >> 1) * 16 + swz / 64; C = (st & 1) * 32 + (swz % 64) / 2; }
__host__ __device__ __forceinline__ int perm32(int rho) { const int n = rho >> 4, i = rho & 15; return 8 * (i >> 2) + 4 * n + (i & 3); }

struct Unit { int pm, pn; const char* a; const char* b; const int* rows; int nvalid; int cls; int slot0; };

__device__ __forceinline__ unsigned cvt_pk_bf16(float lo, float hi) { return pk2(lo, hi); }
__device__ __forceinline__ int lane_fresh() { int l; asm volatile("v_mbcnt_lo_u32_b32 %0, -1, 0\n\tv_mbcnt_hi_u32_b32 %0, -1, %0" : "=v"(l)); return l; }
#ifndef FP8_FROM
#define FP8_FROM 0
#endif
#ifndef F8_MO
#define F8_MO 1
#endif
#ifndef F8_Q
#define F8_Q 1
#endif
static_assert(FP8_FROM == 0, "WS_WMKV2 lives in the half of WS_W13 that only the fp8 expert weights leave free");
constexpr float F8_WSCALE = 64.0f, F8_HSCALE = 16.0f;
__device__ __forceinline__ float f8clamp(float x) { return __builtin_amdgcn_fmed3f(x, -448.0f, 448.0f); }
__device__ __forceinline__ unsigned f8x4(float a, float b, float c, float d) { int v = __builtin_amdgcn_cvt_pk_fp8_f32(f8clamp(a), f8clamp(b), 0, false); v = __builtin_amdgcn_cvt_pk_fp8_f32(f8clamp(c), f8clamp(d), v, true); return (unsigned)v; }
__device__ __forceinline__ bool layer_f8(int l) { return FP8_FROM <= 0 ? true : (FP8_FROM >= DEPTH ? false : l >= FP8_FROM); }

__device__ __forceinline__ int xcd_remap(int L, int nwg) { const int q = nwg / NXCD, r = nwg % NXCD, xcd = L % NXCD, off = L / NXCD; return (xcd < r ? xcd * (q + 1) : r * (q + 1) + (xcd - r) * q) + off; }

struct SchedInKv {
    const char* A; const char* B; const char* A2; const char* B2; int G, c; size_t tstep; int ncol, nkv;
    __device__ __forceinline__ bool next(int i, Unit& u) const {
        const int nin = 128 * ncol;
        const long L = (long)i * G + c; if (L >= nin + nkv) return false;
        u.rows = nullptr; u.nvalid = 256; u.slot0 = 0;
        if (L < nin) { const int wgid = xcd_remap((int)L, nin); const int nig = WGM * ncol, gid = wgid / nig, fm = gid * WGM;
            u.pm = fm + ((wgid % nig) % WGM); u.pn = (wgid % nig) / WGM; u.a = A + (size_t)u.pm * tstep; u.b = B + (size_t)u.pn * tstep; u.cls = 0; }
        else { const int id = (int)L - nin; u.pm = id >> 3; u.pn = id & 7; u.a = A2 + (size_t)u.pm * tstep; u.b = B2 + (size_t)u.pn * tstep; u.cls = 1; }
        return true;
    }
};
struct SchedKv {
    const char* A2; const char* B2; int G, c; size_t tstep;
    __device__ __forceinline__ bool next(int i, Unit& u) const {
        const long L = (long)i * G + (G - 1 - c); if (L >= 128) return false;
        const int id = (int)L; u.pm = id >> 3; u.pn = id & 7; u.a = A2 + (size_t)u.pm * tstep; u.b = B2 + (size_t)u.pn * tstep; u.cls = 1; u.rows = nullptr; u.nvalid = 256; u.slot0 = 0; return true;
    }
};
struct SchedDense {
    const char* A; const char* B; int nM, nN, nwg, G, c; size_t tstep;
    __device__ void init(const void* A_, const void* B_, int M, int N, int K, int G_, int c_) { A = (const char*)A_; B = (const char*)B_; nM = M / BM; nN = N / BM; nwg = nM * nN; G = G_; c = c_; tstep = (size_t)BM * K * 2; }
    __device__ __forceinline__ bool next(int i, Unit& u) const {
        const long L = (long)i * G + c; if (L >= nwg) return false;
        const int wgid = xcd_remap((int)L, nwg);
        const int nig = WGM * nN, gid = wgid / nig, fm = gid * WGM, gsz = (nM - fm) < WGM ? (nM - fm) : WGM;
        u.pm = fm + ((wgid % nig) % gsz); u.pn = (wgid % nig) / gsz;
        u.a = A + (size_t)u.pm * tstep; u.b = B + (size_t)u.pn * tstep; u.rows = nullptr; u.nvalid = 256; u.cls = 0; u.slot0 = 0; return true;
    }
};

typedef int v8i_t __attribute__((ext_vector_type(8)));
typedef int i32x4_t __attribute__((ext_vector_type(4)));
template <class Epi, class Sched, bool GATHER, bool F8 = false>
__device__ __forceinline__ void gemm_phase(LAS unsigned char* lds, const int tid, const int K, const Sched& S, const Epi& E) {
    const int wid = __builtin_amdgcn_readfirstlane(tid >> 6), lane = tid & 63, wr = wid >> 2, wc = wid & 3, fr = lane & 15, fq = lane >> 4;
    const int nt = K / BK;
    unsigned voffB[2], va[2][2];
#pragma unroll
    for (int i = 0; i < 2; ++i) { int R, C; stage_rc(tid * 16 + i * 8192, R, C); const int Rb = Epi::PERM ? ((R & ~31) + perm32(R & 31)) : R;
        voffB[i] = (unsigned)(Rb * K + C) * 2u; va[0][i] = (unsigned)(R * K + C) * 2u; va[1][i] = (unsigned)((R + HALF) * K + C) * 2u; }
    const size_t kstep = (size_t)(BK * 2);
    const size_t hstep = (size_t)HALF * K * 2;
    const unsigned ldsw = (unsigned)wid * 1024u;
    const int aoff = lds_byte(wr * 64 + fr, fq * 8), boff = lds_byte(wc * 32 + fr, fq * 8);
#define PG8_SA(b, h) (((b) * 2 + (h)) * HTB)
#define PG8_SB(b, h) ((4 + (b) * 2 + (h)) * HTB)
#define PG8_STAGEB(bufoff, gbase) do { if constexpr (F8) { const __amdgpu_buffer_rsrc_t _r = __builtin_amdgcn_make_buffer_rsrc((void*)(gbase), 0, 0x7fffffff, 0x00020000); _Pragma("unroll") for (int _i = 0; _i < 2; ++_i) \
        __builtin_amdgcn_raw_ptr_buffer_load_lds(_r, (LAS void*)(lds + (bufoff) + ldsw + _i * 8192), 16, (int)voffB[_i], 0, 0, 0); } else { _Pragma("unroll") for (int _i = 0; _i < 2; ++_i) \
        __builtin_amdgcn_global_load_lds((const unsigned*)((const char*)(gbase) + voffB[_i]), (LAS unsigned*)(lds + (bufoff) + ldsw + _i * 8192), 16, 0, 0); } } while (0)
#define PG8_STAGEA(bufoff, gbase, h) do { if constexpr (F8) { const __amdgpu_buffer_rsrc_t _r = __builtin_amdgcn_make_buffer_rsrc((void*)(gbase), 0, 0x7fffffff, 0x00020000); _Pragma("unroll") for (int _i = 0; _i < 2; ++_i) \
        __builtin_amdgcn_raw_ptr_buffer_load_lds(_r, (LAS void*)(lds + (bufoff) + ldsw + _i * 8192), 16, (int)va[h][_i], 0, 0, 0); } else { _Pragma("unroll") for (int _i = 0; _i < 2; ++_i) \
        __builtin_amdgcn_global_load_lds((const unsigned*)((const char*)(gbase) + va[h][_i]), (LAS unsigned*)(lds + (bufoff) + ldsw + _i * 8192), 16, 0, 0); } } while (0)
#define PG8_LDA(dst, b, h) do { _Pragma("unroll") for (int m = 0; m < 4; ++m) _Pragma("unroll") for (int k = 0; k < 2; ++k) dst[m][k] = *(const LAS bf16x8*)(lds + PG8_SA(b, h) + aoff + m * 2048 + k * 1024); } while (0)
#define PG8_LDB(dst, b, h) do { _Pragma("unroll") for (int n = 0; n < 2; ++n) _Pragma("unroll") for (int k = 0; k < 2; ++k) dst[n][k] = *(const LAS bf16x8*)(lds + PG8_SB(b, h) + boff + n * 2048 + k * 1024); } while (0)
#define PG8_MMA(ai, bj, At, Bt) do { __builtin_amdgcn_s_setprio(1); _Pragma("unroll") for (int m = 0; m < 4; ++m) _Pragma("unroll") for (int n = 0; n < 2; ++n) { \
        if constexpr (F8) { const v8i_t fb = __builtin_shufflevector(__builtin_bit_cast(i32x4_t, Bt[n][0]), __builtin_bit_cast(i32x4_t, Bt[n][1]), 0, 1, 2, 3, 4, 5, 6, 7), fa = __builtin_shufflevector(__builtin_bit_cast(i32x4_t, At[m][0]), __builtin_bit_cast(i32x4_t, At[m][1]), 0, 1, 2, 3, 4, 5, 6, 7); \
            acc[ai][bj][m][n] = __builtin_amdgcn_mfma_scale_f32_16x16x128_f8f6f4(fb, fa, acc[ai][bj][m][n], 0, 0, 0, 0x7f7f7f7f, 0, 0x7f7f7f7f); } \
        else { _Pragma("unroll") for (int k = 0; k < 2; ++k) acc[ai][bj][m][n] = __builtin_amdgcn_mfma_f32_16x16x32_f16(__builtin_bit_cast(f16x8, Bt[n][k]), __builtin_bit_cast(f16x8, At[m][k]), acc[ai][bj][m][n], 0, 0, 0); } } \
        __builtin_amdgcn_s_setprio(0); } while (0)
#define PG8_LDA8(dst, b, h, m0) do { _Pragma("unroll") for (int m = 0; m < 2; ++m) _Pragma("unroll") for (int k = 0; k < 2; ++k) dst[m][k] = *(const LAS bf16x8*)(lds + PG8_SA(b, h) + aoff + ((m0) + m) * 2048 + k * 1024); } while (0)
#define PG8_MMA8(ai, mm, Am, B0_, B1_) do { _Pragma("unroll") for (int bj = 0; bj < 2; ++bj) _Pragma("unroll") for (int n = 0; n < 2; ++n) { \
        const v8i_t fb = bj ? __builtin_shufflevector(__builtin_bit_cast(i32x4_t, B1_[n][0]), __builtin_bit_cast(i32x4_t, B1_[n][1]), 0, 1, 2, 3, 4, 5, 6, 7) : __builtin_shufflevector(__builtin_bit_cast(i32x4_t, B0_[n][0]), __builtin_bit_cast(i32x4_t, B0_[n][1]), 0, 1, 2, 3, 4, 5, 6, 7); \
        const v8i_t fa = __builtin_shufflevector(__builtin_bit_cast(i32x4_t, Am[0]), __builtin_bit_cast(i32x4_t, Am[1]), 0, 1, 2, 3, 4, 5, 6, 7); \
        acc[ai][bj][mm][n] = __builtin_amdgcn_mfma_scale_f32_16x16x128_f8f6f4(fb, fa, acc[ai][bj][mm][n], 0, 0, 0, 0x7f7f7f7f, 0, 0x7f7f7f7f); } } while (0)
#define PG8_PHASE8(ai, b, h) do { PG8_WAIT_L(0); PG8_BAR; __builtin_amdgcn_s_setprio(1); PG8_MMA8(ai, 0, At[0], B0, B1); PG8_SCHED; { _Pragma("unroll") for (int k = 0; k < 2; ++k) At[0][k] = *(const LAS bf16x8*)(lds + PG8_SA(b, h) + aoff + 2 * 2048 + k * 1024); } PG8_SCHED; \
        PG8_MMA8(ai, 1, At[1], B0, B1); PG8_SCHED; { _Pragma("unroll") for (int k = 0; k < 2; ++k) At[1][k] = *(const LAS bf16x8*)(lds + PG8_SA(b, h) + aoff + 3 * 2048 + k * 1024); } PG8_SCHED; \
        PG8_MMA8(ai, 2, At[0], B0, B1); PG8_MMA8(ai, 3, At[1], B0, B1); __builtin_amdgcn_s_setprio(0); PG8_WAIT_L(0); PG8_BAR; PG8_SCHED; } while (0)
#define PG8_WAIT_V(n) asm volatile("s_waitcnt vmcnt(" #n ")" ::: "memory")
#define PG8_WAIT_L(n) asm volatile("s_waitcnt lgkmcnt(" #n ")" ::: "memory")
#define PG8_BAR __builtin_amdgcn_s_barrier()
#define PG8_SCHED __builtin_amdgcn_sched_barrier(0)
#define PG8_LOADVA(u, dst) do { int _t = tid; asm volatile("" : "+v"(_t)); _Pragma("unroll") for (int _i = 0; _i < 2; ++_i) { int _R, _C; stage_rc(_t * 16 + _i * 8192, _R, _C); \
        _Pragma("unroll") for (int _h = 0; _h < 2; ++_h) { const int _s = _h * HALF + _R; \
        const int _r = (_s < (u).nvalid) ? (u).rows[_s] : 0; dst[_h][_i] = (unsigned)(_r * K + _C) * 2u; } } } while (0)
    Unit cur, nxt; int ui = 0;
    if (!S.next(0, cur)) return;
    f32x4 acc[2][2][4][2];
#pragma unroll
    for (int a = 0; a < 2; ++a)
#pragma unroll
        for (int b = 0; b < 2; ++b)
#pragma unroll
            for (int m = 0; m < 4; ++m)
#pragma unroll
                for (int n = 0; n < 2; ++n) acc[a][b][m][n] = (f32x4){0.f, 0.f, 0.f, 0.f};
    bf16x8 At[F8 ? 2 : 4][2], B0[2][2], B1[2][2];
    const char* cA = cur.a; const char* cB = cur.b;
    if constexpr (GATHER) { PG8_LOADVA(cur, va); }
    PG8_STAGEB(PG8_SB(0, 0), cB); PG8_STAGEB(PG8_SB(0, 1), cB + hstep); PG8_STAGEA(PG8_SA(0, 0), cA, 0); PG8_STAGEA(PG8_SA(0, 1), cA, 1);
    if (wr == 1) PG8_BAR;
    PG8_WAIT_V(2); PG8_BAR;
    PG8_STAGEB(PG8_SB(1, 0), cB + kstep); PG8_STAGEA(PG8_SA(1, 0), cA + kstep, 0); PG8_STAGEB(PG8_SB(1, 1), cB + hstep + kstep);
    PG8_WAIT_V(6); PG8_BAR;
    for (;;) {
        const bool has_next = S.next(ui + 1, nxt);
        const char* nA = has_next ? nxt.a : cA; const char* nB = has_next ? nxt.b : cB;
#pragma unroll 1
        for (int t = 0; t < nt; t += 2) {
            const bool last = (t == nt - 2);
            const char* a1 = cA + (size_t)(t + 1) * kstep;
            const char* a2 = last ? nA : cA + (size_t)(t + 2) * kstep; const char* b2 = last ? nB : cB + (size_t)(t + 2) * kstep;
            const char* a3 = a2 + kstep; const char* b3 = b2 + kstep;
            if constexpr (F8) {
            PG8_LDB(B0, 0, 0); PG8_LDB(B1, 0, 1); PG8_SCHED; PG8_LDA8(At, 0, 0, 0); PG8_STAGEA(PG8_SA(1, 1), a1, 1);
            if constexpr (GATHER) { if (last && has_next) { PG8_LOADVA(nxt, va); } }
            PG8_WAIT_V(8); PG8_PHASE8(0, 0, 0);
            PG8_LDA8(At, 0, 1, 0); PG8_STAGEB(PG8_SB(0, 0), b2); PG8_STAGEB(PG8_SB(0, 1), b2 + hstep); PG8_STAGEA(PG8_SA(0, 0), a2, 0);
            PG8_WAIT_V(8); PG8_PHASE8(1, 0, 1);
            PG8_LDB(B0, 1, 0); PG8_LDB(B1, 1, 1); PG8_SCHED; PG8_LDA8(At, 1, 0, 0); PG8_STAGEA(PG8_SA(0, 1), a2, 1);
            PG8_WAIT_V(8); PG8_PHASE8(0, 1, 0);
            PG8_LDA8(At, 1, 1, 0); PG8_STAGEB(PG8_SB(1, 0), b3); PG8_STAGEB(PG8_SB(1, 1), b3 + hstep); PG8_STAGEA(PG8_SA(1, 0), a3, 0);
            PG8_WAIT_V(8); PG8_PHASE8(1, 1, 1);
            } else {
            PG8_LDB(B0, 0, 0); PG8_LDB(B1, 0, 1); PG8_SCHED; PG8_LDA(At, 0, 0); PG8_STAGEA(PG8_SA(1, 1), a1, 1);
            if constexpr (GATHER) { if (last && has_next) { PG8_LOADVA(nxt, va); } }
            PG8_WAIT_V(8); PG8_WAIT_L(0); PG8_BAR; PG8_MMA(0, 0, At, B0); PG8_MMA(0, 1, At, B1); PG8_BAR; PG8_SCHED;
            PG8_LDA(At, 0, 1); PG8_STAGEB(PG8_SB(0, 0), b2); PG8_STAGEB(PG8_SB(0, 1), b2 + hstep); PG8_STAGEA(PG8_SA(0, 0), a2, 0);
            PG8_WAIT_V(8); PG8_WAIT_L(0); PG8_BAR; PG8_MMA(1, 0, At, B0); PG8_MMA(1, 1, At, B1); PG8_BAR; PG8_SCHED;
            PG8_LDB(B0, 1, 0); PG8_LDB(B1, 1, 1); PG8_SCHED; PG8_LDA(At, 1, 0); PG8_STAGEA(PG8_SA(0, 1), a2, 1);
            PG8_WAIT_V(8); PG8_WAIT_L(0); PG8_BAR; PG8_MMA(0, 0, At, B0); PG8_MMA(0, 1, At, B1); PG8_BAR; PG8_SCHED;
            PG8_LDA(At, 1, 1); PG8_STAGEB(PG8_SB(1, 0), b3); PG8_STAGEB(PG8_SB(1, 1), b3 + hstep); PG8_STAGEA(PG8_SA(1, 0), a3, 0);
            PG8_WAIT_V(8); PG8_WAIT_L(0); PG8_BAR; PG8_MMA(1, 0, At, B0); PG8_MMA(1, 1, At, B1); PG8_BAR; PG8_SCHED;
            }
        }
        if (wr == 0) PG8_BAR;
        { Unit ce = cur; ce.pm = __builtin_amdgcn_readfirstlane(cur.pm); ce.pn = __builtin_amdgcn_readfirstlane(cur.pn); ce.cls = __builtin_amdgcn_readfirstlane(cur.cls); ce.slot0 = __builtin_amdgcn_readfirstlane(cur.slot0); ce.nvalid = __builtin_amdgcn_readfirstlane(cur.nvalid);
          asm volatile("" : "+s"(ce.pm), "+s"(ce.pn), "+s"(ce.cls), "+s"(ce.slot0), "+s"(ce.nvalid));
          E(acc, ce, wr, wc, fr, fq); }
        if (!has_next) break;
#pragma unroll
        for (int a = 0; a < 2; ++a)
#pragma unroll
            for (int b = 0; b < 2; ++b)
#pragma unroll
                for (int m = 0; m < 4; ++m)
#pragma unroll
                    for (int n = 0; n < 2; ++n) acc[a][b][m][n] = (f32x4){0.f, 0.f, 0.f, 0.f};
        cur = nxt; cA = nA; cB = nB; ++ui;
        if (wr == 1) PG8_BAR;
    }
    PG8_WAIT_V(0);
    PG8_BAR;
#undef PG8_SA
#undef PG8_SB
#undef PG8_STAGEA
#undef PG8_STAGEB
#undef PG8_LDA
#undef PG8_LDB
#undef PG8_MMA
#undef PG8_WAIT_V
#undef PG8_LDA8
#undef PG8_MMA8
#undef PG8_PHASE8
#undef PG8_WAIT_L
#undef PG8_BAR
#undef PG8_SCHED
#undef PG8_LOADVA
}

__device__ __forceinline__ float rstd_from_ssq(const float* ssq, int row) {
    const f32x4* p = (const f32x4*)(ssq + (size_t)row * 16); const f32x4 a = p[0], b = p[1], c = p[2], d = p[3];
    const float s = ((a[0] + a[1]) + (a[2] + a[3])) + ((b[0] + b[1]) + (b[2] + b[3])) + ((c[0] + c[1]) + (c[2] + c[3])) + ((d[0] + d[1]) + (d[2] + d[3]));
    return rsqrtf(s * (1.0f / D) + EPS);
}
struct EpiScaleBf16 {
    static constexpr bool PERM = true;
    bf16* O; int ldc; const float* ssq; const float* rtab; float* gates; int gate_pn; bf16* O2; int ldc2; const float* rtab2;
    float osc = 1.0f;
    __device__ __forceinline__ void operator()(const f32x4 (&acc)[2][2][4][2], const Unit& u, int wr, int wc, int fr, int fq) const {
        { const int ln_ = lane_fresh(); fr = ln_ & 15; fq = ln_ >> 4; }
        const int row0 = u.pm * BM + wr * 64 + fr; const int col0 = u.pn * BM + wc * 32 + 8 * fq;
        if (u.cls == 1) {
#pragma unroll
            for (int ai = 0; ai < 2; ++ai)
#pragma unroll
                for (int m = 0; m < 4; ++m) { const int row = row0 + ai * HALF + m * 16; const float rs = rtab2[row] * osc; bf16* rowp = O2 + (size_t)row * ldc2 + col0;
#pragma unroll
                    for (int bj = 0; bj < 2; ++bj) { const f32x4 v0 = acc[ai][bj][m][0] * rs, v1 = acc[ai][bj][m][1] * rs; u32x4 w; w.x = cvt_pk_bf16(v0[0], v0[1]); w.y = cvt_pk_bf16(v0[2], v0[3]); w.z = cvt_pk_bf16(v1[0], v1[1]); w.w = cvt_pk_bf16(v1[2], v1[3]);
                        *(u32x4*)(rowp + bj * HALF) = w; } }
            return; }
#pragma unroll
        for (int ai = 0; ai < 2; ++ai)
#pragma unroll
            for (int m = 0; m < 4; ++m) { const int row = row0 + ai * HALF + m * 16; const float rs = (rtab ? rtab[row] : rstd_from_ssq(ssq, row)) * osc;
                if (u.pn < gate_pn) { bf16* rowp = O + (size_t)row * ldc + col0;
#pragma unroll
                    for (int bj = 0; bj < 2; ++bj) { const f32x4 v0 = acc[ai][bj][m][0] * rs, v1 = acc[ai][bj][m][1] * rs; u32x4 w; w.x = cvt_pk_bf16(v0[0], v0[1]); w.y = cvt_pk_bf16(v0[2], v0[3]); w.z = cvt_pk_bf16(v1[0], v1[1]); w.w = cvt_pk_bf16(v1[2], v1[3]);
                        *(u32x4*)(rowp + bj * HALF) = w; } }
                else if (wc == 0 && fq == 0) { *(f32x4*)(gates + (size_t)row * 8) = acc[ai][0][m][0] * rs; *(f32x4*)(gates + (size_t)row * 8 + 4) = acc[ai][0][m][1] * rs; } }
    }
};
template <bool SCATTER, bool F8 = false> struct EpiRes {
    static constexpr bool PERM = true;
    bf16* xb; float* ssq; int probe; unsigned char* x8 = nullptr;
    __device__ __forceinline__ void operator()(const f32x4 (&acc)[2][2][4][2], const Unit& u, int wr, int wc, int fr, int fq) const {
        { const int ln_ = lane_fresh(); fr = ln_ & 15; fq = ln_ >> 4; }
        const int col0 = u.pn * BM + wc * 32 + 8 * fq;
#pragma unroll
        for (int ai = 0; ai < 2; ++ai)
#pragma unroll
            for (int m = 0; m < 4; ++m) { const int lr = wr * 64 + fr + ai * HALF + m * 16; int row; bool ok = true;
                if constexpr (SCATTER) { ok = lr < u.nvalid; row = ok ? u.rows[lr] : 0; } else row = u.pm * BM + lr;
                float ss = 0.f; bf16* rowp = xb + (size_t)row * D + col0;
#pragma unroll
                for (int bj = 0; bj < 2; ++bj) { const u32x4 v = *(const u32x4*)(rowp + bj * HALF); constexpr float ASC = F8 ? 1.0f / (F8_WSCALE * F8_HSCALE) : 1.0f; const f32x4 a0 = acc[ai][bj][m][0] * ASC, a1 = acc[ai][bj][m][1] * ASC;
                    float o[8] = {bflo(v.x), bfhi(v.x), bflo(v.y), bfhi(v.y), bflo(v.z), bfhi(v.z), bflo(v.w), bfhi(v.w)};
                    if (!probe) { o[0] += a0[0]; o[1] += a0[1]; o[2] += a0[2]; o[3] += a0[3]; o[4] += a1[0]; o[5] += a1[1]; o[6] += a1[2]; o[7] += a1[3]; }
                    ss += (o[0] * o[0] + o[1] * o[1]) + (o[2] * o[2] + o[3] * o[3]) + (o[4] * o[4] + o[5] * o[5]) + (o[6] * o[6] + o[7] * o[7]);
                    u32x4 w; w.x = cvt_pk_bf16(o[0], o[1]); w.y = cvt_pk_bf16(o[2], o[3]); w.z = cvt_pk_bf16(o[4], o[5]); w.w = cvt_pk_bf16(o[6], o[7]);
                    if (ok) *(u32x4*)(rowp + bj * HALF) = w;
                    if constexpr (!SCATTER) { if (x8) { u32x2 w8; w8.x = f8x4(o[0], o[1], o[2], o[3]); w8.y = f8x4(o[4], o[5], o[6], o[7]); *(u32x2*)(x8 + (size_t)row * D + col0 + bj * HALF) = w8; } } }
                ss = xor16_sum(ss); ss = xor32_sum(ss);
                if (fq == 0 && ok) ssq[(size_t)row * 16 + u.pn * 4 + wc] = ss; }
    }
};
template <bool F8 = false> struct EpiMoe1 {
    static constexpr bool PERM = true;
    bf16* hid; const float* rs; const float* gwa; const float* gwb;
    __device__ __forceinline__ void operator()(const f32x4 (&acc)[2][2][4][2], const Unit& u, int wr, int wc, int fr, int fq) const {
        { const int ln_ = lane_fresh(); fr = ln_ & 15; fq = ln_ >> 4; }
        const float* gw = (u.pn < 4 ? gwa : gwb) + (size_t)u.cls * CLSCAP + u.slot0; const float* rsp = rs + (size_t)u.cls * CLSCAP + u.slot0;
        const int col0 = (u.pn >> 2) * 512 + (u.pn & 3) * 128 + wc * 32 + 8 * fq;
#pragma unroll
        for (int ai = 0; ai < 2; ++ai)
#pragma unroll
            for (int m = 0; m < 4; ++m) { const int lr = wr * 64 + fr + ai * HALF + m * 16; const float r = rsp[lr] * (F8 ? 1.0f / F8_WSCALE : 1.0f), ru = F8 ? r * F8_HSCALE : r, g = gw[lr]; float h[8];
#pragma unroll
                for (int n = 0; n < 2; ++n)
#pragma unroll
                    for (int j = 0; j < 4; ++j) { const float a = acc[ai][0][m][n][j] * r, uu = acc[ai][1][m][n][j] * ru; h[n * 4 + j] = siluf(a) * uu * g; }
                u32x4 w; w.x = cvt_pk_bf16(h[0], h[1]); w.y = cvt_pk_bf16(h[2], h[3]); w.z = cvt_pk_bf16(h[4], h[5]); w.w = cvt_pk_bf16(h[6], h[7]);
                if constexpr (F8) { u32x2 w8; w8.x = f8x4(h[0], h[1], h[2], h[3]); w8.y = f8x4(h[4], h[5], h[6], h[7]); *(u32x2*)((unsigned char*)hid + ((size_t)u.pm * BM + lr) * 1024 + col0) = w8; }
                else *(u32x4*)(hid + ((size_t)u.pm * BM + lr) * 1024 + col0) = w; }
    }
};
}
using pg8::f8x4; using pg8::layer_f8; using pg8::F8_WSCALE; using pg8::F8_HSCALE;

#define XB_TMO      128
#define XB_XCNT(j)  (256  + 64 * (j))
#define XB_XSUB(j)  (1280 + 64 * (j))
#define XB_XGEN(j)  (2304 + 64 * (j))
#define XB_TOP      3328
#define XB_TOPGEN   3392
#define XCD_BAR_WORDS 3456
#define XB_SPIN_CAP (1u << 20)
__device__ __forceinline__ unsigned xb_ld(unsigned* p)              { return __hip_atomic_load(p, __ATOMIC_RELAXED, __HIP_MEMORY_SCOPE_AGENT); }
__device__ __forceinline__ unsigned xb_add(unsigned* p, unsigned v) { return __hip_atomic_fetch_add(p, v, __ATOMIC_RELAXED, __HIP_MEMORY_SCOPE_AGENT); }
__device__ __forceinline__ unsigned xb_xcc_id() { return (unsigned)__builtin_amdgcn_s_getreg((3 << 11) | 20) & 0xFu; }
#define XB_SPIN(cond, bar) do { unsigned _sp = 0; while (cond) { __builtin_amdgcn_s_sleep(1); \
    if ((++_sp & 255u) == 0u) { if (xb_ld(&(bar)[XB_TMO])) break; if (_sp > XB_SPIN_CAP) { atomicAdd(&(bar)[XB_TMO], 1u); break; } } } } while (0)
struct XcdBarrier { unsigned* bar; unsigned x; volatile LAS unsigned* st; };
__device__ __forceinline__ XcdBarrier xcd_barrier_post(unsigned* bar, volatile LAS unsigned* st) {
    XcdBarrier b; b.bar = bar; b.x = xb_xcc_id(); b.st = st;
    if (threadIdx.x == 0) (void)xb_add(&bar[XB_XCNT(b.x)], 1u);
    return b;
}
__device__ __forceinline__ void xcd_barrier_complete(unsigned* bar, unsigned x, unsigned& nloc, unsigned& nx) {
    const unsigned G = gridDim.x * gridDim.y * gridDim.z;
    unsigned sum, cnt, mine, sp = 0u;
    for (;;) {
        sum = 0u; cnt = 0u; mine = 0u;
#pragma unroll 1
        for (unsigned j = 0; j < 16; ++j) { const unsigned c = xb_ld(&bar[XB_XCNT(j)]); sum += c; cnt += (c > 0u) ? 1u : 0u; mine = (j == x) ? c : mine; }
        if (sum == G) break;
        __builtin_amdgcn_s_sleep(1);
        if ((++sp & 255u) == 0u) { if (xb_ld(&bar[XB_TMO])) break; if (sp > XB_SPIN_CAP) { atomicAdd(&bar[XB_TMO], 1u); break; } }
    }
    nloc = mine > 0u ? mine : 1u; nx = cnt > 0u ? cnt : 1u;
}
__device__ __forceinline__ void xcd_barrier(const XcdBarrier& b) {
    asm volatile("s_waitcnt vmcnt(0)" ::: "memory");
    __syncthreads();
    if (threadIdx.x == 0) {
        unsigned* bar = b.bar; asm volatile("" : "+s"(bar));
        __builtin_amdgcn_s_waitcnt(0);
        unsigned nloc = b.st[0], nx = b.st[1];
        if (nloc == 0u) { xcd_barrier_complete(bar, b.x, nloc, nx); b.st[0] = nloc; b.st[1] = nx; }
        const unsigned old = xb_add(&bar[XB_XSUB(b.x)], 1u);
        const unsigned gen = old / nloc;
        if (old + 1u == (gen + 1u) * nloc) {
            __builtin_amdgcn_fence(__ATOMIC_RELEASE, "agent");
            asm volatile("s_waitcnt vmcnt(0)" ::: "memory");
            const unsigned og = xb_add(&bar[XB_TOP], 1u);
            const unsigned tg = og / nx;
            __builtin_amdgcn_fence(__ATOMIC_ACQUIRE, "agent");
            if (og + 1u != (tg + 1u) * nx) XB_SPIN(xb_ld(&bar[XB_TOP]) < (tg + 1u) * nx, bar);
            xb_add(&bar[XB_XGEN(b.x)], 1u);
            asm volatile("s_waitcnt vmcnt(0)" ::: "memory");
        } else {
            __builtin_amdgcn_fence(__ATOMIC_ACQUIRE, "agent");
            XB_SPIN(xb_ld(&bar[XB_XGEN(b.x)]) == gen, bar);
            asm volatile("s_waitcnt vmcnt(0)" ::: "memory");
        }
    }
    __syncthreads();
}

struct Args { const float* in[26]; float* out; unsigned char* ws; int ph_lo, ph_hi, mode, pad; };
struct Frame {
    LAS unsigned char* lds; volatile LAS unsigned* MISC; unsigned* ctl; unsigned char* ws;
    int tid, lane, wave, G, bx;
    float* out;
    __device__ __forceinline__ const float* in_(int i) const { const LAS unsigned* t = (const LAS unsigned*)(lds + PTAB_OFF); const unsigned lo = __builtin_amdgcn_readfirstlane(t[2 * i]), hi = __builtin_amdgcn_readfirstlane(t[2 * i + 1]); return (const float*)(const GAS float*)(((unsigned long long)hi << 32) | lo); }
};
#define LDS_WAIT() asm volatile("s_waitcnt lgkmcnt(0)" ::: "memory")

__device__ __forceinline__ void tr_item(const float* W, int ldw, int k0, int n0, int ncols, const float* g, float cs, bf16* dst0, bf16* dst1, bf16* dst2, int ldd, LAS float* scr, int lane) {
    const int nl = lane & 31;
#pragma unroll 8
    for (int i = 0; i < 32; ++i) { const int kk = 2 * i + (lane >> 5); float v = 0.f; if (nl < ncols) v = W[(size_t)(k0 + kk) * ldw + n0 + nl] * (g ? g[k0 + kk] * cs : cs); scr[kk * 33 + nl] = v; }
    LDS_WAIT(); asm volatile("" ::: "memory");
    const int c = lane & 7;
#pragma unroll
    for (int j = 0; j < 4; ++j) { const int n = (lane >> 3) + 8 * j; const LAS float* s = scr + (8 * c) * 33 + n;
        u32x4 o; o.x = pk2(s[0 * 33], s[1 * 33]); o.y = pk2(s[2 * 33], s[3 * 33]); o.z = pk2(s[4 * 33], s[5 * 33]); o.w = pk2(s[6 * 33], s[7 * 33]);
        if (n < ncols) { *(u32x4*)(dst0 + (size_t)n * ldd + 8 * c) = o; if (dst1) *(u32x4*)(dst1 + (size_t)n * ldd + 8 * c) = o; if (dst2) *(u32x4*)(dst2 + (size_t)n * ldd + 8 * c) = o; } }
    LDS_WAIT(); asm volatile("" ::: "memory");
}
__device__ __forceinline__ void tr_item64(const float* W, int ldw, int k0, int n0, const float* g, float cs, bf16* dst0, bf16* dst1, bf16* dst2, int ldd, LAS float* scr, int lane) {
    const int r4 = lane >> 4, c4 = (lane & 15) * 4;
#pragma unroll 4
    for (int i = 0; i < 16; ++i) { const int kk = 4 * i + r4; f32x4 v = __builtin_nontemporal_load((const f32x4*)(W + (size_t)(k0 + kk) * ldw + n0 + c4));   const float sc = g ? g[k0 + kk] * cs : cs; v = v * sc; *(LAS f32x4*)(scr + kk * 68 + c4) = v; }
    LDS_WAIT(); asm volatile("" ::: "memory");
    const int c = lane & 7;
#pragma unroll
    for (int j = 0; j < 8; ++j) { const int n = (lane >> 3) + 8 * j; const LAS float* s_ = scr + (8 * c) * 68 + n;
        u32x4 o; o.x = pk2(s_[0 * 68], s_[1 * 68]); o.y = pk2(s_[2 * 68], s_[3 * 68]); o.z = pk2(s_[4 * 68], s_[5 * 68]); o.w = pk2(s_[6 * 68], s_[7 * 68]);
        *(u32x4*)(dst0 + (size_t)n * ldd + 8 * c) = o; if (dst1) *(u32x4*)(dst1 + (size_t)n * ldd + 8 * c) = o; if (dst2) *(u32x4*)(dst2 + (size_t)n * ldd + 8 * c) = o; }
    LDS_WAIT(); asm volatile("" ::: "memory");
}
__device__ __forceinline__ void tr_item64_f8(const float* W, int ldw, int k0, int n0, const float* g, float cs, unsigned char* dst0, unsigned char* dst1, unsigned char* dst2, int ldd, LAS float* scr, int lane) {
    const int r4 = lane >> 4, c4 = (lane & 15) * 4;
#pragma unroll 4
    for (int i = 0; i < 16; ++i) { const int kk = 4 * i + r4; f32x4 v = __builtin_nontemporal_load((const f32x4*)(W + (size_t)(k0 + kk) * ldw + n0 + c4)); const float sc = g ? g[k0 + kk] * cs : cs; v = v * sc; *(LAS f32x4*)(scr + kk * 68 + c4) = v; }
    LDS_WAIT(); asm volatile("" ::: "memory");
    const int c = lane & 7;
#pragma unroll
    for (int j = 0; j < 8; ++j) { const int n = (lane >> 3) + 8 * j; const LAS float* s_ = scr + (8 * c) * 68 + n;
        u32x2 o; o.x = f8x4(s_[0 * 68], s_[1 * 68], s_[2 * 68], s_[3 * 68]); o.y = f8x4(s_[4 * 68], s_[5 * 68], s_[6 * 68], s_[7 * 68]);
        *(u32x2*)(dst0 + (size_t)n * ldd + 8 * c) = o; if (dst1) *(u32x2*)(dst1 + (size_t)n * ldd + 8 * c) = o; if (dst2) *(u32x2*)(dst2 + (size_t)n * ldd + 8 * c) = o; }
    LDS_WAIT(); asm volatile("" ::: "memory");
}
__device__ __forceinline__ int pair_index(int a, int b) { return a == 0 ? (b - 1) : (a == 1 ? (b + 1) : 5); }

__device__ __forceinline__ void phase_convert(Frame& F, int l) {
    LAS float* scr = (LAS float*)(F.lds + F.wave * (64 * 68 * 4));
    const int gw = F.bx * NWAVES + F.wave, NGW = F.G * NWAVES, lane = F.lane;
    unsigned char* ws = F.ws;
    bf16* Win = (bf16*)(ws + WS_WIN); bf16* Wout = (bf16*)(ws + WS_WOUT); bf16* Wmq = (bf16*)(ws + WS_WMQ); bf16* Wmkv = (bf16*)(ws + WS_WMKV); bf16* Wmo = (bf16*)(ws + WS_WMO);
    bf16* W13 = (bf16*)(ws + WS_W13); bf16* W2c = (bf16*)(ws + WS_W2C);
    const float* w_in = F.in_(3) + (size_t)l * D * DIN; const float* ln_mix = F.in_(2) + l * D;
    const float* w_out = F.in_(10) + (size_t)l * D * D;
    const float* ln_mem = F.in_(11) + l * D; const float* ln_memkv = F.in_(12) + l * D;
    const float* w_mq = F.in_(13) + (size_t)l * D * D; const float* w_mk = F.in_(14) + (size_t)l * D * D; const float* w_mv = F.in_(15) + (size_t)l * D * D; const float* w_mo = F.in_(16) + (size_t)l * D * D;
    const float* ln_ffn = F.in_(17) + l * D;
    const float* w_e1 = F.in_(22) + (size_t)l * 16 * D * DEXP; const float* w_e3 = F.in_(23) + (size_t)l * 16 * D * DEXP; const float* w_e2 = F.in_(24) + (size_t)l * 16 * DEXP * D;
    constexpr int I_SEG = 128;
    constexpr int I_IN = 7 * I_SEG, I_GATE = 16, I_SQ = 256, I_E13 = 32 * I_SEG, I_E2 = 16 * 128;
    const int kvp = (l == 0) ? 2 : (l + 1 < DEPTH ? 1 : 0); const int I_SQS = (3 + 2 * kvp) * I_SQ;
    const int NITEMS = I_IN + I_GATE + I_SQS + I_E13 + I_E2;
    for (int it = gw; it < NITEMS; it += NGW) {
        int r = it;
        if (r < I_IN) { const int seg = r / I_SEG, q = r % I_SEG, kb = q / 8, nb = q % 8;
            const int srcc = seg < 4 ? seg * 512 : 2056 + (seg - 4) * 512; const int dstr = seg * 512; const float cs = (seg == 4) ? (0.08838834764831845f * 1.4426950408889634f) : 1.0f;
            tr_item64(w_in, DIN, kb * 64, srcc + nb * 64, ln_mix, cs, Win + (size_t)(dstr + nb * 64) * D + kb * 64, nullptr, nullptr, D, scr, lane); continue; }
        r -= I_IN;
        if (r < I_GATE) { tr_item(w_in, DIN, r * 64, 2048, 8, ln_mix, 1.0f, Win + (size_t)NPROJ * D + r * 64, nullptr, nullptr, D, scr, lane); continue; }
        r -= I_GATE;
        if (r < I_SQS) { const int m5 = r / I_SQ, q = r % I_SQ, kb = q / 16, nb = q % 16;
            const int mat = m5 < 3 ? (m5 == 2 ? 4 : m5) : 2 + ((m5 - 3) & 1);
            const int lk = m5 < 3 ? l : ((l == 0) ? ((m5 - 3) >> 1) : l + 1);
            const float* W = mat == 0 ? w_out : mat == 1 ? w_mq : mat == 2 ? F.in_(14) + (size_t)lk * D * D : mat == 3 ? F.in_(15) + (size_t)lk * D * D : w_mo;
            const float* g = mat == 1 ? ln_mem : (mat == 2 || mat == 3) ? F.in_(12) + lk * D : nullptr;
            const float cs = (mat == 1) ? (0.0625f * 1.4426950408889634f) : 1.0f;
            bf16* Wkv = (lk & 1) ? (bf16*)(ws + WS_WMKV2) : Wmkv;
            bf16* dst = mat == 0 ? Wout : mat == 1 ? Wmq : mat == 2 ? Wkv : mat == 3 ? (Wkv + (size_t)1024 * D) : Wmo;
            if ((mat == 1 && F8_Q) || (mat == 4 && F8_MO) || ((mat == 2 || mat == 3) && lk > 0)) tr_item64_f8(W, D, kb * 64, nb * 64, g, cs * F8_WSCALE, (mat == 3 ? (unsigned char*)Wkv + (size_t)1024 * D : (unsigned char*)dst) + (size_t)(nb * 64) * D + kb * 64, nullptr, nullptr, D, scr, lane);
            else tr_item64(W, D, kb * 64, nb * 64, g, cs, dst + (size_t)(nb * 64) * D + kb * 64, nullptr, nullptr, D, scr, lane);
            continue; }
        r -= I_SQS;
        if (r < I_E13) { const int mat = r / I_SEG, q = r % I_SEG, kb = q / 8, nb = q % 8; const int ge = mat >> 1, which = mat & 1;
            const float* W = (which ? w_e3 : w_e1) + (size_t)ge * D * DEXP; const int c0 = nb * 64;
            bf16* dst = W13 + ((size_t)ge * 1024 + (c0 >> 7) * 256 + which * 128 + (c0 & 127)) * D + kb * 64;
            if (layer_f8(l)) tr_item64_f8(W, DEXP, kb * 64, c0, ln_ffn, F8_WSCALE, (unsigned char*)W13 + ((size_t)ge * 1024 + (c0 >> 7) * 256 + which * 128 + (c0 & 127)) * D + kb * 64, nullptr, nullptr, D, scr, lane);
            else tr_item64(W, DEXP, kb * 64, c0, ln_ffn, 1.0f, dst, nullptr, nullptr, D, scr, lane);
            continue; }
        r -= I_E13;
        { const int ge = r / 128, q = r % 128, kb = q / 16, nb = q % 16; const int g = ge >> 2, e = ge & 3;
            const float* W = w_e2 + (size_t)ge * DEXP * D; bf16* dd[3];
#pragma unroll
            for (int j = 0; j < 3; ++j) { const int o = (e + 1 + j) & 3; const int a = o < e ? o : e, b = o < e ? e : o; const int cls = g * 6 + pair_index(a, b); const int pos = (e == b) ? 1 : 0;
                dd[j] = W2c + ((size_t)cls * 1024 + nb * 64) * 1024 + pos * 512 + kb * 64; }
            if (layer_f8(l)) { unsigned char* d8[3];
#pragma unroll
                for (int j = 0; j < 3; ++j) d8[j] = (unsigned char*)W2c + (size_t)(dd[j] - W2c);
                tr_item64_f8(W, D, kb * 64, nb * 64, nullptr, F8_WSCALE, d8[0], d8[1], d8[2], 1024, scr, lane); }
            else tr_item64(W, D, kb * 64, nb * 64, nullptr, 1.0f, dd[0], dd[1], dd[2], 1024, scr, lane); }
    }
    { float* wr = (float*)(ws + WS_WR); const float* w_rg = F.in_(18) + (size_t)l * D * NG; const float* w_re = F.in_(20) + (size_t)l * D * 16;
      const float* b_rg = F.in_(19) + l * NG; const float* b_re = F.in_(21) + l * 16;
      const int gt = F.bx * NTHREADS + F.tid, NT = F.G * NTHREADS;
      for (int e = gt; e < 20 * D; e += NT) { const int j = e / D, k = e % D; wr[e] = ln_ffn[k] * (j < 4 ? w_rg[k * NG + j] : w_re[k * 16 + (j - 4)]); }
      if (gt < 20) wr[20 * D + gt] = gt < 4 ? b_rg[gt] : b_re[gt - 4]; }
    if (l == 0) {
        const float* x = F.in_(0); const float* mem = F.in_(1); bf16* xb = (bf16*)(ws + WS_XB); float* ssq = (float*)(ws + WS_SSQ); bf16* memb = (bf16*)(ws + WS_MEMB); float* memr = (float*)(ws + WS_MEMR);
        for (int m = gw; m < NTOK + NMEM; m += NGW) { const bool ism = m >= NTOK; const int row = ism ? m - NTOK : m;
            const f32x4* xr = (const f32x4*)((ism ? mem : x) + (size_t)row * D) + lane; unsigned long long* o8 = (unsigned long long*)((ism ? memb : xb) + (size_t)row * D) + lane;
            float s = 0.f;
#pragma unroll
            for (int j = 0; j < 4; ++j) { const f32x4 v = xr[64 * j]; s += (v[0] * v[0] + v[1] * v[1]) + (v[2] * v[2] + v[3] * v[3]); o8[64 * j] = (unsigned long long)pk2(v[0], v[1]) | ((unsigned long long)pk2(v[2], v[3]) << 32);
                if (ism) ((unsigned*)(ws + WS_MEMB8 + (size_t)row * D))[lane + 64 * j] = f8x4(v[0], v[1], v[2], v[3]); }
            s = wave_sum(s);
            if (ism) { if (lane == 0) memr[row] = rsqrtf(s * (1.0f / D) + EPS); }
            else if (lane < 16) ssq[(size_t)row * 16 + lane] = lane == 0 ? s : 0.f; }
    }
}

typedef float f32x16 __attribute__((ext_vector_type(16)));
typedef short s16x4 __attribute__((ext_vector_type(4)));
namespace sbat {
constexpr int KST = 272, VST = 320, KBUF = 64 * KST, VBUF = 64 * VST, STG = KBUF + VBUF, OST = 272;
__device__ __forceinline__ f16x8 cvt8(float a, float b, float c, float d, float e, float f, float g, float h) { u32x4 w; w.x = pk2(a, b); w.y = pk2(c, d); w.z = pk2(e, f); w.w = pk2(g, h); return __builtin_bit_cast(f16x8, w); }
typedef short v4i16_t __attribute__((ext_vector_type(4)));
__device__ __forceinline__ s16x4 vtr(const LAS unsigned char* p) { return __builtin_bit_cast(s16x4, __builtin_amdgcn_ds_read_tr16_b64_v4i16((LAS v4i16_t*)p)); }
#define SB_MFMA(a, b, c) __builtin_amdgcn_mfma_f32_32x32x16_f16((a), (b), (c), 0, 0, 0)
}
__device__ __forceinline__ void sb_unit(Frame& F, int l, const int bh, const int qb) {
    using namespace sbat;
    unsigned char* ws = F.ws; const bf16* proj = (const bf16*)(ws + WS_PROJ); bf16* y = (bf16*)(ws + WS_Y); const float* sg = F.in_(9) + l * 512;
    const int tid = F.tid, lane = F.lane, w = F.wave, t32 = lane & 31, hi = lane >> 5;
    LAS unsigned char* lds = F.lds;
    f16x8 tri0, tri1, ones;
#pragma unroll
    for (int j = 0; j < 8; ++j) { const int k0 = 8 * (j >> 2) + 4 * hi + (j & 3); tri0[j] = (k0 > t32) ? (_Float16)1.0f : (_Float16)0.0f; tri1[j] = (16 + k0 > t32) ? (_Float16)1.0f : (_Float16)0.0f; ones[j] = (_Float16)1.0f; }
    {
        const int b = bh >> 2, hh = bh & 3;
        const size_t tokb = (size_t)b * SEQ; const int q0 = qb * 256, t0w = q0 + 32 * w, tg = t0w + t32;
        f16x8 qf[8];
        { const bf16* qrow = proj + (tokb + tg) * NPROJ + 2048 + hh * 128 + 8 * hi;
#pragma unroll
          for (int kk = 0; kk < 8; ++kk) qf[kk] = *(const f16x8*)(qrow + 16 * kk); }
        f32x16 O[4]; f32x16 Rv;
#pragma unroll
        for (int r = 0; r < 16; ++r) { O[0][r] = 0.f; O[1][r] = 0.f; O[2][r] = 0.f; O[3][r] = 0.f; Rv[r] = 0.f; }
        const int njt = 4 * qb + 4;
        LAS float* rmaxL = (LAS float*)(lds + 2 * STG);
        const int rowL = tid >> 4, chunk = tid & 15;
        const bf16* kg = proj + (tokb + rowL) * NPROJ + 2560 + hh * 128 + chunk * 8; const bf16* vg = kg + 512;
        const int kdst = rowL * KST + chunk * 16, vdst = KBUF + rowL * VST + chunk * 16;
        u32x4 kr0, kr1, vr0, vr1;
        { const size_t o = (size_t)(64 * (njt - 1)) * NPROJ; kr0 = *(const u32x4*)(kg + o); kr1 = *(const u32x4*)(kg + o + 32 * NPROJ); vr0 = *(const u32x4*)(vg + o); vr1 = *(const u32x4*)(vg + o + 32 * NPROJ); }
        *(LAS u32x4*)(lds + kdst) = kr0; *(LAS u32x4*)(lds + kdst + 32 * KST) = kr1; *(LAS u32x4*)(lds + vdst) = vr0; *(LAS u32x4*)(lds + vdst + 32 * VST) = vr1;
        __syncthreads();
        int cur = 0;
        for (int jt = njt - 1; jt >= 0; --jt) {
            const bool act = (64 * jt <= t0w);
            const LAS unsigned char* Kb = lds + cur * STG; const LAS unsigned char* Vb = Kb + KBUF;
            f16x8 Af[2][2];
            if (act) {
                f32x16 p0, p1;
#pragma unroll
                for (int r = 0; r < 16; ++r) { p0[r] = 0.f; p1[r] = 0.f; }
#pragma unroll
                for (int kk = 0; kk < 8; ++kk) { const f16x8 k0 = *(const LAS f16x8*)(Kb + t32 * KST + 32 * kk + 16 * hi); const f16x8 k1 = *(const LAS f16x8*)(Kb + (t32 + 32) * KST + 32 * kk + 16 * hi);
                    p0 = SB_MFMA(k0, qf[kk], p0); p1 = SB_MFMA(k1, qf[kk], p1); }
                const bool diag = (64 * jt + 63 >= t0w);
                float L0[16], L1[16];
                if (diag) {
#pragma unroll
                    for (int r = 0; r < 16; ++r) { const int sl = 64 * jt + (r & 3) + 8 * (r >> 2) + 4 * hi; if (!(sl < tg)) p0[r] = -1e30f; if (!(sl + 32 < tg)) p1[r] = -1e30f; } }
#pragma unroll
                for (int r = 0; r < 16; ++r) {
                    { const float z = __builtin_amdgcn_fmed3f(p0[r], -3.0e38f, 115.f); const float lg = __builtin_amdgcn_logf(1.0f + __builtin_amdgcn_exp2f(z)); L0[r] = -lg; p0[r] = z - lg; }
                    { const float z = __builtin_amdgcn_fmed3f(p1[r], -3.0e38f, 115.f); const float lg = __builtin_amdgcn_logf(1.0f + __builtin_amdgcn_exp2f(z)); L1[r] = -lg; p1[r] = z - lg; } }
                const f16x8 X0a = cvt8(L0[0], L0[1], L0[2], L0[3], L0[4], L0[5], L0[6], L0[7]), X0b = cvt8(L0[8], L0[9], L0[10], L0[11], L0[12], L0[13], L0[14], L0[15]);
                const f16x8 X1a = cvt8(L1[0], L1[1], L1[2], L1[3], L1[4], L1[5], L1[6], L1[7]), X1b = cvt8(L1[8], L1[9], L1[10], L1[11], L1[12], L1[13], L1[14], L1[15]);
                f32x16 Y1 = SB_MFMA(tri0, X1a, Rv); Y1 = SB_MFMA(tri1, X1b, Y1);
                f32x16 U = SB_MFMA(ones, X1a, Rv); U = SB_MFMA(ones, X1b, U);
                f32x16 Y0 = SB_MFMA(tri0, X0a, U); Y0 = SB_MFMA(tri1, X0b, Y0);
                Rv = SB_MFMA(ones, X0a, U); Rv = SB_MFMA(ones, X0b, Rv);
#pragma unroll
                for (int r = 0; r < 16; ++r) { p0[r] = __builtin_amdgcn_exp2f(p0[r] + Y0[r]); p1[r] = __builtin_amdgcn_exp2f(p1[r] + Y1[r]); }
                Af[0][0] = cvt8(p0[0], p0[1], p0[2], p0[3], p0[4], p0[5], p0[6], p0[7]); Af[0][1] = cvt8(p0[8], p0[9], p0[10], p0[11], p0[12], p0[13], p0[14], p0[15]);
                Af[1][0] = cvt8(p1[0], p1[1], p1[2], p1[3], p1[4], p1[5], p1[6], p1[7]); Af[1][1] = cvt8(p1[8], p1[9], p1[10], p1[11], p1[12], p1[13], p1[14], p1[15]);
            }
            if (jt > 0) { const size_t o = (size_t)(64 * (jt - 1)) * NPROJ; kr0 = *(const u32x4*)(kg + o); kr1 = *(const u32x4*)(kg + o + 32 * NPROJ); vr0 = *(const u32x4*)(vg + o); vr1 = *(const u32x4*)(vg + o + 32 * NPROJ); }
            if (act) {
                const int i16 = lane & 15, dhalf = (lane >> 4) & 1;
                const LAS unsigned char* va = Vb + (4 * hi + (i16 >> 2)) * VST + (dhalf * 16 + 4 * (i16 & 3)) * 2;
#pragma unroll
                for (int dblk = 0; dblk < 4; ++dblk)
#pragma unroll
                    for (int sb = 0; sb < 2; ++sb)
#pragma unroll
                        for (int sp = 0; sp < 2; ++sp) { const LAS unsigned char* pp = va + (32 * sb + 16 * sp) * VST + dblk * 64; const s16x4 lo = vtr(pp), h4 = vtr(pp + 8 * VST);
                            const bf16x8 vf = (bf16x8){lo[0], lo[1], lo[2], lo[3], h4[0], h4[1], h4[2], h4[3]};
                            O[dblk] = SB_MFMA(__builtin_bit_cast(f16x8, vf), Af[sb][sp], O[dblk]); }
            }
            if (jt > 0) { const int nb = (cur ^ 1) * STG; *(LAS u32x4*)(lds + nb + kdst) = kr0; *(LAS u32x4*)(lds + nb + kdst + 32 * KST) = kr1; *(LAS u32x4*)(lds + nb + vdst) = vr0; *(LAS u32x4*)(lds + nb + vdst + 32 * VST) = vr1; }
            { const float rw = wave_max(Rv[0]); if (lane == 0) rmaxL[(jt & 1) * 8 + w] = rw; }
            __syncthreads(); cur ^= 1;
            { const f32x4 ra = *(const LAS f32x4*)(rmaxL + (jt & 1) * 8), rb = *(const LAS f32x4*)(rmaxL + (jt & 1) * 8 + 4);
              const float rm = fmaxf(fmaxf(fmaxf(ra[0], ra[1]), fmaxf(ra[2], ra[3])), fmaxf(fmaxf(rb[0], rb[1]), fmaxf(rb[2], rb[3])));
              if (rm < -27.0f) break; }
        }
        { float ss = 0.f;
#pragma unroll
          for (int dblk = 0; dblk < 4; ++dblk)
#pragma unroll
              for (int r = 0; r < 16; ++r) ss += O[dblk][r] * O[dblk][r];
          ss = xor32_sum(ss); const float rr = rsqrtf(ss * (1.0f / 128) + EPS);
          LAS unsigned char* st = lds + w * (32 * OST);
#pragma unroll
          for (int dblk = 0; dblk < 4; ++dblk)
#pragma unroll
              for (int rq = 0; rq < 4; ++rq) { u32x2 v; v.x = pk2(O[dblk][4 * rq] * rr, O[dblk][4 * rq + 1] * rr); v.y = pk2(O[dblk][4 * rq + 2] * rr, O[dblk][4 * rq + 3] * rr);
                  *(LAS u32x2*)(st + t32 * OST + (dblk * 32 + 8 * rq + 4 * hi) * 2) = v; }
          LDS_WAIT();
          int le = lane; asm volatile("" : "+v"(le));
          const int ch = le & 15; const f32x4 g0 = *(const f32x4*)(sg + hh * 128 + ch * 8), g1 = *(const f32x4*)(sg + hh * 128 + ch * 8 + 4);
#pragma unroll
          for (int i = 0; i < 8; ++i) { const int row = i * 4 + (le >> 4); const u32x4 v = *(const LAS u32x4*)(st + row * OST + ch * 16); u32x4 o;
              o.x = pk2(bflo(v.x) * g0[0], bfhi(v.x) * g0[1]); o.y = pk2(bflo(v.y) * g0[2], bfhi(v.y) * g0[3]); o.z = pk2(bflo(v.z) * g1[0], bfhi(v.z) * g1[1]); o.w = pk2(bflo(v.w) * g1[2], bfhi(v.w) * g1[3]);
              *(u32x4*)(y + (tokb + t0w + row) * D + 512 + hh * 128 + ch * 8) = o; }
        }
        __syncthreads();
    }
}


namespace mls {
constexpr int ST = 272, KC = 0, VC = 128 * ST, CT = 2 * 128 * ST, QC = 3 * 128 * ST, GB = 4 * 128 * ST;
static_assert(GB + 2560 <= LDSCTL_OFF, "mLSTM LDS map");
#define ML_MFMA(a, b, c) __builtin_amdgcn_mfma_f32_16x16x32_f16((a), (b), (c), 0, 0, 0)
__device__ __forceinline__ f16x8 tr8(const LAS unsigned char* p, int second_off) { const s16x4 lo = sbat::vtr(p), h4 = sbat::vtr(p + second_off); const bf16x8 v = (bf16x8){lo[0], lo[1], lo[2], lo[3], h4[0], h4[1], h4[2], h4[3]}; return __builtin_bit_cast(f16x8, v); }
}
__device__ __forceinline__ void ml_x1(Frame& F, int l, const int item) {
    using namespace mls;
    unsigned char* ws = F.ws; const bf16* proj = (const bf16*)(ws + WS_PROJ); const float* gates = (const float*)(ws + WS_GATES);
    const int tid = F.tid, lane = F.lane, w = F.wave, l16 = lane & 15, g = lane >> 4; LAS unsigned char* lds = F.lds;
    const int chain = item >> 4, c = item & 15, b = chain >> 2, h = chain & 3;
    const float* convw = F.in_(4) + (size_t)l * 4 * 1024; const float* convb = F.in_(5) + l * 1024; const float ib = F.in_(6)[l * 4 + h], fb = F.in_(7)[l * 4 + h];
    bf16* qcv = (bf16*)(ws + WS_QCV) + (size_t)item * 16384; bf16* kcv = (bf16*)(ws + WS_KCV) + (size_t)item * 16384; bf16* dC = (bf16*)(ws + WS_DC) + (size_t)item * 16384;
    float* gbuf = (float*)(ws + WS_GBUF) + (size_t)item * 384; float* dn = (float*)(ws + WS_DN) + (size_t)item * 128; float* scal = (float*)(ws + WS_SCAL) + (size_t)item * 4;
    LAS float* gL = (LAS float*)(lds + GB) + 128; LAS _Float16* wS = (LAS _Float16*)(lds + GB + 2048);
    const int ts0 = c * 128; const size_t tokc = (size_t)b * SEQ + ts0; const int q4 = l16 >> 2, p4 = l16 & 3;
    { const int cg = tid & 15, r0 = 4 * (tid >> 4);
#pragma unroll
      for (int qk = 0; qk < 2; ++qk) { const int ch = qk * 512 + h * 128 + cg * 8; u32x4 raw[7];
#pragma unroll
          for (int j = 0; j < 7; ++j) { const int tt = ts0 + r0 - 3 + j; const int ttc = tt < 0 ? 0 : tt; u32x4 r_ = *(const u32x4*)(proj + ((size_t)b * SEQ + ttc) * NPROJ + ch);
              if (tt < 0) r_ = (u32x4){0u, 0u, 0u, 0u}; raw[j] = r_; }
          float wv[4][8], bv[8];
#pragma unroll
          for (int e4 = 0; e4 < 2; ++e4) { const f32x4 t_ = *(const f32x4*)(convb + ch + 4 * e4); bv[4 * e4] = t_[0]; bv[4 * e4 + 1] = t_[1]; bv[4 * e4 + 2] = t_[2]; bv[4 * e4 + 3] = t_[3];
#pragma unroll
              for (int tap = 0; tap < 4; ++tap) { const f32x4 u_ = *(const f32x4*)(convw + tap * 1024 + ch + 4 * e4); wv[tap][4 * e4] = u_[0]; wv[tap][4 * e4 + 1] = u_[1]; wv[tap][4 * e4 + 2] = u_[2]; wv[tap][4 * e4 + 3] = u_[3]; } }
          const float sc = qk ? 0.08838834764831845f : 1.0f;
#pragma unroll
          for (int r = 0; r < 4; ++r) { float a[8];
#pragma unroll
              for (int e = 0; e < 8; ++e) a[e] = bv[e];
#pragma unroll
              for (int tap = 0; tap < 4; ++tap) { const u32x4 r_ = raw[r + tap];
                  a[0] += wv[tap][0] * bflo(r_.x); a[1] += wv[tap][1] * bfhi(r_.x); a[2] += wv[tap][2] * bflo(r_.y); a[3] += wv[tap][3] * bfhi(r_.y);
                  a[4] += wv[tap][4] * bflo(r_.z); a[5] += wv[tap][5] * bfhi(r_.z); a[6] += wv[tap][6] * bflo(r_.w); a[7] += wv[tap][7] * bfhi(r_.w); }
              u32x4 o_; o_.x = pk2(siluf(a[0]) * sc, siluf(a[1]) * sc); o_.y = pk2(siluf(a[2]) * sc, siluf(a[3]) * sc); o_.z = pk2(siluf(a[4]) * sc, siluf(a[5]) * sc); o_.w = pk2(siluf(a[6]) * sc, siluf(a[7]) * sc);
              *(u32x4*)((qk ? kcv : qcv) + (r0 + r) * 128 + cg * 8) = o_;
              if (qk) *(LAS u32x4*)(lds + KC + (r0 + r) * ST + cg * 16) = o_; } }
#pragma unroll
      for (int r = 0; r < 4; ++r) *(LAS u32x4*)(lds + VC + (r0 + r) * ST + cg * 16) = *(const u32x4*)(proj + (tokc + r0 + r) * NPROJ + 1024 + h * 128 + cg * 8); }
    if (w == 0) { const int t0 = 2 * lane; const float* gp = gates + (tokc + t0) * 8;
        const float i0 = gp[h] + ib, f0 = gp[4 + h] + fb, i1 = gp[8 + h] + ib, f1 = gp[12 + h] + fb;
        const float lf0 = -softplusf(-f0), lf1 = -softplusf(-f1); const float s2 = lf0 + lf1; float incl = s2;
        incl += DPPF(0.f, incl, 0x111, 0xF); incl += DPPF(0.f, incl, 0x112, 0xF); incl += DPPF(0.f, incl, 0x114, 0xF); incl += DPPF(0.f, incl, 0x118, 0xF);
        incl += DPPF(0.f, incl, 0x142, 0xA); incl += DPPF(0.f, incl, 0x143, 0xC);
        const float b0 = incl - s2 + lf0, b1 = b0 + lf1; const float g0 = i0 - b0, g1 = i1 - b1; float pm = fmaxf(g0, g1);
        pm = fmaxf(pm, DPPF(-INFINITY, pm, 0x111, 0xF)); pm = fmaxf(pm, DPPF(-INFINITY, pm, 0x112, 0xF)); pm = fmaxf(pm, DPPF(-INFINITY, pm, 0x114, 0xF)); pm = fmaxf(pm, DPPF(-INFINITY, pm, 0x118, 0xF));
        pm = fmaxf(pm, DPPF(-INFINITY, pm, 0x142, 0xA)); pm = fmaxf(pm, DPPF(-INFINITY, pm, 0x143, 0xC));
        const float pe = DPPF(-INFINITY, pm, 0x138, 0xF);
        const float G0 = fmaxf(pe, g0), G1 = fmaxf(G0, g1);
        const float Gmax = __builtin_bit_cast(float, __builtin_amdgcn_readlane(__builtin_bit_cast(int, G1), 63)), blast = __builtin_bit_cast(float, __builtin_amdgcn_readlane(__builtin_bit_cast(int, b1), 63));
        *(f32x2*)(gbuf + t0) = (f32x2){b0, b1}; *(f32x2*)(gbuf + 128 + t0) = (f32x2){g0, g1}; *(f32x2*)(gbuf + 256 + t0) = (f32x2){G0, G1};
        wS[t0] = (_Float16)__expf(g0 - Gmax); wS[t0 + 1] = (_Float16)__expf(g1 - Gmax);
        if (lane == 0) { scal[0] = blast; scal[1] = Gmax; } }
    __syncthreads();
    { f32x4 Cacc[8]; f32x4 Cn = (f32x4){0.f, 0.f, 0.f, 0.f};
#pragma unroll
      for (int vt = 0; vt < 8; ++vt) Cacc[vt] = (f32x4){0.f, 0.f, 0.f, 0.f};
#pragma unroll
      for (int ks = 0; ks < 4; ++ks) { const f16x8 kb = tr8(lds + KC + (32 * ks + 4 * g + q4) * ST + (16 * w + 4 * p4) * 2, 16 * ST);
          const u32x2 wa = *(const LAS u32x2*)(wS + 32 * ks + 4 * g), wb = *(const LAS u32x2*)(wS + 32 * ks + 16 + 4 * g); const u32x4 w4 = (u32x4){wa.x, wa.y, wb.x, wb.y}; const f16x8 wf = __builtin_bit_cast(f16x8, w4);
          Cn = ML_MFMA(wf, kb, Cn);
          f16x8 vfb[8];
#pragma unroll
          for (int vt = 0; vt < 8; ++vt) vfb[vt] = tr8(lds + VC + (32 * ks + 4 * g + q4) * ST + (16 * vt + 4 * p4) * 2, 16 * ST);
          __builtin_amdgcn_sched_barrier(0);
#pragma unroll
          for (int vt = 0; vt < 8; ++vt) Cacc[vt] = ML_MFMA(vfb[vt] * wf, kb, Cacc[vt]);
          __builtin_amdgcn_sched_barrier(0); }
#pragma unroll
      for (int vt = 0; vt < 8; ++vt) { u32x2 o_; o_.x = pk2(Cacc[vt][0], Cacc[vt][1]); o_.y = pk2(Cacc[vt][2], Cacc[vt][3]); *(u32x2*)(dC + (16 * w + l16) * 128 + 16 * vt + 4 * g) = o_; }
      if (g == 0) dn[16 * w + l16] = Cn[0]; }
    __syncthreads();
}
__device__ __forceinline__ void phase_ml_scan(Frame& F) {
    unsigned char* ws = F.ws; const int tid = F.tid;
    for (int u = F.bx; u < 256; u += F.G) { const int chain = u >> 2, qtr = u & 3; const size_t e0 = (size_t)qtr * 4096 + tid * 8;
        const bf16* dC = (const bf16*)(ws + WS_DC) + (size_t)chain * 16 * 16384 + e0; bf16* Cp = (bf16*)(ws + WS_CPREV) + (size_t)chain * 16 * 16384 + e0;
        const float* dn = (const float*)(ws + WS_DN) + (size_t)chain * 16 * 128; float* np = (float*)(ws + WS_NPREV) + (size_t)chain * 16 * 128; float* scal = (float*)(ws + WS_SCAL) + (size_t)chain * 16 * 4;
        float z0 = 0.f; asm volatile("" : "+v"(z0));
        float C[8] = {z0, z0, z0, z0, z0, z0, z0, z0}; float nn = z0; float m = z0; const bool don = (qtr == 0 && tid < 128);
        u32x4 dall[16]; float dnall[16]; f32x2 scall[16];
#pragma unroll
        for (int c = 0; c < 16; ++c) { dall[c] = *(const u32x4*)(dC + (size_t)c * 16384); dnall[c] = don ? dn[c * 128 + tid] : z0; scall[c] = *(const f32x2*)(scal + c * 4); }
#pragma unroll
        for (int c = 0; c < 16; ++c) { const u32x4 dcur = dall[c]; const float dncur = dnall[c]; const f32x2 sc = scall[c];
            u32x4 o_; o_.x = pk2(C[0], C[1]); o_.y = pk2(C[2], C[3]); o_.z = pk2(C[4], C[5]); o_.w = pk2(C[6], C[7]); *(u32x4*)(Cp + (size_t)c * 16384) = o_;
            if (don) np[c * 128 + tid] = nn;
            if (qtr == 0 && tid == 0) scal[c * 4 + 2] = m;
            const float Mlast = fmaxf(m, sc[1]), wold = __expf(m - Mlast), wloc = __expf(sc[1] - Mlast);
            C[0] = wold * C[0] + wloc * bflo(dcur.x); C[1] = wold * C[1] + wloc * bfhi(dcur.x); C[2] = wold * C[2] + wloc * bflo(dcur.y); C[3] = wold * C[3] + wloc * bfhi(dcur.y);
            C[4] = wold * C[4] + wloc * bflo(dcur.z); C[5] = wold * C[5] + wloc * bfhi(dcur.z); C[6] = wold * C[6] + wloc * bflo(dcur.w); C[7] = wold * C[7] + wloc * bfhi(dcur.w);
            nn = wold * nn + wloc * dncur; m = sc[0] + Mlast; } }
}
struct X3Pf { u32x4 q[4], k[4], c[4], v[4]; f32x4 g; float mp; };
__device__ __forceinline__ void x3_load(Frame& F, const int item, X3Pf& pf) {
    unsigned char* ws = F.ws; const bf16* proj = (const bf16*)(ws + WS_PROJ); const int tid = F.wave * 64 + pg8::lane_fresh();
    const int chain = item >> 4, c = item & 15, b = chain >> 2, h = chain & 3; const size_t tokc = (size_t)b * SEQ + c * 128;
    const bf16* qcv = (const bf16*)(ws + WS_QCV) + (size_t)item * 16384; const bf16* kcv = (const bf16*)(ws + WS_KCV) + (size_t)item * 16384; const bf16* Cp = (const bf16*)(ws + WS_CPREV) + (size_t)item * 16384;
    const float* gbuf = (const float*)(ws + WS_GBUF) + (size_t)item * 384; const float* np = (const float*)(ws + WS_NPREV) + (size_t)item * 128; const float* scal = (const float*)(ws + WS_SCAL) + (size_t)item * 4;
    const int cg = tid & 15, r0 = tid >> 4;
#pragma unroll
    for (int i = 0; i < 4; ++i) { const int row = r0 + 32 * i;
        pf.q[i] = *(const u32x4*)(qcv + row * 128 + cg * 8); pf.k[i] = *(const u32x4*)(kcv + row * 128 + cg * 8);
        pf.c[i] = *(const u32x4*)(Cp + row * 128 + cg * 8); pf.v[i] = *(const u32x4*)(proj + (tokc + row) * NPROJ + 1024 + h * 128 + cg * 8); }
    pf.g = (f32x4){0.f, 0.f, 0.f, 0.f};
    if (tid < 96) pf.g = *(const f32x4*)(gbuf + 4 * tid); else if (tid < 128) pf.g = *(const f32x4*)(np + 4 * (tid - 96));
    pf.mp = scal[2];
}
__device__ __forceinline__ void ml_x3(Frame& F, int l, const int item, X3Pf& pf, const int next_item) {
    using namespace mls;
    unsigned char* ws = F.ws; const bf16* proj = (const bf16*)(ws + WS_PROJ); bf16* y = (bf16*)(ws + WS_Y);
    const int tid = F.tid, lane = F.lane, w = F.wave, l16 = lane & 15, g = lane >> 4; LAS unsigned char* lds = F.lds;
    const int chain = item >> 4, c = item & 15, b = chain >> 2, h = chain & 3;
    const float* hg = F.in_(8) + l * 512 + h * 128;
    const bf16* qcv = (const bf16*)(ws + WS_QCV) + (size_t)item * 16384; const bf16* kcv = (const bf16*)(ws + WS_KCV) + (size_t)item * 16384; const bf16* Cp = (const bf16*)(ws + WS_CPREV) + (size_t)item * 16384;
    const float* gbuf = (const float*)(ws + WS_GBUF) + (size_t)item * 384; const float* np = (const float*)(ws + WS_NPREV) + (size_t)item * 128; const float* scal = (const float*)(ws + WS_SCAL) + (size_t)item * 4;
    LAS float* bL = (LAS float*)(lds + GB); LAS float* gL = bL + 128; LAS float* GL = bL + 256; LAS float* nL = bL + 384;
    const size_t tokc = (size_t)b * SEQ + c * 128; const int q4 = l16 >> 2, p4 = l16 & 3;
    { const int cg = tid & 15, r0 = tid >> 4;
#pragma unroll
      for (int i = 0; i < 4; ++i) { const int row = r0 + 32 * i;
          *(LAS u32x4*)(lds + QC + row * ST + cg * 16) = pf.q[i]; *(LAS u32x4*)(lds + KC + row * ST + cg * 16) = pf.k[i];
          *(LAS u32x4*)(lds + CT + row * ST + cg * 16) = pf.c[i]; *(LAS u32x4*)(lds + VC + row * ST + cg * 16) = pf.v[i]; }
      if (tid < 96) *(LAS f32x4*)(bL + 4 * tid) = pf.g;
      else if (tid < 128) *(LAS f32x4*)(nL + 4 * (tid - 96)) = pf.g; }
    const float mp = pf.mp;
    __syncthreads();
    if (next_item >= 0) x3_load(F, next_item, pf);
    { const int t = 16 * w + l16; const size_t tok = tokc + t; const float Mt = fmaxf(mp, GL[t]), bt = bL[t]; const float wi = __expf(mp - Mt);
      u32x2 mo8[8];
#pragma unroll
      for (int vt = 0; vt < 8; ++vt) mo8[vt] = *(const u32x2*)(proj + tok * NPROJ + 1536 + h * 128 + 16 * vt + 4 * g);
      f16x8 qf[4], qs[4];
#pragma unroll
      for (int kk = 0; kk < 4; ++kk) { qf[kk] = *(const LAS f16x8*)(lds + QC + (16 * w + l16) * ST + (32 * kk + 8 * g) * 2); qs[kk] = qf[kk] * (_Float16)wi; }
      f32x4 sa[8];
#pragma unroll
      for (int st = 0; st < 8; ++st) { sa[st] = (f32x4){0.f, 0.f, 0.f, 0.f};
          if (st <= w) { f16x8 kf[4];
#pragma unroll
              for (int kk = 0; kk < 4; ++kk) kf[kk] = *(const LAS f16x8*)(lds + KC + (16 * st + l16) * ST + (32 * kk + 8 * g) * 2);
              __builtin_amdgcn_sched_barrier(0);
#pragma unroll
              for (int kk = 0; kk < 4; ++kk) sa[st] = ML_MFMA(kf[kk], qf[kk], sa[st]);
              __builtin_amdgcn_sched_barrier(0); } }
      float den = 0.f;
#pragma unroll
      for (int st = 0; st < 8; ++st) { const f32x4 gv = *(const LAS f32x4*)(gL + 16 * st + 4 * g);
#pragma unroll
          for (int r = 0; r < 4; ++r) { const int s_ = 16 * st + 4 * g + r; const float p = (s_ <= t) ? sa[st][r] * __expf(gv[r] - Mt) : 0.f; den += p; sa[st][r] = p; } }
      f16x8 Pf[4];
#pragma unroll
      for (int ks = 0; ks < 4; ++ks) Pf[ks] = sbat::cvt8(sa[2 * ks][0], sa[2 * ks][1], sa[2 * ks][2], sa[2 * ks][3], sa[2 * ks + 1][0], sa[2 * ks + 1][1], sa[2 * ks + 1][2], sa[2 * ks + 1][3]);
      f32x4 nt[8];
#pragma unroll
      for (int vt = 0; vt < 8; ++vt) { nt[vt] = (f32x4){0.f, 0.f, 0.f, 0.f}; f16x8 vf[4], cf[4];
#pragma unroll
          for (int ks = 0; ks < 4; ++ks) if (32 * ks <= 16 * w + 15) vf[ks] = tr8(lds + VC + (32 * ks + 4 * g + q4) * ST + (16 * vt + 4 * p4) * 2, 16 * ST);
#pragma unroll
          for (int kk = 0; kk < 4; ++kk) cf[kk] = tr8(lds + CT + (32 * kk + 8 * g + q4) * ST + (16 * vt + 4 * p4) * 2, 4 * ST);
          __builtin_amdgcn_sched_barrier(0);
#pragma unroll
          for (int ks = 0; ks < 4; ++ks) if (32 * ks <= 16 * w + 15) nt[vt] = ML_MFMA(vf[ks], Pf[ks], nt[vt]);
#pragma unroll
          for (int kk = 0; kk < 4; ++kk) nt[vt] = ML_MFMA(cf[kk], qs[kk], nt[vt]);
          __builtin_amdgcn_sched_barrier(0); }
      den = xor16_sum(den); den = xor32_sum(den);
      float nq = 0.f;
#pragma unroll
      for (int kk = 0; kk < 4; ++kk) { const f32x4 n0 = *(const LAS f32x4*)(nL + 32 * kk + 8 * g), n1 = *(const LAS f32x4*)(nL + 32 * kk + 8 * g + 4);
          nq += n0[0] * (float)qf[kk][0] + n0[1] * (float)qf[kk][1] + n0[2] * (float)qf[kk][2] + n0[3] * (float)qf[kk][3] + n1[0] * (float)qf[kk][4] + n1[1] * (float)qf[kk][5] + n1[2] * (float)qf[kk][6] + n1[3] * (float)qf[kk][7]; }
      nq = xor16_sum(nq); nq = xor32_sum(nq);
      den += wi * nq;
      const float dn_ = __builtin_amdgcn_rcpf(fmaxf(fabsf(den), __expf(-(bt + Mt)))); float ss = 0.f;
#pragma unroll
      for (int vt = 0; vt < 8; ++vt)
#pragma unroll
          for (int r = 0; r < 4; ++r) { nt[vt][r] *= dn_; ss += nt[vt][r] * nt[vt][r]; }
      ss = xor16_sum(ss); ss = xor32_sum(ss); const float rr = rsqrtf(ss * (1.0f / 128) + EPS);
#pragma unroll
      for (int vt = 0; vt < 8; ++vt) { const int v0 = 16 * vt + 4 * g; const u32x2 mo = mo8[vt]; const f32x4 gg = *(const f32x4*)(hg + v0);
          u32x2 o_; o_.x = pk2(sigmf(bflo(mo.x)) * nt[vt][0] * rr * gg[0], sigmf(bfhi(mo.x)) * nt[vt][1] * rr * gg[1]); o_.y = pk2(sigmf(bflo(mo.y)) * nt[vt][2] * rr * gg[2], sigmf(bfhi(mo.y)) * nt[vt][3] * rr * gg[3]);
          *(u32x2*)(y + tok * D + h * 128 + v0) = o_; } }
    __syncthreads();
}

__device__ __forceinline__ void phase_mixer(Frame& F, int l, int qidx, int mode) {
    volatile LAS int* qs = (volatile LAS int*)(F.lds + MISC_OFF + 64); unsigned* qc = F.ctl + CW_Q + qidx;
    int ahead = 0; if (F.tid == 0) ahead = (int)atomicAdd(qc, 1u);
    for (;;) {
        if (F.tid == 0) *qs = ahead;
        __syncthreads();
        const int it = __builtin_amdgcn_readfirstlane(*qs);
        __syncthreads();
        if (it >= 512 + 1024) break;
        if (F.tid == 0) ahead = (int)atomicAdd(qc, 1u);
        if (mode == 1 && it < 512) continue;
        if (mode == 3 && it >= 512) break;
        Frame G = F;
        { int t_ = F.tid; asm volatile("" : "+v"(t_)); G.tid = t_; G.lane = t_ & 63; G.wave = __builtin_amdgcn_readfirstlane(t_ >> 6);
          unsigned lb_ = 0; asm volatile("" : "+s"(lb_)); G.lds = F.lds + lb_;
          GAS unsigned char* w_ = (GAS unsigned char*)F.ws; asm volatile("" : "+s"(w_)); G.ws = (unsigned char*)w_; }
        if (it >= 512) ml_x1(G, l, it - 512);
        else sb_unit(G, l, it & 63, 7 - (it >> 6));
    }
}

namespace xat {
constexpr int KST = 272, VST = 320, BUFB = 64 * VST, OST = 272;
typedef __amdgpu_buffer_rsrc_t rsrc_t;
__device__ __forceinline__ float xor32_max(float x) { auto t = __builtin_amdgcn_permlane32_swap(__float_as_uint(x), __float_as_uint(x), false, false); return fmaxf(__uint_as_float(t[0]), __uint_as_float(t[1])); }
template <int S> struct Step { static constexpr int isV = S >= 8, tile = isV ? ((S - 8) & 3) : (S >> 1), dh = isV ? ((S - 8) >> 2) : (S & 1), buf = S % 3; };
template <int S> __device__ __forceinline__ void ld(u32x4 (&r)[2], rsrc_t kvr, unsigned loff) {
    if constexpr (S < 16) {
#pragma unroll
        for (int i = 0; i < 2; ++i) r[i] = __builtin_bit_cast(u32x4, __builtin_amdgcn_raw_buffer_load_b128(kvr, loff, ((64 * Step<S>::tile + 32 * i) * 2048 + Step<S>::isV * 1024 + Step<S>::dh * 128) * 2, 0)); }
}
template <int S> __device__ __forceinline__ void st(const u32x4 (&r)[2], LAS unsigned char* lds, unsigned lk, unsigned lv) {
    if constexpr (S < 16) { constexpr int ST = Step<S>::isV ? VST : KST;
#pragma unroll
        for (int i = 0; i < 2; ++i) *(LAS u32x4*)(lds + (Step<S>::isV ? lv : lk) + Step<S>::buf * BUFB + 32 * i * ST) = r[i]; }
}
template <int S> __device__ __forceinline__ void qk(f32x16& S0, f32x16& S1, const f16x8 (&qf)[16], const LAS unsigned char* lds, int t32, int hi) {
#pragma unroll
    for (int kk = 0; kk < 8; ++kk) { const f16x8 k0 = *(const LAS f16x8*)(lds + Step<S>::buf * BUFB + t32 * KST + 32 * kk + 16 * hi); const f16x8 k1 = *(const LAS f16x8*)(lds + Step<S>::buf * BUFB + (32 + t32) * KST + 32 * kk + 16 * hi);
        S0 = SB_MFMA(k0, qf[8 * Step<S>::dh + kk], S0); S1 = SB_MFMA(k1, qf[8 * Step<S>::dh + kk], S1); }
}
template <int TILE> __device__ __forceinline__ void smax(f32x16& S0, f32x16& S1, f16x8 (&Pf)[8][2], float (&mt)[4], float& m, float& sum) {
    float tm = fmaxf(S0[0], S1[0]);
#pragma unroll
    for (int r = 1; r < 16; ++r) tm = fmaxf(tm, fmaxf(S0[r], S1[r]));
    tm = xor32_max(tm);
    const float mn = fmaxf(m, tm); sum *= __builtin_amdgcn_exp2f(m - mn); m = mn; mt[TILE] = mn;
    float ps = 0.f;
#pragma unroll
    for (int r = 0; r < 16; ++r) { S0[r] = __builtin_amdgcn_exp2f(S0[r] - mn); S1[r] = __builtin_amdgcn_exp2f(S1[r] - mn); ps += S0[r] + S1[r]; }
    sum += ps;
    Pf[2 * TILE][0] = sbat::cvt8(S0[0], S0[1], S0[2], S0[3], S0[4], S0[5], S0[6], S0[7]); Pf[2 * TILE][1] = sbat::cvt8(S0[8], S0[9], S0[10], S0[11], S0[12], S0[13], S0[14], S0[15]);
    Pf[2 * TILE + 1][0] = sbat::cvt8(S1[0], S1[1], S1[2], S1[3], S1[4], S1[5], S1[6], S1[7]); Pf[2 * TILE + 1][1] = sbat::cvt8(S1[8], S1[9], S1[10], S1[11], S1[12], S1[13], S1[14], S1[15]);
#pragma unroll
    for (int r = 0; r < 16; ++r) { S0[r] = 0.f; S1[r] = 0.f; }
}
template <int S> __device__ __forceinline__ void pv(f32x16 (&O)[4], const f16x8 (&Pf)[8][2], const LAS unsigned char* lds, int lane, int hi) {
    const int i16 = lane & 15, dhalf = (lane >> 4) & 1;
    const LAS unsigned char* va = lds + Step<S>::buf * BUFB + (4 * hi + (i16 >> 2)) * VST + (dhalf * 16 + 4 * (i16 & 3)) * 2;
#pragma unroll
    for (int dblk = 0; dblk < 4; ++dblk)
#pragma unroll
        for (int sb = 0; sb < 2; ++sb)
#pragma unroll
            for (int sp = 0; sp < 2; ++sp) { const LAS unsigned char* pp = va + (32 * sb + 16 * sp) * VST + dblk * 64; const s16x4 lo = sbat::vtr(pp), h4 = sbat::vtr(pp + 8 * VST);
                const bf16x8 vf = (bf16x8){lo[0], lo[1], lo[2], lo[3], h4[0], h4[1], h4[2], h4[3]};
                O[dblk] = SB_MFMA(__builtin_bit_cast(f16x8, vf), Pf[2 * Step<S>::tile + sb][sp], O[dblk]); }
}
}
__device__ __forceinline__ void phase_xattn(Frame& F) {
    using namespace xat;
    unsigned char* ws = F.ws; const bf16* q = (const bf16*)(ws + WS_Q); const bf16* kv = (const bf16*)(ws + WS_KV); bf16* o = (bf16*)(ws + WS_O);
    const int tid = F.tid, lane = F.lane, w = F.wave, t32 = lane & 31, hi = lane >> 5; LAS unsigned char* lds = F.lds;
    const unsigned loff = (unsigned)((tid >> 4) * 2048 + (tid & 15) * 8) * 2u, lk = (unsigned)((tid >> 4) * KST + (tid & 15) * 16), lv = (unsigned)((tid >> 4) * VST + (tid & 15) * 16);
    for (int unit = F.bx; unit < 512; unit += F.G) {
        const int bh = (unit & 255) >> 2, qblk = ((unit & 3) << 1) | (unit >> 8), b = bh >> 2, hd = bh & 3;
        const size_t tok0 = (size_t)b * SEQ + qblk * 256 + 32 * w;
        const bf16* kvb = kv + (size_t)b * MEML * 2048 + hd * 256;
        const rsrc_t kvr = __builtin_amdgcn_make_buffer_rsrc((void*)kvb, 0, 0x7fffffff, 0x00020000);
        f16x8 qf[16];
        { const bf16* qrow = q + (tok0 + t32) * D + hd * 256 + 8 * hi;
#pragma unroll
          for (int kk = 0; kk < 16; ++kk) qf[kk] = *(const f16x8*)(qrow + 16 * kk); }
        f16x8 Pf[8][2]; float mt[4]; float m = -INFINITY, sum = 0.f;
        f32x16 S0, S1;
#pragma unroll
        for (int r = 0; r < 16; ++r) { S0[r] = 0.f; S1[r] = 0.f; }
        u32x4 rA[2], rB[2];
        ld<0>(rA, kvr, loff); st<0>(rA, lds, lk, lv); ld<1>(rB, kvr, loff); __syncthreads();
#define XA_KSTEP(S_, RL, RS) ld<S_ + 2>(RL, kvr, loff); qk<S_>(S0, S1, qf, lds, t32, hi); if ((S_) & 1) smax<((S_) / 2)>(S0, S1, Pf, mt, m, sum); st<S_ + 1>(RS, lds, lk, lv); __syncthreads();
        XA_KSTEP(0, rA, rB) XA_KSTEP(1, rB, rA) XA_KSTEP(2, rA, rB) XA_KSTEP(3, rB, rA) XA_KSTEP(4, rA, rB) XA_KSTEP(5, rB, rA) XA_KSTEP(6, rA, rB) XA_KSTEP(7, rB, rA)
#undef XA_KSTEP
#pragma unroll
        for (int t = 0; t < 3; ++t) { const _Float16 f = (_Float16)__builtin_amdgcn_exp2f(mt[t] - m);
#pragma unroll
            for (int sb = 0; sb < 2; ++sb)
#pragma unroll
                for (int sp = 0; sp < 2; ++sp) Pf[2 * t + sb][sp] = Pf[2 * t + sb][sp] * f; }
        sum = xor32_sum(sum); const float inv = 1.0f / sum;
        LAS unsigned char* stg = lds + 3 * BUFB + w * (32 * OST);
#define XA_VSTEP(S_, RL, RS) ld<S_ + 2>(RL, kvr, loff); pv<S_>(O, Pf, lds, lane, hi); st<S_ + 1>(RS, lds, lk, lv); __syncthreads();
#pragma unroll
        for (int dh = 0; dh < 2; ++dh) {
            f32x16 O[4];
#pragma unroll
            for (int dblk = 0; dblk < 4; ++dblk)
#pragma unroll
                for (int r = 0; r < 16; ++r) O[dblk][r] = 0.f;
            if (dh == 0) { XA_VSTEP(8, rA, rB) XA_VSTEP(9, rB, rA) XA_VSTEP(10, rA, rB) XA_VSTEP(11, rB, rA) }
            else         { XA_VSTEP(12, rA, rB) XA_VSTEP(13, rB, rA) XA_VSTEP(14, rA, rB) XA_VSTEP(15, rB, rA) }
            int le = lane; asm volatile("" : "+v"(le));
            const int t32e = le & 31, hie = le >> 5;
#pragma unroll
            for (int db = 0; db < 4; ++db)
#pragma unroll
                for (int rq = 0; rq < 4; ++rq) { u32x2 v; v.x = pk2(O[db][4 * rq] * inv, O[db][4 * rq + 1] * inv); v.y = pk2(O[db][4 * rq + 2] * inv, O[db][4 * rq + 3] * inv);
                    *(LAS u32x2*)(stg + t32e * OST + (db * 32 + 8 * rq + 4 * hie) * 2) = v; }
            LDS_WAIT();
            const int ch = le & 15;
#pragma unroll
            for (int i = 0; i < 8; ++i) { const int row = i * 4 + (le >> 4); const u32x4 v = *(const LAS u32x4*)(stg + row * OST + ch * 16);
                *(u32x4*)(o + (tok0 + row) * D + hd * 256 + dh * 128 + ch * 8) = v; }
            LDS_WAIT();
        }
#undef XA_VSTEP
    }
}


namespace xat2 {
#define XA2_NPARK 7
__device__ __forceinline__ int lane_now() { int l; asm volatile("v_mbcnt_lo_u32_b32 %0, -1, 0\n\tv_mbcnt_hi_u32_b32 %0, -1, %0" : "=v"(l)); return l; }
__device__ __forceinline__ void dma_kv(const char* src0, LAS unsigned char* lds, int w, unsigned gofs) {
#pragma unroll
    for (int i = 0; i < 16; ++i) __builtin_amdgcn_global_load_lds((const unsigned*)(src0 + gofs + (size_t)i * 16 * 4096), (LAS unsigned*)(lds + (w + 8 * i) * 1024), 16, 0, 0);
}
}
__device__ __forceinline__ void phase_xattn2(Frame& F) {
    using namespace xat;
    unsigned char* ws = F.ws; const bf16* q = (const bf16*)(ws + WS_Q); const bf16* kv = (const bf16*)(ws + WS_KV); bf16* o = (bf16*)(ws + WS_O);
    const int w = F.wave; LAS unsigned char* lds = F.lds;
#define XA2_GOFS(L) ((unsigned)(2 * w + ((L) >> 5)) * 4096u + 16u * (unsigned)(((L) & 31) ^ (((2 * (w & 1) + ((L) >> 5)) << 2) | ((w >> 1) & 3))))
    for (int cu = F.bx; cu < 256; cu += F.G) {
        const int bh = cu >> 2, qp = cu & 3, b = bh >> 2, hd = bh & 3;
        const char* kvb = (const char*)(kv + (size_t)b * MEML * 2048 + hd * 256);
        const size_t tokA = (size_t)b * SEQ + 512 * qp + 32 * w;
        int lane = xat2::lane_now();
        xat2::dma_kv(kvb, lds, w, XA2_GOFS(lane));
        lane = xat2::lane_now();
        const int t32 = lane & 31, hi = lane >> 5;
        const int kA = t32 * 512 + ((hi ^ (((t32 & 3) << 2) | ((t32 >> 2) & 3))) << 4);
        f16x8 PfA[8][2], PfB[8][2]; float invA = 0.f, invB = 0.f;
#define XA2_LOADQ(TOK0) { const bf16* qrow = q + ((TOK0) + t32) * D + hd * 256 + 8 * hi; _Pragma("unroll") for (int kk = 0; kk < 16; ++kk) qf[kk] = *(const f16x8*)(qrow + 16 * kk); }
#define XA2_QK(PF, INV) do { \
            float mt[4]; float m = -INFINITY, sum = 0.f; f32x16 S0, S1; _Pragma("unroll") for (int r = 0; r < 16; ++r) { S0[r] = 0.f; S1[r] = 0.f; } \
            XA2_QKT(PF, 0) XA2_QKT(PF, 1) XA2_QKT(PF, 2) XA2_QKT(PF, 3) \
            _Pragma("unroll") for (int t = 0; t < 3; ++t) { const _Float16 f = (_Float16)__builtin_amdgcn_exp2f(mt[t] - m); _Pragma("unroll") for (int sb = 0; sb < 2; ++sb) _Pragma("unroll") for (int sp = 0; sp < 2; ++sp) PF[2 * t + sb][sp] = PF[2 * t + sb][sp] * f; } \
            sum = xor32_sum(sum); INV = 1.0f / sum; } while (0)
#define XA2_RDB(G) { _Pragma("unroll") for (int j = 0; j < XA2_NB; ++j) { const int kk = (G) * XA2_NB + j; kb[(G) & XA2_PIPE][j][0] = *(const LAS f16x8*)(lds + (kAt ^ (32 * kk))); kb[(G) & XA2_PIPE][j][1] = *(const LAS f16x8*)(lds + ((kAt + 32 * 512) ^ (32 * kk))); } }
#define XA2_QKT(PF, T) { int kAt = kA + (64 * (T)) * 512; asm volatile("" : "+v"(kAt)); f16x8 kb[XA2_PIPE + 1][XA2_NB][2]; \
            if (XA2_PIPE) { XA2_RDB(0) } \
            _Pragma("unroll") for (int g = 0; g < 16 / XA2_NB; ++g) { \
                if (XA2_PIPE) { if (g + 1 < 16 / XA2_NB) { XA2_RDB(g + 1) } } else { XA2_RDB(g) } \
                __builtin_amdgcn_sched_barrier(0); \
                _Pragma("unroll") for (int j = 0; j < XA2_NB; ++j) { S0 = SB_MFMA(kb[g & XA2_PIPE][j][0], qf[g * XA2_NB + j], S0); S1 = SB_MFMA(kb[g & XA2_PIPE][j][1], qf[g * XA2_NB + j], S1); } \
                __builtin_amdgcn_sched_barrier(0); } \
            smax<T>(S0, S1, PF, mt, m, sum); __builtin_amdgcn_sched_barrier(0); }
        f16x8 qf[16];
        XA2_LOADQ(tokA);
        asm volatile("s_waitcnt vmcnt(0)" ::: "memory"); __syncthreads();
#define XA2_NB 4
#define XA2_PIPE 1
        XA2_QK(PfA, invA);
#undef XA2_NB
#undef XA2_PIPE
#define XA2_NB 2
#define XA2_PIPE 0
        XA2_LOADQ(tokA + 256);
        u32x4* pscr = (u32x4*)(ws + WS_QCV) + (size_t)cu * XA2_NPARK * NTHREADS + (w * 64 + xat2::lane_now());
#pragma unroll
        for (int i = 0; i < XA2_NPARK; ++i) pscr[i * NTHREADS] = __builtin_bit_cast(u32x4, PfA[i >> 1][i & 1]);
        XA2_QK(PfB, invB);
#undef XA2_NB
#undef XA2_PIPE
#undef XA2_RDB
#undef XA2_QK
#undef XA2_LOADQ
#undef XA2_QKT
        __syncthreads();
        { const int l2 = xat2::lane_now(); xat2::dma_kv(kvb + 2048, lds, w, XA2_GOFS(l2)); }
        asm volatile("s_waitcnt vmcnt(0)" ::: "memory"); __syncthreads();
        const int l3 = xat2::lane_now();
        const int i16 = l3 & 15, q4 = i16 >> 2, p4 = i16 & 3, dhalf = (l3 >> 4) & 1, hi3 = l3 >> 5;
        const int vA = (4 * hi3 + q4) * 512 + ((q4 << 6) | ((((dhalf << 1) | (p4 >> 1)) ^ hi3) << 4) | ((p4 & 1) << 3));
        LAS unsigned char* stg = lds + RING_BYTES + w * 2560;
#define XA2_PV(PF, INV, TOK0) do { _Pragma("unroll") for (int dh = 0; dh < 2; ++dh) { f32x16 O[4]; _Pragma("unroll") for (int db = 0; db < 4; ++db) _Pragma("unroll") for (int r = 0; r < 16; ++r) O[db][r] = 0.f; \
            _Pragma("unroll") for (int T = 0; T < 4; ++T) { int vAt = vA + 64 * T * 512; asm volatile("" : "+v"(vAt)); _Pragma("unroll") for (int db = 0; db < 4; ++db) _Pragma("unroll") for (int sb = 0; sb < 2; ++sb) _Pragma("unroll") for (int sp = 0; sp < 2; ++sp) { \
                const int rows0 = (32 * sb + 16 * sp) * 512, dx = (4 * dh + db) * 64; \
                const s16x4 lo = sbat::vtr(lds + ((vAt + rows0) ^ dx)), h4 = sbat::vtr(lds + ((vAt + rows0 + 8 * 512) ^ dx ^ 32)); \
                const bf16x8 vf = (bf16x8){lo[0], lo[1], lo[2], lo[3], h4[0], h4[1], h4[2], h4[3]}; \
                O[db] = SB_MFMA(__builtin_bit_cast(f16x8, vf), PF[2 * T + sb][sp], O[db]); if (sb == 1 && sp == 1) __builtin_amdgcn_sched_barrier(0); } } \
            const int le = xat2::lane_now(); const int t32e = le & 31, hie = le >> 5; \
            _Pragma("unroll") for (int db = 0; db < 4; ++db) { \
              if (F8_MO) { \
                _Pragma("unroll") for (int rq = 0; rq < 4; ++rq) *(LAS unsigned*)(stg + t32e * 48 + 8 * rq + 4 * hie) = f8x4(O[db][4 * rq] * ((INV) * F8_HSCALE), O[db][4 * rq + 1] * ((INV) * F8_HSCALE), O[db][4 * rq + 2] * ((INV) * F8_HSCALE), O[db][4 * rq + 3] * ((INV) * F8_HSCALE)); \
                LDS_WAIT(); \
                { const int row = le >> 1, hf = le & 1; const u32x4 v = *(const LAS u32x4*)(stg + row * 48 + hf * 16); \
                    *(u32x4*)((unsigned char*)o + ((TOK0) + row) * D + hd * 256 + (4 * dh + db) * 32 + hf * 16) = v; } \
                LDS_WAIT(); \
              } else { \
                _Pragma("unroll") for (int rq = 0; rq < 4; ++rq) { u32x2 v; v.x = pk2(O[db][4 * rq] * (INV), O[db][4 * rq + 1] * (INV)); v.y = pk2(O[db][4 * rq + 2] * (INV), O[db][4 * rq + 3] * (INV)); \
                    *(LAS u32x2*)(stg + t32e * 80 + (8 * rq + 4 * hie) * 2) = v; } \
                LDS_WAIT(); \
                _Pragma("unroll") for (int i = 0; i < 2; ++i) { const int row = (le >> 2) + 16 * i, ch = le & 3; const u32x4 v = *(const LAS u32x4*)(stg + row * 80 + ch * 16); \
                    *(u32x4*)(o + ((TOK0) + row) * D + hd * 256 + (4 * dh + db) * 32 + ch * 8) = v; } \
                LDS_WAIT(); } } } } while (0)
        XA2_PV(PfB, invB, tokA + 256);
#pragma unroll
        for (int i = 0; i < XA2_NPARK; ++i) PfA[i >> 1][i & 1] = __builtin_bit_cast(f16x8, pscr[i * NTHREADS]);
        XA2_PV(PfA, invA, tokA);
#undef XA2_PV
#undef XA2_GOFS
        __syncthreads();
    }
}

__device__ __forceinline__ void phase_gates(Frame& F) {
    unsigned char* ws = F.ws; const bf16* xbp = (const bf16*)(ws + WS_XB); const bf16* wg = (const bf16*)(ws + WS_WIN) + (size_t)NPROJ * D; const float* ssq = (const float*)(ws + WS_SSQ); float* gates = (float*)(ws + WS_GATES);
    const int tid = F.tid, lane = F.lane, w = F.wave, l16 = lane & 15, g = lane >> 4, tpb = NTOK / F.G; LAS unsigned char* lds = F.lds;
    constexpr int WST = 2064;
    for (int e = tid; e < 16 * 128; e += NTHREADS) { const int n = e >> 7, k8 = (e & 127) * 8; u32x4 o_ = (u32x4){0u, 0u, 0u, 0u}; if (n < 8) o_ = *(const u32x4*)(wg + (size_t)n * D + k8); *(LAS u32x4*)(lds + n * WST + k8 * 2) = o_; }
    __syncthreads();
    for (int t0 = w * 16; t0 < tpb; t0 += NWAVES * 16) { const int tokb = F.bx * tpb + t0;
        f32x4 acc = (f32x4){0.f, 0.f, 0.f, 0.f}; const bf16* xrow = xbp + (size_t)(tokb + l16) * D + 8 * g;
#pragma unroll
        for (int kb = 0; kb < 2; ++kb) { f16x8 af[16];
#pragma unroll
            for (int j = 0; j < 16; ++j) af[j] = *(const f16x8*)(xrow + 32 * (16 * kb + j));
#pragma unroll
            for (int j = 0; j < 16; ++j) { const int kk = 16 * kb + j; const f16x8 b0 = *(const LAS f16x8*)(lds + l16 * WST + (32 * kk + 8 * g) * 2); acc = ML_MFMA(af[j], b0, acc); } }
        if (l16 < 8) {
#pragma unroll
            for (int r = 0; r < 4; ++r) gates[(size_t)(tokb + 4 * g + r) * 8 + l16] = acc[r] * pg8::rstd_from_ssq(ssq, tokb + 4 * g + r); } }
    __syncthreads();
}

__device__ __forceinline__ void phase_router1(Frame& F, int l) {
    unsigned char* ws = F.ws; const bf16* xbp = (const bf16*)(ws + WS_XB); const float* wr = (const float*)(ws + WS_WR); const float* ssq = (const float*)(ws + WS_SSQ);
    u32x4* tokinfo = (u32x4*)(ws + WS_TOKINFO); int* cntb = (int*)(ws + WS_CNTB); unsigned char* xq8 = ws + WS_XQ8; const bool f8 = layer_f8(l);
    const int tid = F.tid, lane = F.lane, w = F.wave, l16 = lane & 15, g = lane >> 4, tpb = NTOK / F.G; LAS unsigned char* lds = F.lds;
    constexpr int WST = 2064;
    LAS int* clsL = (LAS int*)(lds + SCR_OFF); LAS float* fL = (LAS float*)(lds + SCR_OFF + 2048); LAS float* lgL = (LAS float*)(lds + 32 * WST) + w * 512;
    for (int e = tid; e < 32 * 128; e += NTHREADS) { const int n = e >> 7, k8 = (e & 127) * 8; u32x4 o_ = (u32x4){0u, 0u, 0u, 0u};
        if (n < 20) { const f32x4 a0 = *(const f32x4*)(wr + n * D + k8), a1 = *(const f32x4*)(wr + n * D + k8 + 4); o_.x = pk2(a0[0], a0[1]); o_.y = pk2(a0[2], a0[3]); o_.z = pk2(a1[0], a1[1]); o_.w = pk2(a1[2], a1[3]); }
        *(LAS u32x4*)(lds + n * WST + k8 * 2) = o_; }
    __syncthreads();
    for (int t0 = w * 16; t0 < tpb; t0 += NWAVES * 16) { const int tokb = F.bx * tpb + t0;
        f32x4 acc0 = (f32x4){0.f, 0.f, 0.f, 0.f}, acc1 = acc0; const bf16* xrow = xbp + (size_t)(tokb + l16) * D + 8 * g;
#pragma unroll
        for (int kb = 0; kb < 4; ++kb) { f16x8 af[8];
#pragma unroll
            for (int j = 0; j < 8; ++j) af[j] = *(const f16x8*)(xrow + 32 * (8 * kb + j));
            if (f8) {
#pragma unroll
                for (int j = 0; j < 8; ++j) { u32x2 o; o.x = f8x4((float)af[j][0], (float)af[j][1], (float)af[j][2], (float)af[j][3]); o.y = f8x4((float)af[j][4], (float)af[j][5], (float)af[j][6], (float)af[j][7]);
                    *(u32x2*)(xq8 + (size_t)(tokb + l16) * D + 32 * (8 * kb + j) + 8 * g) = o; } }
#pragma unroll
            for (int j = 0; j < 8; ++j) { const int kk = 8 * kb + j; const f16x8 b0 = *(const LAS f16x8*)(lds + l16 * WST + (32 * kk + 8 * g) * 2), b1 = *(const LAS f16x8*)(lds + (16 + l16) * WST + (32 * kk + 8 * g) * 2);
                acc0 = ML_MFMA(af[j], b0, acc0); acc1 = ML_MFMA(af[j], b1, acc1); } }
        const float bias0 = wr[20 * D + l16], bias1 = l16 < 4 ? wr[20 * D + 16 + l16] : 0.f;
#pragma unroll
        for (int r = 0; r < 4; ++r) { const float rs = pg8::rstd_from_ssq(ssq, tokb + 4 * g + r); lgL[(4 * g + r) * 32 + l16] = acc0[r] * rs + bias0; lgL[(4 * g + r) * 32 + 16 + l16] = acc1[r] * rs + bias1; }
        LDS_WAIT();
        if (lane < 16) { const LAS float* lp = lgL + lane * 32; const f32x4 lg = *(const LAS f32x4*)lp; const int tok = tokb + lane;
            int gs = 0; float gm = lg[0];
#pragma unroll
            for (int j = 1; j < 4; ++j) if (lg[j] > gm) { gm = lg[j]; gs = j; }
            float gsum = 0.f;
#pragma unroll
            for (int j = 0; j < 4; ++j) gsum += __expf(lg[j] - gm);
            const float psel = 1.f / gsum; const f32x4 es = *(const LAS f32x4*)(lp + 4 + 4 * gs);
            int i0 = 0; float m0 = es[0];
#pragma unroll
            for (int e = 1; e < 4; ++e) if (es[e] > m0) { m0 = es[e]; i0 = e; }
            int i1 = -1; float m1 = -INFINITY;
#pragma unroll
            for (int e = 0; e < 4; ++e) if (e != i0 && es[e] > m1) { m1 = es[e]; i1 = e; }
            const float e1 = __expf(m1 - m0); const float w0 = 1.f / (1.f + e1), w1 = e1 / (1.f + e1);
            const int ea = i0 < i1 ? i0 : i1, eb = i0 < i1 ? i1 : i0; const float ga = psel * (i0 < i1 ? w0 : w1), gb = psel * (i0 < i1 ? w1 : w0);
            const int lt = t0 + lane; clsL[lt] = gs * 6 + pair_index(ea, eb); fL[lt] = ga; fL[tpb + lt] = gb; fL[2 * tpb + lt] = pg8::rstd_from_ssq(ssq, tok); }
        LDS_WAIT(); }
    __syncthreads();
    if (F.tid < tpb) { const int c = clsL[F.tid]; int rank = 0; for (int t = 0; t < F.tid; ++t) rank += (clsL[t] == c) ? 1 : 0;
        tokinfo[F.bx * tpb + F.tid] = (u32x4){(unsigned)c | ((unsigned)rank << 8), __float_as_uint(fL[F.tid]), __float_as_uint(fL[tpb + F.tid]), __float_as_uint(fL[2 * tpb + F.tid])}; }
    if (F.tid >= 256 && F.tid < 256 + 32) { const int c = F.tid - 256; int n = 0; if (c < NCLS) for (int t = 0; t < tpb; ++t) n += (clsL[t] == c) ? 1 : 0; cntb[F.bx * 32 + c] = n; }
}
__device__ __forceinline__ void phase_router2(Frame& F, int l) {
    unsigned char* ws = F.ws; const u32x4* tokinfo = (const u32x4*)(ws + WS_TOKINFO); const int* cntb = (const int*)(ws + WS_CNTB);
    int* tokl = (int*)(ws + WS_SLOT); float* gwa = (float*)(ws + WS_SLOT + SLOT_ARR); float* gwb = (float*)(ws + WS_SLOT + 2 * SLOT_ARR); float* rsl = (float*)(ws + WS_SLOT + 3 * SLOT_ARR);
    const int tpb = NTOK / F.G; LAS int* baseL = (LAS int*)(F.lds + SCR_OFF);
    { const int c = F.tid & 31, part = F.tid >> 5; int acc = 0; for (int b2 = part; b2 < F.bx; b2 += 16) acc += cntb[b2 * 32 + c];
      ((LAS int*)(F.lds + SCR_OFF + 1024))[part * 32 + c] = acc; }
    __syncthreads();
    if (F.tid < 32) { int acc = 0;
#pragma unroll
        for (int part = 0; part < 16; ++part) acc += ((LAS int*)(F.lds + SCR_OFF + 1024))[part * 32 + F.tid]; baseL[F.tid] = acc;
        if (F.bx == F.G - 1 && F.tid < NCLS) F.ctl[CW_CNT + l * 32 + F.tid] = (unsigned)(acc + cntb[F.bx * 32 + F.tid]); }
    __syncthreads();
    if (F.tid < tpb) { const int tok = F.bx * tpb + F.tid; const u32x4 inf = tokinfo[tok]; const int cls = inf.x & 255, rank = inf.x >> 8;
        const size_t o = (size_t)cls * CLSCAP + baseL[cls] + rank; tokl[o] = tok; gwa[o] = __uint_as_float(inf.y); gwb[o] = __uint_as_float(inf.z); rsl[o] = __uint_as_float(inf.w); }
}

__device__ __forceinline__ const char* uni_ptr(const char* p) { const unsigned long long v = (unsigned long long)p; const unsigned lo = __builtin_amdgcn_readfirstlane((unsigned)v), hi = __builtin_amdgcn_readfirstlane((unsigned)(v >> 32)); return (const char*)(((unsigned long long)hi << 32) | lo); }
struct SchedMoe {
    const LAS int* tb; const unsigned* cnt; const char* A; const char* B; const int* tokl; int ncol, G, c, nwg; bool up; int eb;
    __device__ __forceinline__ bool next(int i, pg8::Unit& u) const {
        const long L = (long)i * G + c; if (L >= nwg) return false;
        const int id = pg8::xcd_remap((int)L, nwg); const int rt = id / ncol, ct = id % ncol;
        int cls = 0;
#pragma unroll 1
        for (int k = 1; k < NCLS; ++k) if (rt >= tb[k]) cls = k;
        const int slot0 = (rt - tb[cls]) * 256; const int g = cls / 6, pr = cls % 6;
        const int ea = pr < 3 ? 0 : (pr < 5 ? 1 : 2), eb = pr < 3 ? pr + 1 : (pr < 5 ? pr - 1 : 3);
        u.pm = rt; u.pn = ct; u.cls = cls; u.slot0 = slot0; u.nvalid = (int)cnt[cls] - slot0; u.rows = tokl + (size_t)cls * CLSCAP + slot0;
        if (up) { const int ge = g * 4 + (ct < 4 ? ea : eb); u.a = A; u.b = B + ((size_t)ge * 1024 + (ct & 3) * 256) * (size_t)(D * this->eb); }
        else { u.a = A + (size_t)rt * 256 * 1024 * this->eb; u.b = B + ((size_t)cls * 1024 + ct * 256) * (size_t)(1024 * this->eb); }
        u.a = uni_ptr(u.a); u.b = uni_ptr(u.b); u.rows = (const int*)uni_ptr((const char*)u.rows);
        u.pm = __builtin_amdgcn_readfirstlane(u.pm); u.pn = __builtin_amdgcn_readfirstlane(u.pn); u.cls = __builtin_amdgcn_readfirstlane(u.cls); u.slot0 = __builtin_amdgcn_readfirstlane(u.slot0); u.nvalid = __builtin_amdgcn_readfirstlane(u.nvalid);
        return true;
    }
};

__global__ void __launch_bounds__(NTHREADS, 2) hyb_fwd(Args args) {
    extern __shared__ __attribute__((aligned(16))) unsigned char lds[];
    Frame F;
    F.lds = (LAS unsigned char*)lds; F.MISC = (volatile LAS unsigned*)(F.lds + MISC_OFF);
    F.tid = threadIdx.x; F.lane = F.tid & 63; F.wave = __builtin_amdgcn_readfirstlane(F.tid >> 6); F.G = gridDim.x; F.bx = blockIdx.x;
    F.ws = args.ws; F.ctl = (unsigned*)(args.ws + WS_CTL); F.out = args.out;
    for (int u = F.tid; u < (PTAB_OFF - LDSCTL_OFF) / 4; u += NTHREADS) ((LAS unsigned*)(F.lds + LDSCTL_OFF))[u] = 0u;
    if (F.tid == 0) {
#pragma unroll
        for (int i = 0; i < 26; ++i) ((LAS unsigned long long*)(F.lds + PTAB_OFF))[i] = (unsigned long long)args.in[i]; }
    __syncthreads();
    XcdBarrier bar; bar.bar = F.ctl + CW_BAR; bar.x = 0; bar.st = nullptr;
    const bool one_launch = (args.ph_hi - args.ph_lo) > 1;
    if (one_launch) bar = xcd_barrier_post(F.ctl + CW_BAR, F.MISC + 8);
    const int wave0 = __builtin_amdgcn_readfirstlane((int)threadIdx.x >> 6);
    for (int ph = args.ph_lo; ph < args.ph_hi; ++ph) {
        {
          GAS unsigned char* w_ = (GAS unsigned char*)args.ws; asm volatile("" : "+s"(w_)); F.ws = (unsigned char*)w_; F.ctl = (unsigned*)(F.ws + WS_CTL);
          GAS float* o_ = (GAS float*)args.out; asm volatile("" : "+s"(o_)); F.out = (float*)o_;
          unsigned lb_ = 0; asm volatile("" : "+s"(lb_)); F.lds = (LAS unsigned char*)lds + lb_; F.MISC = (volatile LAS unsigned*)(F.lds + MISC_OFF);
          int g_ = gridDim.x, b_ = blockIdx.x; asm volatile("" : "+s"(g_), "+s"(b_)); F.G = g_; F.bx = b_; }
        unsigned char* ws = F.ws;
        bf16* xb = (bf16*)(ws + WS_XB); float* ssq = (float*)(ws + WS_SSQ);
        const int l = ph / PH_PER_LAYER, p = ph % PH_PER_LAYER;
#define PH_BEGIN() do { int wv_ = wave0; unsigned z_ = 0u; asm volatile("" : "+s"(wv_), "+s"(z_)); F.lane = (int)__builtin_amdgcn_mbcnt_hi(~0u, __builtin_amdgcn_mbcnt_lo(~0u, z_)); F.wave = wv_; F.tid = wv_ * 64 + F.lane; } while (0)
        if (ph == PH_FINAL) {
            PH_BEGIN();
            const float* g = F.in_(25); const int gw = F.bx * NWAVES + F.wave, NGW = F.G * NWAVES;
            for (int m = gw; m < NTOK; m += NGW) { const u32x4* xr = (const u32x4*)(xb + (size_t)m * D) + F.lane; float v[16]; float s_ = 0.f;
#pragma unroll
                for (int j = 0; j < 2; ++j) { const u32x4 q_ = xr[64 * j]; v[8 * j] = bflo(q_.x); v[8 * j + 1] = bfhi(q_.x); v[8 * j + 2] = bflo(q_.y); v[8 * j + 3] = bfhi(q_.y); v[8 * j + 4] = bflo(q_.z); v[8 * j + 5] = bfhi(q_.z); v[8 * j + 6] = bflo(q_.w); v[8 * j + 7] = bfhi(q_.w); }
#pragma unroll
                for (int e = 0; e < 16; ++e) s_ += v[e] * v[e];
                const float r = rsqrtf(wave_sum(s_) * (1.0f / D) + EPS);
#pragma unroll
                for (int j = 0; j < 2; ++j) { const f32x4 g0 = ((const f32x4*)g)[128 * j + 2 * F.lane], g1 = ((const f32x4*)g)[128 * j + 2 * F.lane + 1]; f32x4* op = (f32x4*)(F.out + (size_t)m * D) + 128 * j + 2 * F.lane;
                    op[0] = (f32x4){v[8 * j] * r * g0[0], v[8 * j + 1] * r * g0[1], v[8 * j + 2] * r * g0[2], v[8 * j + 3] * r * g0[3]}; op[1] = (f32x4){v[8 * j + 4] * r * g1[0], v[8 * j + 5] * r * g1[1], v[8 * j + 6] * r * g1[2], v[8 * j + 7] * r * g1[3]}; } }
        } else if (p == 0) {
            PH_BEGIN(); phase_convert(F, l);
        } else if (p == 1) {
            PH_BEGIN();
            if (l > 0) phase_gates(F);
            { pg8::SchedInKv S; S.A = (const char*)xb; S.B = (const char*)(ws + WS_WIN); S.A2 = (const char*)(ws + WS_MEMB); S.B2 = (const char*)(ws + WS_WMKV); S.G = F.G; S.c = F.bx; S.tstep = (size_t)256 * D * 2;
              S.ncol = l > 0 ? 14 : 15; S.nkv = l > 0 ? 0 : 128;
              pg8::EpiScaleBf16 E{(bf16*)(ws + WS_PROJ), NPROJ, ssq, nullptr, (float*)(ws + WS_GATES), 14, (bf16*)(ws + WS_KV), 2048, (const float*)(ws + WS_MEMR)};
              pg8::gemm_phase<pg8::EpiScaleBf16, pg8::SchedInKv, false>(F.lds, F.tid, D, S, E); }
        } else if (p == 2) {
            PH_BEGIN(); phase_mixer(F, l, l, args.mode);
        } else if (p == 3) {
            PH_BEGIN(); phase_ml_scan(F);
        } else if (p == 4) {
            PH_BEGIN();
            X3Pf pf; x3_load(F, F.bx, pf);
            for (int it = F.bx; it < 1024; it += F.G) { Frame G = F;
                { int t_ = F.wave * 64 + pg8::lane_fresh(); G.tid = t_; G.lane = t_ & 63; G.wave = __builtin_amdgcn_readfirstlane(t_ >> 6);
                  unsigned lb_ = 0; asm volatile("" : "+s"(lb_)); G.lds = F.lds + lb_;
                  GAS unsigned char* w_ = (GAS unsigned char*)F.ws; asm volatile("" : "+s"(w_)); G.ws = (unsigned char*)w_; }
                ml_x3(G, l, it, pf, (it + F.G < 1024) ? it + F.G : -1); }
        } else if (p == 5 || p == 8) {
            PH_BEGIN();
            if (p == 8 && F8_MO) { pg8::SchedDense S; S.init(ws + WS_O, ws + WS_WMO, NTOK, D, D / 2, F.G, F.bx);
                pg8::EpiRes<false, true> E{xb, ssq, args.mode == 2};
                pg8::gemm_phase<pg8::EpiRes<false, true>, pg8::SchedDense, false, true>(F.lds, F.tid, D / 2, S, E); }
            else { pg8::SchedDense S; S.init(p == 5 ? ws + WS_Y : ws + WS_O, p == 5 ? ws + WS_WOUT : ws + WS_WMO, NTOK, D, D, F.G, F.bx);
                pg8::EpiRes<false> E{xb, ssq, args.mode == 2, (p == 5 && F8_Q) ? ws + WS_XQ8 : nullptr};
                pg8::gemm_phase<pg8::EpiRes<false>, pg8::SchedDense, false>(F.lds, F.tid, D, S, E); }
        } else if (p == 6) {
            PH_BEGIN();
            if (F8_Q) { pg8::SchedDense S; S.init(ws + WS_XQ8, ws + WS_WMQ, NTOK, D, D / 2, F.G, F.bx);
                pg8::EpiScaleBf16 E{(bf16*)(ws + WS_Q), D, ssq, nullptr, nullptr, 1 << 30, nullptr, 0, nullptr, 1.0f / F8_WSCALE};
                pg8::gemm_phase<pg8::EpiScaleBf16, pg8::SchedDense, false, true>(F.lds, F.tid, D / 2, S, E); }
            else { pg8::SchedDense S; S.init(xb, ws + WS_WMQ, NTOK, D, D, F.G, F.bx);
                pg8::EpiScaleBf16 E{(bf16*)(ws + WS_Q), D, ssq, nullptr, nullptr, 1 << 30, nullptr, 0, nullptr};
                pg8::gemm_phase<pg8::EpiScaleBf16, pg8::SchedDense, false>(F.lds, F.tid, D, S, E); }
        } else if (p == 7) {
            PH_BEGIN(); phase_xattn2(F);
        } else if (p == 9) {
            PH_BEGIN(); phase_router1(F, l);
        } else if (p == 10) {
            PH_BEGIN(); phase_router2(F, l);
        } else {
            PH_BEGIN();
            LAS int* tb = (LAS int*)(F.lds + SCR_OFF); const unsigned* cnt = F.ctl + CW_CNT + l * 32;
            __syncthreads();
            if (F.tid == 0) { int acc = 0; for (int k = 0; k < NCLS; ++k) { tb[k] = acc; acc += ((int)__hip_atomic_load(cnt + k, RLX_AGENT) + 255) >> 8; } tb[NCLS] = acc; }
            __syncthreads();
            SchedMoe S; S.tb = tb; S.cnt = cnt; S.tokl = (const int*)(ws + WS_SLOT); S.G = F.G; S.c = F.bx; S.up = (p == 11);
            const bool f8 = layer_f8(l); S.eb = f8 ? 1 : 2;
            if (p == 11) { S.ncol = 8; S.nwg = tb[NCLS] * 8; S.A = f8 ? (const char*)(ws + WS_XQ8) : (const char*)xb; S.B = (const char*)(ws + WS_W13);
                if (f8) { pg8::EpiMoe1<true> E{(bf16*)(ws + WS_HID), (const float*)(ws + WS_SLOT + 3 * SLOT_ARR), (const float*)(ws + WS_SLOT + SLOT_ARR), (const float*)(ws + WS_SLOT + 2 * SLOT_ARR)};
                    pg8::gemm_phase<pg8::EpiMoe1<true>, SchedMoe, true, true>(F.lds, F.tid, D / 2, S, E); }
                else { pg8::EpiMoe1<false> E{(bf16*)(ws + WS_HID), (const float*)(ws + WS_SLOT + 3 * SLOT_ARR), (const float*)(ws + WS_SLOT + SLOT_ARR), (const float*)(ws + WS_SLOT + 2 * SLOT_ARR)};
                    pg8::gemm_phase<pg8::EpiMoe1<false>, SchedMoe, true, false>(F.lds, F.tid, D, S, E); } }
            else { S.ncol = 4; S.nwg = tb[NCLS] * 4; S.A = (const char*)(ws + WS_HID); S.B = (const char*)(ws + WS_W2C);
                if (f8) { pg8::EpiRes<true, true> E{xb, ssq, args.mode == 2}; pg8::gemm_phase<pg8::EpiRes<true, true>, SchedMoe, false, true>(F.lds, F.tid, 512, S, E); }
                else { pg8::EpiRes<true, false> E{xb, ssq, args.mode == 2}; pg8::gemm_phase<pg8::EpiRes<true, false>, SchedMoe, false, false>(F.lds, F.tid, 1024, S, E); }
                if (l + 1 < DEPTH) {
                    pg8::SchedKv K; K.A2 = (const char*)(ws + WS_MEMB8); K.B2 = (const char*)(ws + (((l + 1) & 1) ? WS_WMKV2 : WS_WMKV)); K.G = F.G; K.c = F.bx; K.tstep = (size_t)256 * D;
                    pg8::EpiScaleBf16 EK{nullptr, 0, ssq, nullptr, nullptr, 14, (bf16*)(ws + WS_KV), 2048, (const float*)(ws + WS_MEMR), 1.0f / F8_WSCALE};
                    int t2 = F.tid; asm volatile("" : "+v"(t2));
                    pg8::gemm_phase<pg8::EpiScaleBf16, pg8::SchedKv, false, true>(F.lds, t2, D / 2, K, EK); } }
            __syncthreads();
        }
        if (ph + 1 < args.ph_hi) xcd_barrier(bar);
    }
}

extern "C" void kernel_launch(void* const* d_in, const int* in_sizes, int n_in, void* d_out, int out_size, void* d_ws, size_t ws_size, hipStream_t stream) {
    static int grid = 0;
    if (grid == 0) {
        if (n_in != 26 || in_sizes[0] != NTOK * D || out_size != NTOK * D || ws_size < WS_END) { fprintf(stderr, "kernel_launch: unexpected shapes (n_in %d, in0 %d, out %d, ws %zu, need %zu); nothing launched\n", n_in, n_in > 0 ? in_sizes[0] : -1, out_size, ws_size, (size_t)WS_END); grid = -1; return; }
        int dev = 0, cus = 0;
        if (hipGetDevice(&dev) != hipSuccess || hipDeviceGetAttribute(&cus, hipDeviceAttributeMultiprocessorCount, dev) != hipSuccess) { grid = -1; return; }
        if (hipFuncSetAttribute((const void*)hyb_fwd, hipFuncAttributeMaxDynamicSharedMemorySize, LDS_BYTES) != hipSuccess) { fprintf(stderr, "kernel_launch: hipFuncSetAttribute failed\n"); grid = -1; return; }
        int per_cu = 0;
        if (hipOccupancyMaxActiveBlocksPerMultiprocessor(&per_cu, (const void*)hyb_fwd, NTHREADS, LDS_BYTES) != hipSuccess || per_cu < 1) fprintf(stderr, "kernel_launch: occupancy query reports %d\n", per_cu);
        (void)hipGetLastError();
        grid = cus >= 256 ? 256 : (cus >= 128 ? 128 : 64);
    }
    if (grid < 0) return;
    (void)hipMemsetAsync((char*)d_ws + WS_CTL, 0, CTL_ZERO_BYTES, stream);
    Args a{};
    for (int i = 0; i < 26; ++i) a.in[i] = (const float*)d_in[i];
    a.out = (float*)d_out; a.ws = (unsigned char*)d_ws;
#if MK_N_LAUNCHES == 1
    a.ph_lo = 0; a.ph_hi = N_PHASES;
    hipLaunchKernelGGL(hyb_fwd, dim3(grid), dim3(NTHREADS), LDS_BYTES, stream, a);
#else
    for (int ph = 0; ph < N_PHASES; ++ph) {
        a.ph_lo = ph; a.ph_hi = ph + 1; hipLaunchKernelGGL(hyb_fwd, dim3(grid), dim3(NTHREADS), LDS_BYTES, stream, a);
        if (MK_REPEAT_P >= 0 && ph != PH_FINAL && ph % PH_PER_LAYER == MK_REPEAT_P) {
            if (MK_REPEAT_P == 2) (void)hipMemsetD32Async((hipDeviceptr_t)((char*)d_ws + WS_CTL + (CW_Q + ph / PH_PER_LAYER) * 4), MK_PROBE_QSTART, 1, stream);
            a.mode = MK_PROBE_MODE; hipLaunchKernelGGL(hyb_fwd, dim3(grid), dim3(NTHREADS), LDS_BYTES, stream, a); a.mode = 0; } }
#endif
}
```

```cpp
#include <hip/hip_runtime.h>
#include <cstdio>
#include <cstdint>

#ifndef MK_N_LAUNCHES
#define MK_N_LAUNCHES 1
#endif

#ifndef MK_PROBE_QSTART
#define MK_PROBE_QSTART 0
#endif
#ifndef MK_PROBE_MODE
#define MK_PROBE_MODE 0
#endif
#ifndef MK_REPEAT_P
#define MK_REPEAT_P (-1)
#endif
#define LAS __attribute__((address_space(3)))
#define GAS __attribute__((address_space(1)))
typedef unsigned short bf16;
typedef short bf16x8 __attribute__((ext_vector_type(8)));
typedef float f32x4 __attribute__((ext_vector_type(4)));
typedef float f32x2 __attribute__((ext_vector_type(2)));
typedef unsigned u32x4 __attribute__((ext_vector_type(4)));
typedef unsigned u32x2 __attribute__((ext_vector_type(2)));

constexpr int D = 1024, BATCH = 16, SEQ = 2048, DEPTH = 4, NTOK = BATCH * SEQ, MEML = 256, NMEM = BATCH * MEML;
constexpr int MLH = 4, DH = 128, MLW = 512, DIN = 3592, NPROJ = 3584, NINP = 3840;
constexpr int XAH = 4, XAD = 256, NG = 4, NE = 4, DEXP = 512, NCLS = 24, CLSCAP = NTOK;
constexpr float EPS = 1e-6f;
constexpr int NWAVES = 8, NTHREADS = 512;
constexpr int PH_PER_LAYER = 13, PH_FINAL = DEPTH * PH_PER_LAYER, N_PHASES = PH_FINAL + 1;

constexpr size_t MiB = 1u << 20;
constexpr size_t WS_CTL = 0, CTL_ZERO_BYTES = 64 * 1024;
constexpr size_t WS_WR = 1 * MiB;
constexpr size_t WS_WIN = 2 * MiB;
constexpr size_t WS_WOUT = WS_WIN + (size_t)NINP * D * 2;
constexpr size_t WS_WMQ = WS_WOUT + 2 * MiB;
constexpr size_t WS_WMKV = WS_WMQ + 2 * MiB;
constexpr size_t WS_WMO = WS_WMKV + 4 * MiB;
constexpr size_t WS_W13 = WS_WMO + 2 * MiB;
constexpr size_t WS_W2C = WS_W13 + 32 * MiB;
constexpr size_t WS_XB = WS_W2C + 48 * MiB;
constexpr size_t WS_SSQ = WS_XB + 64 * MiB;
constexpr size_t WS_MEMB = WS_SSQ + 2 * MiB;
constexpr size_t WS_MEMR = WS_MEMB + 8 * MiB;
constexpr size_t WS_TOKINFO = WS_MEMR + 64 * 1024, WS_CNTB = WS_MEMR + 640 * 1024;
constexpr size_t WS_KV = WS_MEMR + 1 * MiB;
constexpr size_t WS_GATES = WS_KV + 16 * MiB;
constexpr size_t WS_Y = WS_GATES + 1 * MiB;
constexpr size_t WS_SLOT = WS_Y + 64 * MiB;
constexpr size_t SLOT_ARR = (size_t)NCLS * CLSCAP * 4;
constexpr size_t WS_PROJ = WS_SLOT + 4 * SLOT_ARR;
constexpr size_t WS_Q = WS_PROJ, WS_O = WS_PROJ + 64 * MiB, WS_HID = WS_PROJ + 128 * MiB;
constexpr size_t WS_QCV = WS_PROJ + (size_t)NTOK * NPROJ * 2;
constexpr size_t WS_KCV = WS_QCV + 32 * MiB, WS_DC = WS_KCV + 32 * MiB, WS_CPREV = WS_DC + 32 * MiB, WS_GBUF = WS_CPREV + 32 * MiB;
constexpr size_t WS_DN = WS_GBUF + 2 * MiB, WS_NPREV = WS_DN + 512 * 1024, WS_SCAL = WS_NPREV + 512 * 1024;
constexpr size_t WS_END = WS_SCAL + 64 * 1024;
constexpr size_t WS_WMKV2 = WS_W13 + 16 * MiB;
constexpr size_t WS_MEMB8 = WS_WMKV2 + 4 * MiB;
constexpr size_t WS_XQ8 = WS_QCV;
static_assert(WS_HID + (size_t)(128 + NCLS) * 256 * 1024 * 2 <= WS_END, "hidden overlay fits in proj");
constexpr int CW_TMO = 0, CW_CODE = 1, CW_BAR = 4096, CW_CNT = 8192, CW_Q = 8192 + 256;

constexpr int LDS_BYTES = 163840;
constexpr int RING_BYTES = 131072, SCR_OFF = RING_BYTES, LDSCTL_OFF = LDS_BYTES - 1024, MISC_OFF = LDSCTL_OFF + 320, PTAB_OFF = LDSCTL_OFF + 512;

#define RLX_AGENT __ATOMIC_RELAXED, __HIP_MEMORY_SCOPE_AGENT
typedef _Float16 f16x2 __attribute__((ext_vector_type(2)));
typedef _Float16 f16x8 __attribute__((ext_vector_type(8)));
__device__ __forceinline__ unsigned f2bf(float f) { return (unsigned)__builtin_bit_cast(unsigned short, (_Float16)f); }
__device__ __forceinline__ unsigned pk2(float lo, float hi) { const f32x2 v = {lo, hi}; return __builtin_bit_cast(unsigned, __builtin_convertvector(v, f16x2)); }
__device__ __forceinline__ float bf2f(unsigned short b) { return (float)__builtin_bit_cast(_Float16, b); }
__device__ __forceinline__ float bflo(unsigned w) { return (float)__builtin_bit_cast(_Float16, (unsigned short)(w & 0xffffu)); }
__device__ __forceinline__ float bfhi(unsigned w) { return (float)__builtin_bit_cast(_Float16, (unsigned short)(w >> 16)); }
#define DPPF(old_, src_, ctrl_, rm_) __builtin_bit_cast(float, __builtin_amdgcn_update_dpp(__builtin_bit_cast(int, (float)(old_)), __builtin_bit_cast(int, (float)(src_)), (ctrl_), (rm_), 0xF, false))
__device__ __forceinline__ float wave_sum(float v) {
    v += DPPF(0.f, v, 0xB1, 0xF); v += DPPF(0.f, v, 0x4E, 0xF); v += DPPF(0.f, v, 0x141, 0xF); v += DPPF(0.f, v, 0x140, 0xF);
    v += DPPF(0.f, v, 0x142, 0xA); v += DPPF(0.f, v, 0x143, 0xC);
    return __builtin_bit_cast(float, __builtin_amdgcn_readlane(__builtin_bit_cast(int, v), 63));
}
__device__ __forceinline__ float wave_max(float v) {
    v = fmaxf(v, DPPF(v, v, 0xB1, 0xF)); v = fmaxf(v, DPPF(v, v, 0x4E, 0xF)); v = fmaxf(v, DPPF(v, v, 0x141, 0xF)); v = fmaxf(v, DPPF(v, v, 0x140, 0xF));
    v = fmaxf(v, DPPF(v, v, 0x142, 0xA)); v = fmaxf(v, DPPF(v, v, 0x143, 0xC));
    return __builtin_bit_cast(float, __builtin_amdgcn_readlane(__builtin_bit_cast(int, v), 63));
}
__device__ __forceinline__ float xor16_sum(float x) { auto s = __builtin_amdgcn_permlane16_swap(__float_as_uint(x), __float_as_uint(x), false, false); return __uint_as_float(s[0]) + __uint_as_float(s[1]); }
__device__ __forceinline__ float xor32_sum(float x) { auto t = __builtin_amdgcn_permlane32_swap(__float_as_uint(x), __float_as_uint(x), false, false); return __uint_as_float(t[0]) + __uint_as_float(t[1]); }
__device__ __forceinline__ float bperm(int srclane, float v) { return __builtin_bit_cast(float, __builtin_amdgcn_ds_bpermute(srclane << 2, __builtin_bit_cast(int, v))); }
__device__ __forceinline__ float softplusf(float z) { return fmaxf(z, 0.f) + 0.6931471805599453f * __builtin_amdgcn_logf(1.0f + __builtin_amdgcn_exp2f(-1.4426950408889634f * fabsf(z))); }
__device__ __forceinline__ float siluf(float a) { return a * __builtin_amdgcn_rcpf(1.f + __builtin_amdgcn_exp2f(-1.4426950408889634f * a)); }
__device__ __forceinline__ float sigmf(float a) { return __builtin_amdgcn_rcpf(1.f + __builtin_amdgcn_exp2f(-1.4426950408889634f * a)); }

namespace pg8 {
constexpr int BM = 256, BK = 64, HALF = 128, HTB = HALF * BK * 2, STAGE_BYTES = 8 * HTB, NXCD = 8, WGM = 8;
__host__ __device__ __forceinline__ int lds_byte(int r, int c) { const int st = (r >> 4) * 2 + (c >> 5), rr = r & 15, cc = c & 31, ob = rr * 64 + cc * 2; return st * 1024 + (ob ^ (((ob >> 9) & 1) << 5)); }
__host__ __device__ __forceinline__ void stage_rc(int b, int& R, int& C) { const int st = b / 1024, sb = b % 1024, swz = sb ^ (((sb >> 9) & 1) << 5); R = (st >> 1) * 16 + swz / 64; C = (st & 1) * 32 + (swz % 64) / 2; }
__host__ __device__ __forceinline__ int perm32(int rho) { const int n = rho >> 4, i = rho & 15; return 8 * (i >> 2) + 4 * n + (i & 3); }

struct Unit { int pm, pn; const char* a; const char* b; const int* rows; int nvalid; int cls; int slot0; };

__device__ __forceinline__ unsigned cvt_pk_bf16(float lo, float hi) { return pk2(lo, hi); }
__device__ __forceinline__ int lane_fresh() { int l; asm volatile("v_mbcnt_lo_u32_b32 %0, -1, 0\n\tv_mbcnt_hi_u32_b32 %0, -1, %0" : "=v"(l)); return l; }
#ifndef FP8_FROM
#define FP8_FROM 0
#endif
#ifndef F8_MO
#define F8_MO 1
#endif
#ifndef F8_Q
#define F8_Q 1
#endif
static_assert(FP8_FROM == 0, "WS_WMKV2 lives in the half of WS_W13 that only the fp8 expert weights leave free");
constexpr float F8_WSCALE = 64.0f, F8_HSCALE = 16.0f;
__device__ __forceinline__ float f8clamp(float x) { return __builtin_amdgcn_fmed3f(x, -448.0f, 448.0f); }
__device__ __forceinline__ unsigned f8x4(float a, float b, float c, float d) { int v = __builtin_amdgcn_cvt_pk_fp8_f32(f8clamp(a), f8clamp(b), 0, false); v = __builtin_amdgcn_cvt_pk_fp8_f32(f8clamp(c), f8clamp(d), v, true); return (unsigned)v; }
__device__ __forceinline__ bool layer_f8(int l) { return FP8_FROM <= 0 ? true : (FP8_FROM >= DEPTH ? false : l >= FP8_FROM); }

__device__ __forceinline__ int xcd_remap(int L, int nwg) { const int q = nwg / NXCD, r = nwg % NXCD, xcd = L % NXCD, off = L / NXCD; return (xcd < r ? xcd * (q + 1) : r * (q + 1) + (xcd - r) * q) + off; }

struct SchedInKv {
    const char* A; const char* B; const char* A2; const char* B2; int G, c; size_t tstep; int ncol, nkv;
    __device__ __forceinline__ bool next(int i, Unit& u) const {
        const int nin = 128 * ncol;
        const long L = (long)i * G + c; if (L >= nin + nkv) return false;
        u.rows = nullptr; u.nvalid = 256; u.slot0 = 0;
        if (L < nin) { const int wgid = xcd_remap((int)L, nin); const int nig = WGM * ncol, gid = wgid / nig, fm = gid * WGM;
            u.pm = fm + ((wgid % nig) % WGM); u.pn = (wgid % nig) / WGM; u.a = A + (size_t)u.pm * tstep; u.b = B + (size_t)u.pn * tstep; u.cls = 0; }
        else { const int id = (int)L - nin; u.pm = id >> 3; u.pn = id & 7; u.a = A2 + (size_t)u.pm * tstep; u.b = B2 + (size_t)u.pn * tstep; u.cls = 1; }
        return true;
    }
};
struct SchedKv {
    const char* A2; const char* B2; int G, c; size_t tstep;
    __device__ __forceinline__ bool next(int i, Unit& u) const {
        const long L = (long)i * G + (G - 1 - c); if (L >= 128) return false;
        const int id = (int)L; u.pm = id >> 3; u.pn = id & 7; u.a = A2 + (size_t)u.pm * tstep; u.b = B2 + (size_t)u.pn * tstep; u.cls = 1; u.rows = nullptr; u.nvalid = 256; u.slot0 = 0; return true;
    }
};
struct SchedDense {
    const char* A; const char* B; int nM, nN, nwg, G, c; size_t tstep;
    __device__ void init(const void* A_, const void* B_, int M, int N, int K, int G_, int c_) { A = (const char*)A_; B = (const char*)B_; nM = M / BM; nN = N / BM; nwg = nM * nN; G = G_; c = c_; tstep = (size_t)BM * K * 2; }
    __device__ __forceinline__ bool next(int i, Unit& u) const {
        const long L = (long)i * G + c; if (L >= nwg) return false;
        const int wgid = xcd_remap((int)L, nwg);
        const int nig = WGM * nN, gid = wgid / nig, fm = gid * WGM, gsz = (nM - fm) < WGM ? (nM - fm) : WGM;
        u.pm = fm + ((wgid % nig) % gsz); u.pn = (wgid % nig) / gsz;
        u.a = A + (size_t)u.pm * tstep; u.b = B + (size_t)u.pn * tstep; u.rows = nullptr; u.nvalid = 256; u.cls = 0; u.slot0 = 0; return true;
    }
};

typedef int v8i_t __attribute__((ext_vector_type(8)));
typedef int i32x4_t __attribute__((ext_vector_type(4)));
template <class Epi, class Sched, bool GATHER, bool F8 = false>
__device__ __forceinline__ void gemm_phase(LAS unsigned char* lds, const int tid, const int K, const Sched& S, const Epi& E) {
    const int wid = __builtin_amdgcn_readfirstlane(tid >> 6), lane = tid & 63, wr = wid >> 2, wc = wid & 3, fr = lane & 15, fq = lane >> 4;
    const int nt = K / BK;
    unsigned voffB[2], va[2][2];
#pragma unroll
    for (int i = 0; i < 2; ++i) { int R, C; stage_rc(tid * 16 + i * 8192, R, C); const int Rb = Epi::PERM ? ((R & ~31) + perm32(R & 31)) : R;
        voffB[i] = (unsigned)(Rb * K + C) * 2u; va[0][i] = (unsigned)(R * K + C) * 2u; va[1][i] = (unsigned)((R + HALF) * K + C) * 2u; }
    const size_t kstep = (size_t)(BK * 2);
    const size_t hstep = (size_t)HALF * K * 2;
    const unsigned ldsw = (unsigned)wid * 1024u;
    const int aoff = lds_byte(wr * 64 + fr, fq * 8), boff = lds_byte(wc * 32 + fr, fq * 8);
#define PG8_SA(b, h) (((b) * 2 + (h)) * HTB)
#define PG8_SB(b, h) ((4 + (b) * 2 + (h)) * HTB)
#define PG8_STAGEB(bufoff, gbase) do { if constexpr (F8) { const __amdgpu_buffer_rsrc_t _r = __builtin_amdgcn_make_buffer_rsrc((void*)(gbase), 0, 0x7fffffff, 0x00020000); _Pragma("unroll") for (int _i = 0; _i < 2; ++_i) \
        __builtin_amdgcn_raw_ptr_buffer_load_lds(_r, (LAS void*)(lds + (bufoff) + ldsw + _i * 8192), 16, (int)voffB[_i], 0, 0, 0); } else { _Pragma("unroll") for (int _i = 0; _i < 2; ++_i) \
        __builtin_amdgcn_global_load_lds((const unsigned*)((const char*)(gbase) + voffB[_i]), (LAS unsigned*)(lds + (bufoff) + ldsw + _i * 8192), 16, 0, 0); } } while (0)
#define PG8_STAGEA(bufoff, gbase, h) do { if constexpr (F8) { const __amdgpu_buffer_rsrc_t _r = __builtin_amdgcn_make_buffer_rsrc((void*)(gbase), 0, 0x7fffffff, 0x00020000); _Pragma("unroll") for (int _i = 0; _i < 2; ++_i) \
        __builtin_amdgcn_raw_ptr_buffer_load_lds(_r, (LAS void*)(lds + (bufoff) + ldsw + _i * 8192), 16, (int)va[h][_i], 0, 0, 0); } else { _Pragma("unroll") for (int _i = 0; _i < 2; ++_i) \
        __builtin_amdgcn_global_load_lds((const unsigned*)((const char*)(gbase) + va[h][_i]), (LAS unsigned*)(lds + (bufoff) + ldsw + _i * 8192), 16, 0, 0); } } while (0)
#define PG8_LDA(dst, b, h) do { _Pragma("unroll") for (int m = 0; m < 4; ++m) _Pragma("unroll") for (int k = 0; k < 2; ++k) dst[m][k] = *(const LAS bf16x8*)(lds + PG8_SA(b, h) + aoff + m * 2048 + k * 1024); } while (0)
#define PG8_LDB(dst, b, h) do { _Pragma("unroll") for (int n = 0; n < 2; ++n) _Pragma("unroll") for (int k = 0; k < 2; ++k) dst[n][k] = *(const LAS bf16x8*)(lds + PG8_SB(b, h) + boff + n * 2048 + k * 1024); } while (0)
#define PG8_MMA(ai, bj, At, Bt) do { __builtin_amdgcn_s_setprio(1); _Pragma("unroll") for (int m = 0; m < 4; ++m) _Pragma("unroll") for (int n = 0; n < 2; ++n) { \
        if constexpr (F8) { const v8i_t fb = __builtin_shufflevector(__builtin_bit_cast(i32x4_t, Bt[n][0]), __builtin_bit_cast(i32x4_t, Bt[n][1]), 0, 1, 2, 3, 4, 5, 6, 7), fa = __builtin_shufflevector(__builtin_bit_cast(i32x4_t, At[m][0]), __builtin_bit_cast(i32x4_t, At[m][1]), 0, 1, 2, 3, 4, 5, 6, 7); \
            acc[ai][bj][m][n] = __builtin_amdgcn_mfma_scale_f32_16x16x128_f8f6f4(fb, fa, acc[ai][bj][m][n], 0, 0, 0, 0x7f7f7f7f, 0, 0x7f7f7f7f); } \
        else { _Pragma("unroll") for (int k = 0; k < 2; ++k) acc[ai][bj][m][n] = __builtin_amdgcn_mfma_f32_16x16x32_f16(__builtin_bit_cast(f16x8, Bt[n][k]), __builtin_bit_cast(f16x8, At[m][k]), acc[ai][bj][m][n], 0, 0, 0); } } \
        __builtin_amdgcn_s_setprio(0); } while (0)
#define PG8_LDA8(dst, b, h, m0) do { _Pragma("unroll") for (int m = 0; m < 2; ++m) _Pragma("unroll") for (int k = 0; k < 2; ++k) dst[m][k] = *(const LAS bf16x8*)(lds + PG8_SA(b, h) + aoff + ((m0) + m) * 2048 + k * 1024); } while (0)
#define PG8_MMA8(ai, mm, Am, B0_, B1_) do { _Pragma("unroll") for (int bj = 0; bj < 2; ++bj) _Pragma("unroll") for (int n = 0; n < 2; ++n) { \
        const v8i_t fb = bj ? __builtin_shufflevector(__builtin_bit_cast(i32x4_t, B1_[n][0]), __builtin_bit_cast(i32x4_t, B1_[n][1]), 0, 1, 2, 3, 4, 5, 6, 7) : __builtin_shufflevector(__builtin_bit_cast(i32x4_t, B0_[n][0]), __builtin_bit_cast(i32x4_t, B0_[n][1]), 0, 1, 2, 3, 4, 5, 6, 7); \
        const v8i_t fa = __builtin_shufflevector(__builtin_bit_cast(i32x4_t, Am[0]), __builtin_bit_cast(i32x4_t, Am[1]), 0, 1, 2, 3, 4, 5, 6, 7); \
        acc[ai][bj][mm][n] = __builtin_amdgcn_mfma_scale_f32_16x16x128_f8f6f4(fb, fa, acc[ai][bj][mm][n], 0, 0, 0, 0x7f7f7f7f, 0, 0x7f7f7f7f); } } while (0)
#define PG8_PHASE8(ai, b, h) do { PG8_WAIT_L(0); PG8_BAR; __builtin_amdgcn_s_setprio(1); PG8_MMA8(ai, 0, At[0], B0, B1); PG8_SCHED; { _Pragma("unroll") for (int k = 0; k < 2; ++k) At[0][k] = *(const LAS bf16x8*)(lds + PG8_SA(b, h) + aoff + 2 * 2048 + k * 1024); } PG8_SCHED; \
        PG8_MMA8(ai, 1, At[1], B0, B1); PG8_SCHED; { _Pragma("unroll") for (int k = 0; k < 2; ++k) At[1][k] = *(const LAS bf16x8*)(lds + PG8_SA(b, h) + aoff + 3 * 2048 + k * 1024); } PG8_SCHED; \
        PG8_MMA8(ai, 2, At[0], B0, B1); PG8_MMA8(ai, 3, At[1], B0, B1); __builtin_amdgcn_s_setprio(0); PG8_WAIT_L(0); PG8_BAR; PG8_SCHED; } while (0)
#define PG8_WAIT_V(n) asm volatile("s_waitcnt vmcnt(" #n ")" ::: "memory")
#define PG8_WAIT_L(n) asm volatile("s_waitcnt lgkmcnt(" #n ")" ::: "memory")
#define PG8_BAR __builtin_amdgcn_s_barrier()
#define PG8_SCHED __builtin_amdgcn_sched_barrier(0)
#define PG8_LOADVA(u, dst) do { int _t = tid; asm volatile("" : "+v"(_t)); _Pragma("unroll") for (int _i = 0; _i < 2; ++_i) { int _R, _C; stage_rc(_t * 16 + _i * 8192, _R, _C); \
        _Pragma("unroll") for (int _h = 0; _h < 2; ++_h) { const int _s = _h * HALF + _R; \
        const int _r = (_s < (u).nvalid) ? (u).rows[_s] : 0; dst[_h][_i] = (unsigned)(_r * K + _C) * 2u; } } } while (0)
    Unit cur, nxt; int ui = 0;
    if (!S.next(0, cur)) return;
    f32x4 acc[2][2][4][2];
#pragma unroll
    for (int a = 0; a < 2; ++a)
#pragma unroll
        for (int b = 0; b < 2; ++b)
#pragma unroll
            for (int m = 0; m < 4; ++m)
#pragma unroll
                for (int n = 0; n < 2; ++n) acc[a][b][m][n] = (f32x4){0.f, 0.f, 0.f, 0.f};
    bf16x8 At[F8 ? 2 : 4][2], B0[2][2], B1[2][2];
    const char* cA = cur.a; const char* cB = cur.b;
    if constexpr (GATHER) { PG8_LOADVA(cur, va); }
    PG8_STAGEB(PG8_SB(0, 0), cB); PG8_STAGEB(PG8_SB(0, 1), cB + hstep); PG8_STAGEA(PG8_SA(0, 0), cA, 0); PG8_STAGEA(PG8_SA(0, 1), cA, 1);
    if (wr == 1) PG8_BAR;
    PG8_WAIT_V(2); PG8_BAR;
    PG8_STAGEB(PG8_SB(1, 0), cB + kstep); PG8_STAGEA(PG8_SA(1, 0), cA + kstep, 0); PG8_STAGEB(PG8_SB(1, 1), cB + hstep + kstep);
    PG8_WAIT_V(6); PG8_BAR;
    for (;;) {
        const bool has_next = S.next(ui + 1, nxt);
        const char* nA = has_next ? nxt.a : cA; const char* nB = has_next ? nxt.b : cB;
#pragma unroll 1
        for (int t = 0; t < nt; t += 2) {
            const bool last = (t == nt - 2);
            const char* a1 = cA + (size_t)(t + 1) * kstep;
            const char* a2 = last ? nA : cA + (size_t)(t + 2) * kstep; const char* b2 = last ? nB : cB + (size_t)(t + 2) * kstep;
            const char* a3 = a2 + kstep; const char* b3 = b2 + kstep;
            if constexpr (F8) {
            PG8_LDB(B0, 0, 0); PG8_LDB(B1, 0, 1); PG8_SCHED; PG8_LDA8(At, 0, 0, 0); PG8_STAGEA(PG8_SA(1, 1), a1, 1);
            if constexpr (GATHER) { if (last && has_next) { PG8_LOADVA(nxt, va); } }
            PG8_WAIT_V(8); PG8_PHASE8(0, 0, 0);
            PG8_LDA8(At, 0, 1, 0); PG8_STAGEB(PG8_SB(0, 0), b2); PG8_STAGEB(PG8_SB(0, 1), b2 + hstep); PG8_STAGEA(PG8_SA(0, 0), a2, 0);
            PG8_WAIT_V(8); PG8_PHASE8(1, 0, 1);
            PG8_LDB(B0, 1, 0); PG8_LDB(B1, 1, 1); PG8_SCHED; PG8_LDA8(At, 1, 0, 0); PG8_STAGEA(PG8_SA(0, 1), a2, 1);
            PG8_WAIT_V(8); PG8_PHASE8(0, 1, 0);
            PG8_LDA8(At, 1, 1, 0); PG8_STAGEB(PG8_SB(1, 0), b3); PG8_STAGEB(PG8_SB(1, 1), b3 + hstep); PG8_STAGEA(PG8_SA(1, 0), a3, 0);
            PG8_WAIT_V(8); PG8_PHASE8(1, 1, 1);
            } else {
            PG8_LDB(B0, 0, 0); PG8_LDB(B1, 0, 1); PG8_SCHED; PG8_LDA(At, 0, 0); PG8_STAGEA(PG8_SA(1, 1), a1, 1);
            if constexpr (GATHER) { if (last && has_next) { PG8_LOADVA(nxt, va); } }
            PG8_WAIT_V(8); PG8_WAIT_L(0); PG8_BAR; PG8_MMA(0, 0, At, B0); PG8_MMA(0, 1, At, B1); PG8_BAR; PG8_SCHED;
            PG8_LDA(At, 0, 1); PG8_STAGEB(PG8_SB(0, 0), b2); PG8_STAGEB(PG8_SB(0, 1), b2 + hstep); PG8_STAGEA(PG8_SA(0, 0), a2, 0);
            PG8_WAIT_V(8); PG8_WAIT_L(0); PG8_BAR; PG8_MMA(1, 0, At, B0); PG8_MMA(1, 1, At, B1); PG8_BAR; PG8_SCHED;
            PG8_LDB(B0, 1, 0); PG8_LDB(B1, 1, 1); PG8_SCHED; PG8_LDA(At, 1, 0); PG8_STAGEA(PG8_SA(0, 1), a2, 1);
            PG8_WAIT_V(8); PG8_WAIT_L(0); PG8_BAR; PG8_MMA(0, 0, At, B0); PG8_MMA(0, 1, At, B1); PG8_BAR; PG8_SCHED;
            PG8_LDA(At, 1, 1); PG8_STAGEB(PG8_SB(1, 0), b3); PG8_STAGEB(PG8_SB(1, 1), b3 + hstep); PG8_STAGEA(PG8_SA(1, 0), a3, 0);
            PG8_WAIT_V(8); PG8_WAIT_L(0); PG8_BAR; PG8_MMA(1, 0, At, B0); PG8_MMA(1, 1, At, B1); PG8_BAR; PG8_SCHED;
            }
        }
        if (wr == 0) PG8_BAR;
        { Unit ce = cur; ce.pm = __builtin_amdgcn_readfirstlane(cur.pm); ce.pn = __builtin_amdgcn_readfirstlane(cur.pn); ce.cls = __builtin_amdgcn_readfirstlane(cur.cls); ce.slot0 = __builtin_amdgcn_readfirstlane(cur.slot0); ce.nvalid = __builtin_amdgcn_readfirstlane(cur.nvalid);
          asm volatile("" : "+s"(ce.pm), "+s"(ce.pn), "+s"(ce.cls), "+s"(ce.slot0), "+s"(ce.nvalid));
          E(acc, ce, wr, wc, fr, fq); }
        if (!has_next) break;
#pragma unroll
        for (int a = 0; a < 2; ++a)
#pragma unroll
            for (int b = 0; b < 2; ++b)
#pragma unroll
                for (int m = 0; m < 4; ++m)
#pragma unroll
                    for (int n = 0; n < 2; ++n) acc[a][b][m][n] = (f32x4){0.f, 0.f, 0.f, 0.f};
        cur = nxt; cA = nA; cB = nB; ++ui;
        if (wr == 1) PG8_BAR;
    }
    PG8_WAIT_V(0);
    PG8_BAR;
#undef PG8_SA
#undef PG8_SB
#undef PG8_STAGEA
#undef PG8_STAGEB
#undef PG8_LDA
#undef PG8_LDB
#undef PG8_MMA
#undef PG8_WAIT_V
#undef PG8_LDA8
#undef PG8_MMA8
#undef PG8_PHASE8
#undef PG8_WAIT_L
#undef PG8_BAR
#undef PG8_SCHED
#undef PG8_LOADVA
}

__device__ __forceinline__ float rstd_from_ssq(const float* ssq, int row) {
    const f32x4* p = (const f32x4*)(ssq + (size_t)row * 16); const f32x4 a = p[0], b = p[1], c = p[2], d = p[3];
    const float s = ((a[0] + a[1]) + (a[2] + a[3])) + ((b[0] + b[1]) + (b[2] + b[3])) + ((c[0] + c[1]) + (c[2] + c[3])) + ((d[0] + d[1]) + (d[2] + d[3]));
    return rsqrtf(s * (1.0f / D) + EPS);
}
struct EpiScaleBf16 {
    static constexpr bool PERM = true;
    bf16* O; int ldc; const float* ssq; const float* rtab; float* gates; int gate_pn; bf16* O2; int ldc2; const float* rtab2;
    float osc = 1.0f;
    __device__ __forceinline__ void operator()(const f32x4 (&acc)[2][2][4][2], const Unit& u, int wr, int wc, int fr, int fq) const {
        { const int ln_ = lane_fresh(); fr = ln_ & 15; fq = ln_ >> 4; }
        const int row0 = u.pm * BM + wr * 64 + fr; const int col0 = u.pn * BM + wc * 32 + 8 * fq;
        if (u.cls == 1) {
#pragma unroll
            for (int ai = 0; ai < 2; ++ai)
#pragma unroll
                for (int m = 0; m < 4; ++m) { const int row = row0 + ai * HALF + m * 16; const float rs = rtab2[row] * osc; bf16* rowp = O2 + (size_t)row * ldc2 + col0;
#pragma unroll
                    for (int bj = 0; bj < 2; ++bj) { const f32x4 v0 = acc[ai][bj][m][0] * rs, v1 = acc[ai][bj][m][1] * rs; u32x4 w; w.x = cvt_pk_bf16(v0[0], v0[1]); w.y = cvt_pk_bf16(v0[2], v0[3]); w.z = cvt_pk_bf16(v1[0], v1[1]); w.w = cvt_pk_bf16(v1[2], v1[3]);
                        *(u32x4*)(rowp + bj * HALF) = w; } }
            return; }
#pragma unroll
        for (int ai = 0; ai < 2; ++ai)
#pragma unroll
            for (int m = 0; m < 4; ++m) { const int row = row0 + ai * HALF + m * 16; const float rs = (rtab ? rtab[row] : rstd_from_ssq(ssq, row)) * osc;
                if (u.pn < gate_pn) { bf16* rowp = O + (size_t)row * ldc + col0;
#pragma unroll
                    for (int bj = 0; bj < 2; ++bj) { const f32x4 v0 = acc[ai][bj][m][0] * rs, v1 = acc[ai][bj][m][1] * rs; u32x4 w; w.x = cvt_pk_bf16(v0[0], v0[1]); w.y = cvt_pk_bf16(v0[2], v0[3]); w.z = cvt_pk_bf16(v1[0], v1[1]); w.w = cvt_pk_bf16(v1[2], v1[3]);
                        *(u32x4*)(rowp + bj * HALF) = w; } }
                else if (wc == 0 && fq == 0) { *(f32x4*)(gates + (size_t)row * 8) = acc[ai][0][m][0] * rs; *(f32x4*)(gates + (size_t)row * 8 + 4) = acc[ai][0][m][1] * rs; } }
    }
};
template <bool SCATTER, bool F8 = false> struct EpiRes {
    static constexpr bool PERM = true;
    bf16* xb; float* ssq; int probe; unsigned char* x8 = nullptr;
    __device__ __forceinline__ void operator()(const f32x4 (&acc)[2][2][4][2], const Unit& u, int wr, int wc, int fr, int fq) const {
        { const int ln_ = lane_fresh(); fr = ln_ & 15; fq = ln_ >> 4; }
        const int col0 = u.pn * BM + wc * 32 + 8 * fq;
#pragma unroll
        for (int ai = 0; ai < 2; ++ai)
#pragma unroll
            for (int m = 0; m < 4; ++m) { const int lr = wr * 64 + fr + ai * HALF + m * 16; int row; bool ok = true;
                if constexpr (SCATTER) { ok = lr < u.nvalid; row = ok ? u.rows[lr] : 0; } else row = u.pm * BM + lr;
                float ss = 0.f; bf16* rowp = xb + (size_t)row * D + col0;
#pragma unroll
                for (int bj = 0; bj < 2; ++bj) { const u32x4 v = *(const u32x4*)(rowp + bj * HALF); constexpr float ASC = F8 ? 1.0f / (F8_WSCALE * F8_HSCALE) : 1.0f; const f32x4 a0 = acc[ai][bj][m][0] * ASC, a1 = acc[ai][bj][m][1] * ASC;
                    float o[8] = {bflo(v.x), bfhi(v.x), bflo(v.y), bfhi(v.y), bflo(v.z), bfhi(v.z), bflo(v.w), bfhi(v.w)};
                    if (!probe) { o[0] += a0[0]; o[1] += a0[1]; o[2] += a0[2]; o[3] += a0[3]; o[4] += a1[0]; o[5] += a1[1]; o[6] += a1[2]; o[7] += a1[3]; }
                    ss += (o[0] * o[0] + o[1] * o[1]) + (o[2] * o[2] + o[3] * o[3]) + (o[4] * o[4] + o[5] * o[5]) + (o[6] * o[6] + o[7] * o[7]);
                    u32x4 w; w.x = cvt_pk_bf16(o[0], o[1]); w.y = cvt_pk_bf16(o[2], o[3]); w.z = cvt_pk_bf16(o[4], o[5]); w.w = cvt_pk_bf16(o[6], o[7]);
                    if (ok) *(u32x4*)(rowp + bj * HALF) = w;
                    if constexpr (!SCATTER) { if (x8) { u32x2 w8; w8.x = f8x4(o[0], o[1], o[2], o[3]); w8.y = f8x4(o[4], o[5], o[6], o[7]); *(u32x2*)(x8 + (size_t)row * D + col0 + bj * HALF) = w8; } } }
                ss = xor16_sum(ss); ss = xor32_sum(ss);
                if (fq == 0 && ok) ssq[(size_t)row * 16 + u.pn * 4 + wc] = ss; }
    }
};
template <bool F8 = false> struct EpiMoe1 {
    static constexpr bool PERM = true;
    bf16* hid; const float* rs; const float* gwa; const float* gwb;
    __device__ __forceinline__ void operator()(const f32x4 (&acc)[2][2][4][2], const Unit& u, int wr, int wc, int fr, int fq) const {
        { const int ln_ = lane_fresh(); fr = ln_ & 15; fq = ln_ >> 4; }
        const float* gw = (u.pn < 4 ? gwa : gwb) + (size_t)u.cls * CLSCAP + u.slot0; const float* rsp = rs + (size_t)u.cls * CLSCAP + u.slot0;
        const int col0 = (u.pn >> 2) * 512 + (u.pn & 3) * 128 + wc * 32 + 8 * fq;
#pragma unroll
        for (int ai = 0; ai < 2; ++ai)
#pragma unroll
            for (int m = 0; m < 4; ++m) { const int lr = wr * 64 + fr + ai * HALF + m * 16; const float r = rsp[lr] * (F8 ? 1.0f / F8_WSCALE : 1.0f), ru = F8 ? r * F8_HSCALE : r, g = gw[lr]; float h[8];
#pragma unroll
                for (int n = 0; n < 2; ++n)
#pragma unroll
                    for (int j = 0; j < 4; ++j) { const float a = acc[ai][0][m][n][j] * r, uu = acc[ai][1][m][n][j] * ru; h[n * 4 + j] = siluf(a) * uu * g; }
                u32x4 w; w.x = cvt_pk_bf16(h[0], h[1]); w.y = cvt_pk_bf16(h[2], h[3]); w.z = cvt_pk_bf16(h[4], h[5]); w.w = cvt_pk_bf16(h[6], h[7]);
                if constexpr (F8) { u32x2 w8; w8.x = f8x4(h[0], h[1], h[2], h[3]); w8.y = f8x4(h[4], h[5], h[6], h[7]); *(u32x2*)((unsigned char*)hid + ((size_t)u.pm * BM + lr) * 1024 + col0) = w8; }
                else *(u32x4*)(hid + ((size_t)u.pm * BM + lr) * 1024 + col0) = w; }
    }
};
}
using pg8::f8x4; using pg8::layer_f8; using pg8::F8_WSCALE; using pg8::F8_HSCALE;

#define XB_TMO      128
#define XB_XCNT(j)  (256  + 64 * (j))
#define XB_XSUB(j)  (1280 + 64 * (j))
#define XB_XGEN(j)  (2304 + 64 * (j))
#define XB_TOP      3328
#define XB_TOPGEN   3392
#define XCD_BAR_WORDS 3456
#define XB_SPIN_CAP (1u << 20)
__device__ __forceinline__ unsigned xb_ld(unsigned* p)              { return __hip_atomic_load(p, __ATOMIC_RELAXED, __HIP_MEMORY_SCOPE_AGENT); }
__device__ __forceinline__ unsigned xb_add(unsigned* p, unsigned v) { return __hip_atomic_fetch_add(p, v, __ATOMIC_RELAXED, __HIP_MEMORY_SCOPE_AGENT); }
__device__ __forceinline__ unsigned xb_xcc_id() { return (unsigned)__builtin_amdgcn_s_getreg((3 << 11) | 20) & 0xFu; }
#define XB_SPIN(cond, bar) do { unsigned _sp = 0; while (cond) { __builtin_amdgcn_s_sleep(1); \
    if ((++_sp & 255u) == 0u) { if (xb_ld(&(bar)[XB_TMO])) break; if (_sp > XB_SPIN_CAP) { atomicAdd(&(bar)[XB_TMO], 1u); break; } } } } while (0)
struct XcdBarrier { unsigned* bar; unsigned x; volatile LAS unsigned* st; };
__device__ __forceinline__ XcdBarrier xcd_barrier_post(unsigned* bar, volatile LAS unsigned* st) {
    XcdBarrier b; b.bar = bar; b.x = xb_xcc_id(); b.st = st;
    if (threadIdx.x == 0) (void)xb_add(&bar[XB_XCNT(b.x)], 1u);
    return b;
}
__device__ __forceinline__ void xcd_barrier_complete(unsigned* bar, unsigned x, unsigned& nloc, unsigned& nx) {
    const unsigned G = gridDim.x * gridDim.y * gridDim.z;
    unsigned sum, cnt, mine, sp = 0u;
    for (;;) {
        sum = 0u; cnt = 0u; mine = 0u;
#pragma unroll 1
        for (unsigned j = 0; j < 16; ++j) { const unsigned c = xb_ld(&bar[XB_XCNT(j)]); sum += c; cnt += (c > 0u) ? 1u : 0u; mine = (j == x) ? c : mine; }
        if (sum == G) break;
        __builtin_amdgcn_s_sleep(1);
        if ((++sp & 255u) == 0u) { if (xb_ld(&bar[XB_TMO])) break; if (sp > XB_SPIN_CAP) { atomicAdd(&bar[XB_TMO], 1u); break; } }
    }
    nloc = mine > 0u ? mine : 1u; nx = cnt > 0u ? cnt : 1u;
}
__device__ __forceinline__ void xcd_barrier(const XcdBarrier& b) {
    asm volatile("s_waitcnt vmcnt(0)" ::: "memory");
    __syncthreads();
    if (threadIdx.x == 0) {
        unsigned* bar = b.bar; asm volatile("" : "+s"(bar));
        __builtin_amdgcn_s_waitcnt(0);
        unsigned nloc = b.st[0], nx = b.st[1];
        if (nloc == 0u) { xcd_barrier_complete(bar, b.x, nloc, nx); b.st[0] = nloc; b.st[1] = nx; }
        const unsigned old = xb_add(&bar[XB_XSUB(b.x)], 1u);
        const unsigned gen = old / nloc;
        if (old + 1u == (gen + 1u) * nloc) {
            __builtin_amdgcn_fence(__ATOMIC_RELEASE, "agent");
            asm volatile("s_waitcnt vmcnt(0)" ::: "memory");
            const unsigned og = xb_add(&bar[XB_TOP], 1u);
            const unsigned tg = og / nx;
            __builtin_amdgcn_fence(__ATOMIC_ACQUIRE, "agent");
            if (og + 1u != (tg + 1u) * nx) XB_SPIN(xb_ld(&bar[XB_TOP]) < (tg + 1u) * nx, bar);
            xb_add(&bar[XB_XGEN(b.x)], 1u);
            asm volatile("s_waitcnt vmcnt(0)" ::: "memory");
        } else {
            __builtin_amdgcn_fence(__ATOMIC_ACQUIRE, "agent");
            XB_SPIN(xb_ld(&bar[XB_XGEN(b.x)]) == gen, bar);
            asm volatile("s_waitcnt vmcnt(0)" ::: "memory");
        }
    }
    __syncthreads();
}

struct Args { const float* in[26]; float* out; unsigned char* ws; int ph_lo, ph_hi, mode, pad; };
struct Frame {
    LAS unsigned char* lds; volatile LAS unsigned* MISC; unsigned* ctl; unsigned char* ws;
    int tid, lane, wave, G, bx;
    float* out;
    __device__ __forceinline__ const float* in_(int i) const { const LAS unsigned* t = (const LAS unsigned*)(lds + PTAB_OFF); const unsigned lo = __builtin_amdgcn_readfirstlane(t[2 * i]), hi = __builtin_amdgcn_readfirstlane(t[2 * i + 1]); return (const float*)(const GAS float*)(((unsigned long long)hi << 32) | lo); }
};
#define LDS_WAIT() asm volatile("s_waitcnt lgkmcnt(0)" ::: "memory")

__device__ __forceinline__ void tr_item(const float* W, int ldw, int k0, int n0, int ncols, const float* g, float cs, bf16* dst0, bf16* dst1, bf16* dst2, int ldd, LAS float* scr, int lane) {
    const int nl = lane & 31;
#pragma unroll 8
    for (int i = 0; i < 32; ++i) { const int kk = 2 * i + (lane >> 5); float v = 0.f; if (nl < ncols) v = W[(size_t)(k0 + kk) * ldw + n0 + nl] * (g ? g[k0 + kk] * cs : cs); scr[kk * 33 + nl] = v; }
    LDS_WAIT(); asm volatile("" ::: "memory");
    const int c = lane & 7;
#pragma unroll
    for (int j = 0; j < 4; ++j) { const int n = (lane >> 3) + 8 * j; const LAS float* s = scr + (8 * c) * 33 + n;
        u32x4 o; o.x = pk2(s[0 * 33], s[1 * 33]); o.y = pk2(s[2 * 33], s[3 * 33]); o.z = pk2(s[4 * 33], s[5 * 33]); o.w = pk2(s[6 * 33], s[7 * 33]);
        if (n < ncols) { *(u32x4*)(dst0 + (size_t)n * ldd + 8 * c) = o; if (dst1) *(u32x4*)(dst1 + (size_t)n * ldd + 8 * c) = o; if (dst2) *(u32x4*)(dst2 + (size_t)n * ldd + 8 * c) = o; } }
    LDS_WAIT(); asm volatile("" ::: "memory");
}
__device__ __forceinline__ void tr_item64(const float* W, int ldw, int k0, int n0, const float* g, float cs, bf16* dst0, bf16* dst1, bf16* dst2, int ldd, LAS float* scr, int lane) {
    const int r4 = lane >> 4, c4 = (lane & 15) * 4;
#pragma unroll 4
    for (int i = 0; i < 16; ++i) { const int kk = 4 * i + r4; f32x4 v = __builtin_nontemporal_load((const f32x4*)(W + (size_t)(k0 + kk) * ldw + n0 + c4));   const float sc = g ? g[k0 + kk] * cs : cs; v = v * sc; *(LAS f32x4*)(scr + kk * 68 + c4) = v; }
    LDS_WAIT(); asm volatile("" ::: "memory");
    const int c = lane & 7;
#pragma unroll
    for (int j = 0; j < 8; ++j) { const int n = (lane >> 3) + 8 * j; const LAS float* s_ = scr + (8 * c) * 68 + n;
        u32x4 o; o.x = pk2(s_[0 * 68], s_[1 * 68]); o.y = pk2(s_[2 * 68], s_[3 * 68]); o.z = pk2(s_[4 * 68], s_[5 * 68]); o.w = pk2(s_[6 * 68], s_[7 * 68]);
        *(u32x4*)(dst0 + (size_t)n * ldd + 8 * c) = o; if (dst1) *(u32x4*)(dst1 + (size_t)n * ldd + 8 * c) = o; if (dst2) *(u32x4*)(dst2 + (size_t)n * ldd + 8 * c) = o; }
    LDS_WAIT(); asm volatile("" ::: "memory");
}
__device__ __forceinline__ void tr_item64_f8(const float* W, int ldw, int k0, int n0, const float* g, float cs, unsigned char* dst0, unsigned char* dst1, unsigned char* dst2, int ldd, LAS float* scr, int lane) {
    const int r4 = lane >> 4, c4 = (lane & 15) * 4;
#pragma unroll 4
    for (int i = 0; i < 16; ++i) { const int kk = 4 * i + r4; f32x4 v = __builtin_nontemporal_load((const f32x4*)(W + (size_t)(k0 + kk) * ldw + n0 + c4)); const float sc = g ? g[k0 + kk] * cs : cs; v = v * sc; *(LAS f32x4*)(scr + kk * 68 + c4) = v; }
    LDS_WAIT(); asm volatile("" ::: "memory");
    const int c = lane & 7;
#pragma unroll
    for (int j = 0; j < 8; ++j) { const int n = (lane >> 3) + 8 * j; const LAS float* s_ = scr + (8 * c) * 68 + n;
        u32x2 o; o.x = f8x4(s_[0 * 68], s_[1 * 68], s_[2 * 68], s_[3 * 68]); o.y = f8x4(s_[4 * 68], s_[5 * 68], s_[6 * 68], s_[7 * 68]);
        *(u32x2*)(dst0 + (size_t)n * ldd + 8 * c) = o; if (dst1) *(u32x2*)(dst1 + (size_t)n * ldd + 8 * c) = o; if (dst2) *(u32x2*)(dst2 + (size_t)n * ldd + 8 * c) = o; }
    LDS_WAIT(); asm volatile("" ::: "memory");
}
__device__ __forceinline__ int pair_index(int a, int b) { return a == 0 ? (b - 1) : (a == 1 ? (b + 1) : 5); }

__device__ __forceinline__ void phase_convert(Frame& F, int l) {
    LAS float* scr = (LAS float*)(F.lds + F.wave * (64 * 68 * 4));
    const int gw = F.bx * NWAVES + F.wave, NGW = F.G * NWAVES, lane = F.lane;
    unsigned char* ws = F.ws;
    bf16* Win = (bf16*)(ws + WS_WIN); bf16* Wout = (bf16*)(ws + WS_WOUT); bf16* Wmq = (bf16*)(ws + WS_WMQ); bf16* Wmkv = (bf16*)(ws + WS_WMKV); bf16* Wmo = (bf16*)(ws + WS_WMO);
    bf16* W13 = (bf16*)(ws + WS_W13); bf16* W2c = (bf16*)(ws + WS_W2C);
    const float* w_in = F.in_(3) + (size_t)l * D * DIN; const float* ln_mix = F.in_(2) + l * D;
    const float* w_out = F.in_(10) + (size_t)l * D * D;
    const float* ln_mem = F.in_(11) + l * D; const float* ln_memkv = F.in_(12) + l * D;
    const float* w_mq = F.in_(13) + (size_t)l * D * D; const float* w_mk = F.in_(14) + (size_t)l * D * D; const float* w_mv = F.in_(15) + (size_t)l * D * D; const float* w_mo = F.in_(16) + (size_t)l * D * D;
    const float* ln_ffn = F.in_(17) + l * D;
    const float* w_e1 = F.in_(22) + (size_t)l * 16 * D * DEXP; const float* w_e3 = F.in_(23) + (size_t)l * 16 * D * DEXP; const float* w_e2 = F.in_(24) + (size_t)l * 16 * DEXP * D;
    constexpr int I_SEG = 128;
    constexpr int I_IN = 7 * I_SEG, I_GATE = 16, I_SQ = 256, I_E13 = 32 * I_SEG, I_E2 = 16 * 128;
    const int kvp = (l == 0) ? 2 : (l + 1 < DEPTH ? 1 : 0); const int I_SQS = (3 + 2 * kvp) * I_SQ;
    const int NITEMS = I_IN + I_GATE + I_SQS + I_E13 + I_E2;
    for (int it = gw; it < NITEMS; it += NGW) {
        int r = it;
        if (r < I_IN) { const int seg = r / I_SEG, q = r % I_SEG, kb = q / 8, nb = q % 8;
            const int srcc = seg < 4 ? seg * 512 : 2056 + (seg - 4) * 512; const int dstr = seg * 512; const float cs = (seg == 4) ? (0.08838834764831845f * 1.4426950408889634f) : 1.0f;
            tr_item64(w_in, DIN, kb * 64, srcc + nb * 64, ln_mix, cs, Win + (size_t)(dstr + nb * 64) * D + kb * 64, nullptr, nullptr, D, scr, lane); continue; }
        r -= I_IN;
        if (r < I_GATE) { tr_item(w_in, DIN, r * 64, 2048, 8, ln_mix, 1.0f, Win + (size_t)NPROJ * D + r * 64, nullptr, nullptr, D, scr, lane); continue; }
        r -= I_GATE;
        if (r < I_SQS) { const int m5 = r / I_SQ, q = r % I_SQ, kb = q / 16, nb = q % 16;
            const int mat = m5 < 3 ? (m5 == 2 ? 4 : m5) : 2 + ((m5 - 3) & 1);
            const int lk = m5 < 3 ? l : ((l == 0) ? ((m5 - 3) >> 1) : l + 1);
            const float* W = mat == 0 ? w_out : mat == 1 ? w_mq : mat == 2 ? F.in_(14) + (size_t)lk * D * D : mat == 3 ? F.in_(15) + (size_t)lk * D * D : w_mo;
            const float* g = mat == 1 ? ln_mem : (mat == 2 || mat == 3) ? F.in_(12) + lk * D : nullptr;
            const float cs = (mat == 1) ? (0.0625f * 1.4426950408889634f) : 1.0f;
            bf16* Wkv = (lk & 1) ? (bf16*)(ws + WS_WMKV2) : Wmkv;
            bf16* dst = mat == 0 ? Wout : mat == 1 ? Wmq : mat == 2 ? Wkv : mat == 3 ? (Wkv + (size_t)1024 * D) : Wmo;
            if ((mat == 1 && F8_Q) || (mat == 4 && F8_MO) || ((mat == 2 || mat == 3) && lk > 0)) tr_item64_f8(W, D, kb * 64, nb * 64, g, cs * F8_WSCALE, (mat == 3 ? (unsigned char*)Wkv + (size_t)1024 * D : (unsigned char*)dst) + (size_t)(nb * 64) * D + kb * 64, nullptr, nullptr, D, scr, lane);
            else tr_item64(W, D, kb * 64, nb * 64, g, cs, dst + (size_t)(nb * 64) * D + kb * 64, nullptr, nullptr, D, scr, lane);
            continue; }
        r -= I_SQS;
        if (r < I_E13) { const int mat = r / I_SEG, q = r % I_SEG, kb = q / 8, nb = q % 8; const int ge = mat >> 1, which = mat & 1;
            const float* W = (which ? w_e3 : w_e1) + (size_t)ge * D * DEXP; const int c0 = nb * 64;
            bf16* dst = W13 + ((size_t)ge * 1024 + (c0 >> 7) * 256 + which * 128 + (c0 & 127)) * D + kb * 64;
            if (layer_f8(l)) tr_item64_f8(W, DEXP, kb * 64, c0, ln_ffn, F8_WSCALE, (unsigned char*)W13 + ((size_t)ge * 1024 + (c0 >> 7) * 256 + which * 128 + (c0 & 127)) * D + kb * 64, nullptr, nullptr, D, scr, lane);
            else tr_item64(W, DEXP, kb * 64, c0, ln_ffn, 1.0f, dst, nullptr, nullptr, D, scr, lane);
            continue; }
        r -= I_E13;
        { const int ge = r / 128, q = r % 128, kb = q / 16, nb = q % 16; const int g = ge >> 2, e = ge & 3;
            const float* W = w_e2 + (size_t)ge * DEXP * D; bf16* dd[3];
#pragma unroll
            for (int j = 0; j < 3; ++j) { const int o = (e + 1 + j) & 3; const int a = o < e ? o : e, b = o < e ? e : o; const int cls = g * 6 + pair_index(a, b); const int pos = (e == b) ? 1 : 0;
                dd[j] = W2c + ((size_t)cls * 1024 + nb * 64) * 1024 + pos * 512 + kb * 64; }
            if (layer_f8(l)) { unsigned char* d8[3];
#pragma unroll
                for (int j = 0; j < 3; ++j) d8[j] = (unsigned char*)W2c + (size_t)(dd[j] - W2c);
                tr_item64_f8(W, D, kb * 64, nb * 64, nullptr, F8_WSCALE, d8[0], d8[1], d8[2], 1024, scr, lane); }
            else tr_item64(W, D, kb * 64, nb * 64, nullptr, 1.0f, dd[0], dd[1], dd[2], 1024, scr, lane); }
    }
    { float* wr = (float*)(ws + WS_WR); const float* w_rg = F.in_(18) + (size_t)l * D * NG; const float* w_re = F.in_(20) + (size_t)l * D * 16;
      const float* b_rg = F.in_(19) + l * NG; const float* b_re = F.in_(21) + l * 16;
      const int gt = F.bx * NTHREADS + F.tid, NT = F.G * NTHREADS;
      for (int e = gt; e < 20 * D; e += NT) { const int j = e / D, k = e % D; wr[e] = ln_ffn[k] * (j < 4 ? w_rg[k * NG + j] : w_re[k * 16 + (j - 4)]); }
      if (gt < 20) wr[20 * D + gt] = gt < 4 ? b_rg[gt] : b_re[gt - 4]; }
    if (l == 0) {
        const float* x = F.in_(0); const float* mem = F.in_(1); bf16* xb = (bf16*)(ws + WS_XB); float* ssq = (float*)(ws + WS_SSQ); bf16* memb = (bf16*)(ws + WS_MEMB); float* memr = (float*)(ws + WS_MEMR);
        for (int m = gw; m < NTOK + NMEM; m += NGW) { const bool ism = m >= NTOK; const int row = ism ? m - NTOK : m;
            const f32x4* xr = (const f32x4*)((ism ? mem : x) + (size_t)row * D) + lane; unsigned long long* o8 = (unsigned long long*)((ism ? memb : xb) + (size_t)row * D) + lane;
            float s = 0.f;
#pragma unroll
            for (int j = 0; j < 4; ++j) { const f32x4 v = xr[64 * j]; s += (v[0] * v[0] + v[1] * v[1]) + (v[2] * v[2] + v[3] * v[3]); o8[64 * j] = (unsigned long long)pk2(v[0], v[1]) | ((unsigned long long)pk2(v[2], v[3]) << 32);
                if (ism) ((unsigned*)(ws + WS_MEMB8 + (size_t)row * D))[lane + 64 * j] = f8x4(v[0], v[1], v[2], v[3]); }
            s = wave_sum(s);
            if (ism) { if (lane == 0) memr[row] = rsqrtf(s * (1.0f / D) + EPS); }
            else if (lane < 16) ssq[(size_t)row * 16 + lane] = lane == 0 ? s : 0.f; }
    }
}

typedef float f32x16 __attribute__((ext_vector_type(16)));
typedef short s16x4 __attribute__((ext_vector_type(4)));
namespace sbat {
constexpr int KST = 272, VST = 320, KBUF = 64 * KST, VBUF = 64 * VST, STG = KBUF + VBUF, OST = 272;
__device__ __forceinline__ f16x8 cvt8(float a, float b, float c, float d, float e, float f, float g, float h) { u32x4 w; w.x = pk2(a, b); w.y = pk2(c, d); w.z = pk2(e, f); w.w = pk2(g, h); return __builtin_bit_cast(f16x8, w); }
typedef short v4i16_t __attribute__((ext_vector_type(4)));
__device__ __forceinline__ s16x4 vtr(const LAS unsigned char* p) { return __builtin_bit_cast(s16x4, __builtin_amdgcn_ds_read_tr16_b64_v4i16((LAS v4i16_t*)p)); }
#define SB_MFMA(a, b, c) __builtin_amdgcn_mfma_f32_32x32x16_f16((a), (b), (c), 0, 0, 0)
}
__device__ __forceinline__ void sb_unit(Frame& F, int l, const int bh, const int qb) {
    using namespace sbat;
    unsigned char* ws = F.ws; const bf16* proj = (const bf16*)(ws + WS_PROJ); bf16* y = (bf16*)(ws + WS_Y); const float* sg = F.in_(9) + l * 512;
    const int tid = F.tid, lane = F.lane, w = F.wave, t32 = lane & 31, hi = lane >> 5;
    LAS unsigned char* lds = F.lds;
    f16x8 tri0, tri1, ones;
#pragma unroll
    for (int j = 0; j < 8; ++j) { const int k0 = 8 * (j >> 2) + 4 * hi + (j & 3); tri0[j] = (k0 > t32) ? (_Float16)1.0f : (_Float16)0.0f; tri1[j] = (16 + k0 > t32) ? (_Float16)1.0f : (_Float16)0.0f; ones[j] = (_Float16)1.0f; }
    {
        const int b = bh >> 2, hh = bh & 3;
        const size_t tokb = (size_t)b * SEQ; const int q0 = qb * 256, t0w = q0 + 32 * w, tg = t0w + t32;
        f16x8 qf[8];
        { const bf16* qrow = proj + (tokb + tg) * NPROJ + 2048 + hh * 128 + 8 * hi;
#pragma unroll
          for (int kk = 0; kk < 8; ++kk) qf[kk] = *(const f16x8*)(qrow + 16 * kk); }
        f32x16 O[4]; f32x16 Rv;
#pragma unroll
        for (int r = 0; r < 16; ++r) { O[0][r] = 0.f; O[1][r] = 0.f; O[2][r] = 0.f; O[3][r] = 0.f; Rv[r] = 0.f; }
        const int njt = 4 * qb + 4;
        LAS float* rmaxL = (LAS float*)(lds + 2 * STG);
        const int rowL = tid >> 4, chunk = tid & 15;
        const bf16* kg = proj + (tokb + rowL) * NPROJ + 2560 + hh * 128 + chunk * 8; const bf16* vg = kg + 512;
        const int kdst = rowL * KST + chunk * 16, vdst = KBUF + rowL * VST + chunk * 16;
        u32x4 kr0, kr1, vr0, vr1;
        { const size_t o = (size_t)(64 * (njt - 1)) * NPROJ; kr0 = *(const u32x4*)(kg + o); kr1 = *(const u32x4*)(kg + o + 32 * NPROJ); vr0 = *(const u32x4*)(vg + o); vr1 = *(const u32x4*)(vg + o + 32 * NPROJ); }
        *(LAS u32x4*)(lds + kdst) = kr0; *(LAS u32x4*)(lds + kdst + 32 * KST) = kr1; *(LAS u32x4*)(lds + vdst) = vr0; *(LAS u32x4*)(lds + vdst + 32 * VST) = vr1;
        __syncthreads();
        int cur = 0;
        for (int jt = njt - 1; jt >= 0; --jt) {
            const bool act = (64 * jt <= t0w);
            const LAS unsigned char* Kb = lds + cur * STG; const LAS unsigned char* Vb = Kb + KBUF;
            f16x8 Af[2][2];
            if (act) {
                f32x16 p0, p1;
#pragma unroll
                for (int r = 0; r < 16; ++r) { p0[r] = 0.f; p1[r] = 0.f; }
#pragma unroll
                for (int kk = 0; kk < 8; ++kk) { const f16x8 k0 = *(const LAS f16x8*)(Kb + t32 * KST + 32 * kk + 16 * hi); const f16x8 k1 = *(const LAS f16x8*)(Kb + (t32 + 32) * KST + 32 * kk + 16 * hi);
                    p0 = SB_MFMA(k0, qf[kk], p0); p1 = SB_MFMA(k1, qf[kk], p1); }
                const bool diag = (64 * jt + 63 >= t0w);
                float L0[16], L1[16];
#pragma unroll
                for (int r = 0; r < 16; ++r) { const int sl = 64 * jt + (r & 3) + 8 * (r >> 2) + 4 * hi;
                    { const float z = fminf(p0[r], 115.f); const float lg = __builtin_amdgcn_logf(1.0f + __builtin_amdgcn_exp2f(z)); float Lv = -lg, lb = z - lg; if (diag && !(sl < tg)) { Lv = 0.f; lb = -1e30f; } L0[r] = Lv; p0[r] = lb; }
                    { const float z = fminf(p1[r], 115.f); const float lg = __builtin_amdgcn_logf(1.0f + __builtin_amdgcn_exp2f(z)); float Lv = -lg, lb = z - lg; if (diag && !(sl + 32 < tg)) { Lv = 0.f; lb = -1e30f; } L1[r] = Lv; p1[r] = lb; } }
                const f16x8 X0a = cvt8(L0[0], L0[1], L0[2], L0[3], L0[4], L0[5], L0[6], L0[7]), X0b = cvt8(L0[8], L0[9], L0[10], L0[11], L0[12], L0[13], L0[14], L0[15]);
                const f16x8 X1a = cvt8(L1[0], L1[1], L1[2], L1[3], L1[4], L1[5], L1[6], L1[7]), X1b = cvt8(L1[8], L1[9], L1[10], L1[11], L1[12], L1[13], L1[14], L1[15]);
                f32x16 Y1 = SB_MFMA(tri0, X1a, Rv); Y1 = SB_MFMA(tri1, X1b, Y1);
                f32x16 U = SB_MFMA(ones, X1a, Rv); U = SB_MFMA(ones, X1b, U);
                f32x16 Y0 = SB_MFMA(tri0, X0a, U); Y0 = SB_MFMA(tri1, X0b, Y0);
                Rv = SB_MFMA(ones, X0a, U); Rv = SB_MFMA(ones, X0b, Rv);
#pragma unroll
                for (int r = 0; r < 16; ++r) { p0[r] = __builtin_amdgcn_exp2f(p0[r] + Y0[r]); p1[r] = __builtin_amdgcn_exp2f(p1[r] + Y1[r]); }
                Af[0][0] = cvt8(p0[0], p0[1], p0[2], p0[3], p0[4], p0[5], p0[6], p0[7]); Af[0][1] = cvt8(p0[8], p0[9], p0[10], p0[11], p0[12], p0[13], p0[14], p0[15]);
                Af[1][0] = cvt8(p1[0], p1[1], p1[2], p1[3], p1[4], p1[5], p1[6], p1[7]); Af[1][1] = cvt8(p1[8], p1[9], p1[10], p1[11], p1[12], p1[13], p1[14], p1[15]);
            }
            if (jt > 0) { const size_t o = (size_t)(64 * (jt - 1)) * NPROJ; kr0 = *(const u32x4*)(kg + o); kr1 = *(const u32x4*)(kg + o + 32 * NPROJ); vr0 = *(const u32x4*)(vg + o); vr1 = *(const u32x4*)(vg + o + 32 * NPROJ); }
            if (act) {
                const int i16 = lane & 15, dhalf = (lane >> 4) & 1;
                const LAS unsigned char* va = Vb + (4 * hi + (i16 >> 2)) * VST + (dhalf * 16 + 4 * (i16 & 3)) * 2;
#pragma unroll
                for (int dblk = 0; dblk < 4; ++dblk)
#pragma unroll
                    for (int sb = 0; sb < 2; ++sb)
#pragma unroll
                        for (int sp = 0; sp < 2; ++sp) { const LAS unsigned char* pp = va + (32 * sb + 16 * sp) * VST + dblk * 64; const s16x4 lo = vtr(pp), h4 = vtr(pp + 8 * VST);
                            const bf16x8 vf = (bf16x8){lo[0], lo[1], lo[2], lo[3], h4[0], h4[1], h4[2], h4[3]};
                            O[dblk] = SB_MFMA(__builtin_bit_cast(f16x8, vf), Af[sb][sp], O[dblk]); }
            }
            if (jt > 0) { const int nb = (cur ^ 1) * STG; *(LAS u32x4*)(lds + nb + kdst) = kr0; *(LAS u32x4*)(lds + nb + kdst + 32 * KST) = kr1; *(LAS u32x4*)(lds + nb + vdst) = vr0; *(LAS u32x4*)(lds + nb + vdst + 32 * VST) = vr1; }
            { const float rw = wave_max(Rv[0]); if (lane == 0) rmaxL[(jt & 1) * 8 + w] = rw; }
            __syncthreads(); cur ^= 1;
            { const f32x4 ra = *(const LAS f32x4*)(rmaxL + (jt & 1) * 8), rb = *(const LAS f32x4*)(rmaxL + (jt & 1) * 8 + 4);
              const float rm = fmaxf(fmaxf(fmaxf(ra[0], ra[1]), fmaxf(ra[2], ra[3])), fmaxf(fmaxf(rb[0], rb[1]), fmaxf(rb[2], rb[3])));
              if (rm < -27.0f) break; }
        }
        { float ss = 0.f;
#pragma unroll
          for (int dblk = 0; dblk < 4; ++dblk)
#pragma unroll
              for (int r = 0; r < 16; ++r) ss += O[dblk][r] * O[dblk][r];
          ss = xor32_sum(ss); const float rr = rsqrtf(ss * (1.0f / 128) + EPS);
          LAS unsigned char* st = lds + w * (32 * OST);
#pragma unroll
          for (int dblk = 0; dblk < 4; ++dblk)
#pragma unroll
              for (int rq = 0; rq < 4; ++rq) { u32x2 v; v.x = pk2(O[dblk][4 * rq] * rr, O[dblk][4 * rq + 1] * rr); v.y = pk2(O[dblk][4 * rq + 2] * rr, O[dblk][4 * rq + 3] * rr);
                  *(LAS u32x2*)(st + t32 * OST + (dblk * 32 + 8 * rq + 4 * hi) * 2) = v; }
          LDS_WAIT();
          int le = lane; asm volatile("" : "+v"(le));
          const int ch = le & 15; const f32x4 g0 = *(const f32x4*)(sg + hh * 128 + ch * 8), g1 = *(const f32x4*)(sg + hh * 128 + ch * 8 + 4);
#pragma unroll
          for (int i = 0; i < 8; ++i) { const int row = i * 4 + (le >> 4); const u32x4 v = *(const LAS u32x4*)(st + row * OST + ch * 16); u32x4 o;
              o.x = pk2(bflo(v.x) * g0[0], bfhi(v.x) * g0[1]); o.y = pk2(bflo(v.y) * g0[2], bfhi(v.y) * g0[3]); o.z = pk2(bflo(v.z) * g1[0], bfhi(v.z) * g1[1]); o.w = pk2(bflo(v.w) * g1[2], bfhi(v.w) * g1[3]);
              *(u32x4*)(y + (tokb + t0w + row) * D + 512 + hh * 128 + ch * 8) = o; }
        }
        __syncthreads();
    }
}


namespace mls {
constexpr int ST = 272, KC = 0, VC = 128 * ST, CT = 2 * 128 * ST, QC = 3 * 128 * ST, GB = 4 * 128 * ST;
static_assert(GB + 2560 <= LDSCTL_OFF, "mLSTM LDS map");
#define ML_MFMA(a, b, c) __builtin_amdgcn_mfma_f32_16x16x32_f16((a), (b), (c), 0, 0, 0)
__device__ __forceinline__ f16x8 tr8(const LAS unsigned char* p, int second_off) { const s16x4 lo = sbat::vtr(p), h4 = sbat::vtr(p + second_off); const bf16x8 v = (bf16x8){lo[0], lo[1], lo[2], lo[3], h4[0], h4[1], h4[2], h4[3]}; return __builtin_bit_cast(f16x8, v); }
}
__device__ __forceinline__ void ml_x1(Frame& F, int l, const int item) {
    using namespace mls;
    unsigned char* ws = F.ws; const bf16* proj = (const bf16*)(ws + WS_PROJ); const float* gates = (const float*)(ws + WS_GATES);
    const int tid = F.tid, lane = F.lane, w = F.wave, l16 = lane & 15, g = lane >> 4; LAS unsigned char* lds = F.lds;
    const int chain = item >> 4, c = item & 15, b = chain >> 2, h = chain & 3;
    const float* convw = F.in_(4) + (size_t)l * 4 * 1024; const float* convb = F.in_(5) + l * 1024; const float ib = F.in_(6)[l * 4 + h], fb = F.in_(7)[l * 4 + h];
    bf16* qcv = (bf16*)(ws + WS_QCV) + (size_t)item * 16384; bf16* kcv = (bf16*)(ws + WS_KCV) + (size_t)item * 16384; bf16* dC = (bf16*)(ws + WS_DC) + (size_t)item * 16384;
    float* gbuf = (float*)(ws + WS_GBUF) + (size_t)item * 384; float* dn = (float*)(ws + WS_DN) + (size_t)item * 128; float* scal = (float*)(ws + WS_SCAL) + (size_t)item * 4;
    LAS float* gL = (LAS float*)(lds + GB) + 128; LAS _Float16* wS = (LAS _Float16*)(lds + GB + 2048);
    const int ts0 = c * 128; const size_t tokc = (size_t)b * SEQ + ts0; const int q4 = l16 >> 2, p4 = l16 & 3;
    { const int cg = tid & 15, r0 = 4 * (tid >> 4);
#pragma unroll
      for (int qk = 0; qk < 2; ++qk) { const int ch = qk * 512 + h * 128 + cg * 8; u32x4 raw[7];
#pragma unroll
          for (int j = 0; j < 7; ++j) { const int tt = ts0 + r0 - 3 + j; const int ttc = tt < 0 ? 0 : tt; u32x4 r_ = *(const u32x4*)(proj + ((size_t)b * SEQ + ttc) * NPROJ + ch);
              if (tt < 0) r_ = (u32x4){0u, 0u, 0u, 0u}; raw[j] = r_; }
          float wv[4][8], bv[8];
#pragma unroll
          for (int e4 = 0; e4 < 2; ++e4) { const f32x4 t_ = *(const f32x4*)(convb + ch + 4 * e4); bv[4 * e4] = t_[0]; bv[4 * e4 + 1] = t_[1]; bv[4 * e4 + 2] = t_[2]; bv[4 * e4 + 3] = t_[3];
#pragma unroll
              for (int tap = 0; tap < 4; ++tap) { const f32x4 u_ = *(const f32x4*)(convw + tap * 1024 + ch + 4 * e4); wv[tap][4 * e4] = u_[0]; wv[tap][4 * e4 + 1] = u_[1]; wv[tap][4 * e4 + 2] = u_[2]; wv[tap][4 * e4 + 3] = u_[3]; } }
          const float sc = qk ? 0.08838834764831845f : 1.0f;
#pragma unroll
          for (int r = 0; r < 4; ++r) { float a[8];
#pragma unroll
              for (int e = 0; e < 8; ++e) a[e] = bv[e];
#pragma unroll
              for (int tap = 0; tap < 4; ++tap) { const u32x4 r_ = raw[r + tap];
                  a[0] += wv[tap][0] * bflo(r_.x); a[1] += wv[tap][1] * bfhi(r_.x); a[2] += wv[tap][2] * bflo(r_.y); a[3] += wv[tap][3] * bfhi(r_.y);
                  a[4] += wv[tap][4] * bflo(r_.z); a[5] += wv[tap][5] * bfhi(r_.z); a[6] += wv[tap][6] * bflo(r_.w); a[7] += wv[tap][7] * bfhi(r_.w); }
              u32x4 o_; o_.x = pk2(siluf(a[0]) * sc, siluf(a[1]) * sc); o_.y = pk2(siluf(a[2]) * sc, siluf(a[3]) * sc); o_.z = pk2(siluf(a[4]) * sc, siluf(a[5]) * sc); o_.w = pk2(siluf(a[6]) * sc, siluf(a[7]) * sc);
              *(u32x4*)((qk ? kcv : qcv) + (r0 + r) * 128 + cg * 8) = o_;
              if (qk) *(LAS u32x4*)(lds + KC + (r0 + r) * ST + cg * 16) = o_; } }
#pragma unroll
      for (int r = 0; r < 4; ++r) *(LAS u32x4*)(lds + VC + (r0 + r) * ST + cg * 16) = *(const u32x4*)(proj + (tokc + r0 + r) * NPROJ + 1024 + h * 128 + cg * 8); }
    if (w == 0) { const int t0 = 2 * lane; const float* gp = gates + (tokc + t0) * 8;
        const float i0 = gp[h] + ib, f0 = gp[4 + h] + fb, i1 = gp[8 + h] + ib, f1 = gp[12 + h] + fb;
        const float lf0 = -softplusf(-f0), lf1 = -softplusf(-f1); const float s2 = lf0 + lf1; float incl = s2;
        incl += DPPF(0.f, incl, 0x111, 0xF); incl += DPPF(0.f, incl, 0x112, 0xF); incl += DPPF(0.f, incl, 0x114, 0xF); incl += DPPF(0.f, incl, 0x118, 0xF);
        incl += DPPF(0.f, incl, 0x142, 0xA); incl += DPPF(0.f, incl, 0x143, 0xC);
        const float b0 = incl - s2 + lf0, b1 = b0 + lf1; const float g0 = i0 - b0, g1 = i1 - b1; float pm = fmaxf(g0, g1);
        pm = fmaxf(pm, DPPF(-INFINITY, pm, 0x111, 0xF)); pm = fmaxf(pm, DPPF(-INFINITY, pm, 0x112, 0xF)); pm = fmaxf(pm, DPPF(-INFINITY, pm, 0x114, 0xF)); pm = fmaxf(pm, DPPF(-INFINITY, pm, 0x118, 0xF));
        pm = fmaxf(pm, DPPF(-INFINITY, pm, 0x142, 0xA)); pm = fmaxf(pm, DPPF(-INFINITY, pm, 0x143, 0xC));
        const float pe = DPPF(-INFINITY, pm, 0x138, 0xF);
        const float G0 = fmaxf(pe, g0), G1 = fmaxf(G0, g1);
        const float Gmax = __builtin_bit_cast(float, __builtin_amdgcn_readlane(__builtin_bit_cast(int, G1), 63)), blast = __builtin_bit_cast(float, __builtin_amdgcn_readlane(__builtin_bit_cast(int, b1), 63));
        *(f32x2*)(gbuf + t0) = (f32x2){b0, b1}; *(f32x2*)(gbuf + 128 + t0) = (f32x2){g0, g1}; *(f32x2*)(gbuf + 256 + t0) = (f32x2){G0, G1};
        wS[t0] = (_Float16)__expf(g0 - Gmax); wS[t0 + 1] = (_Float16)__expf(g1 - Gmax);
        if (lane == 0) { scal[0] = blast; scal[1] = Gmax; } }
    __syncthreads();
    { f32x4 Cacc[8]; f32x4 Cn = (f32x4){0.f, 0.f, 0.f, 0.f};
#pragma unroll
      for (int vt = 0; vt < 8; ++vt) Cacc[vt] = (f32x4){0.f, 0.f, 0.f, 0.f};
#pragma unroll
      for (int ks = 0; ks < 4; ++ks) { const f16x8 kb = tr8(lds + KC + (32 * ks + 4 * g + q4) * ST + (16 * w + 4 * p4) * 2, 16 * ST);
          const u32x2 wa = *(const LAS u32x2*)(wS + 32 * ks + 4 * g), wb = *(const LAS u32x2*)(wS + 32 * ks + 16 + 4 * g); const u32x4 w4 = (u32x4){wa.x, wa.y, wb.x, wb.y}; const f16x8 wf = __builtin_bit_cast(f16x8, w4);
          Cn = ML_MFMA(wf, kb, Cn);
          f16x8 vfb[8];
#pragma unroll
          for (int vt = 0; vt < 8; ++vt) vfb[vt] = tr8(lds + VC + (32 * ks + 4 * g + q4) * ST + (16 * vt + 4 * p4) * 2, 16 * ST);
          __builtin_amdgcn_sched_barrier(0);
#pragma unroll
          for (int vt = 0; vt < 8; ++vt) Cacc[vt] = ML_MFMA(vfb[vt] * wf, kb, Cacc[vt]);
          __builtin_amdgcn_sched_barrier(0); }
#pragma unroll
      for (int vt = 0; vt < 8; ++vt) { u32x2 o_; o_.x = pk2(Cacc[vt][0], Cacc[vt][1]); o_.y = pk2(Cacc[vt][2], Cacc[vt][3]); *(u32x2*)(dC + (16 * w + l16) * 128 + 16 * vt + 4 * g) = o_; }
      if (g == 0) dn[16 * w + l16] = Cn[0]; }
    __syncthreads();
}
__device__ __forceinline__ void phase_ml_scan(Frame& F) {
    unsigned char* ws = F.ws; const int tid = F.tid;
    for (int u = F.bx; u < 256; u += F.G) { const int chain = u >> 2, qtr = u & 3; const size_t e0 = (size_t)qtr * 4096 + tid * 8;
        const bf16* dC = (const bf16*)(ws + WS_DC) + (size_t)chain * 16 * 16384 + e0; bf16* Cp = (bf16*)(ws + WS_CPREV) + (size_t)chain * 16 * 16384 + e0;
        const float* dn = (const float*)(ws + WS_DN) + (size_t)chain * 16 * 128; float* np = (float*)(ws + WS_NPREV) + (size_t)chain * 16 * 128; float* scal = (float*)(ws + WS_SCAL) + (size_t)chain * 16 * 4;
        float z0 = 0.f; asm volatile("" : "+v"(z0));
        float C[8] = {z0, z0, z0, z0, z0, z0, z0, z0}; float nn = z0; float m = z0; const bool don = (qtr == 0 && tid < 128);
        u32x4 dall[16]; float dnall[16]; f32x2 scall[16];
#pragma unroll
        for (int c = 0; c < 16; ++c) { dall[c] = *(const u32x4*)(dC + (size_t)c * 16384); dnall[c] = don ? dn[c * 128 + tid] : z0; scall[c] = *(const f32x2*)(scal + c * 4); }
#pragma unroll
        for (int c = 0; c < 16; ++c) { const u32x4 dcur = dall[c]; const float dncur = dnall[c]; const f32x2 sc = scall[c];
            u32x4 o_; o_.x = pk2(C[0], C[1]); o_.y = pk2(C[2], C[3]); o_.z = pk2(C[4], C[5]); o_.w = pk2(C[6], C[7]); *(u32x4*)(Cp + (size_t)c * 16384) = o_;
            if (don) np[c * 128 + tid] = nn;
            if (qtr == 0 && tid == 0) scal[c * 4 + 2] = m;
            const float Mlast = fmaxf(m, sc[1]), wold = __expf(m - Mlast), wloc = __expf(sc[1] - Mlast);
            C[0] = wold * C[0] + wloc * bflo(dcur.x); C[1] = wold * C[1] + wloc * bfhi(dcur.x); C[2] = wold * C[2] + wloc * bflo(dcur.y); C[3] = wold * C[3] + wloc * bfhi(dcur.y);
            C[4] = wold * C[4] + wloc * bflo(dcur.z); C[5] = wold * C[5] + wloc * bfhi(dcur.z); C[6] = wold * C[6] + wloc * bflo(dcur.w); C[7] = wold * C[7] + wloc * bfhi(dcur.w);
            nn = wold * nn + wloc * dncur; m = sc[0] + Mlast; } }
}
struct X3Pf { u32x4 q[4], k[4], c[4], v[4]; f32x4 g; float mp; };
__device__ __forceinline__ void x3_load(Frame& F, const int item, X3Pf& pf) {
    unsigned char* ws = F.ws; const bf16* proj = (const bf16*)(ws + WS_PROJ); const int tid = F.wave * 64 + pg8::lane_fresh();
    const int chain = item >> 4, c = item & 15, b = chain >> 2, h = chain & 3; const size_t tokc = (size_t)b * SEQ + c * 128;
    const bf16* qcv = (const bf16*)(ws + WS_QCV) + (size_t)item * 16384; const bf16* kcv = (const bf16*)(ws + WS_KCV) + (size_t)item * 16384; const bf16* Cp = (const bf16*)(ws + WS_CPREV) + (size_t)item * 16384;
    const float* gbuf = (const float*)(ws + WS_GBUF) + (size_t)item * 384; const float* np = (const float*)(ws + WS_NPREV) + (size_t)item * 128; const float* scal = (const float*)(ws + WS_SCAL) + (size_t)item * 4;
    const int cg = tid & 15, r0 = tid >> 4;
#pragma unroll
    for (int i = 0; i < 4; ++i) { const int row = r0 + 32 * i;
        pf.q[i] = *(const u32x4*)(qcv + row * 128 + cg * 8); pf.k[i] = *(const u32x4*)(kcv + row * 128 + cg * 8);
        pf.c[i] = *(const u32x4*)(Cp + row * 128 + cg * 8); pf.v[i] = *(const u32x4*)(proj + (tokc + row) * NPROJ + 1024 + h * 128 + cg * 8); }
    pf.g = (f32x4){0.f, 0.f, 0.f, 0.f};
    if (tid < 96) pf.g = *(const f32x4*)(gbuf + 4 * tid); else if (tid < 128) pf.g = *(const f32x4*)(np + 4 * (tid - 96));
    pf.mp = scal[2];
}
__device__ __forceinline__ void ml_x3(Frame& F, int l, const int item, X3Pf& pf, const int next_item) {
    using namespace mls;
    unsigned char* ws = F.ws; const bf16* proj = (const bf16*)(ws + WS_PROJ); bf16* y = (bf16*)(ws + WS_Y);
    const int tid = F.tid, lane = F.lane, w = F.wave, l16 = lane & 15, g = lane >> 4; LAS unsigned char* lds = F.lds;
    const int chain = item >> 4, c = item & 15, b = chain >> 2, h = chain & 3;
    const float* hg = F.in_(8) + l * 512 + h * 128;
    const bf16* qcv = (const bf16*)(ws + WS_QCV) + (size_t)item * 16384; const bf16* kcv = (const bf16*)(ws + WS_KCV) + (size_t)item * 16384; const bf16* Cp = (const bf16*)(ws + WS_CPREV) + (size_t)item * 16384;
    const float* gbuf = (const float*)(ws + WS_GBUF) + (size_t)item * 384; const float* np = (const float*)(ws + WS_NPREV) + (size_t)item * 128; const float* scal = (const float*)(ws + WS_SCAL) + (size_t)item * 4;
    LAS float* bL = (LAS float*)(lds + GB); LAS float* gL = bL + 128; LAS float* GL = bL + 256; LAS float* nL = bL + 384;
    const size_t tokc = (size_t)b * SEQ + c * 128; const int q4 = l16 >> 2, p4 = l16 & 3;
    { const int cg = tid & 15, r0 = tid >> 4;
#pragma unroll
      for (int i = 0; i < 4; ++i) { const int row = r0 + 32 * i;
          *(LAS u32x4*)(lds + QC + row * ST + cg * 16) = pf.q[i]; *(LAS u32x4*)(lds + KC + row * ST + cg * 16) = pf.k[i];
          *(LAS u32x4*)(lds + CT + row * ST + cg * 16) = pf.c[i]; *(LAS u32x4*)(lds + VC + row * ST + cg * 16) = pf.v[i]; }
      if (tid < 96) *(LAS f32x4*)(bL + 4 * tid) = pf.g;
      else if (tid < 128) *(LAS f32x4*)(nL + 4 * (tid - 96)) = pf.g; }
    const float mp = pf.mp;
    __syncthreads();
    if (next_item >= 0) x3_load(F, next_item, pf);
    { const int t = 16 * w + l16; const size_t tok = tokc + t; const float Mt = fmaxf(mp, GL[t]), bt = bL[t]; const float wi = __expf(mp - Mt);
      u32x2 mo8[8];
#pragma unroll
      for (int vt = 0; vt < 8; ++vt) mo8[vt] = *(const u32x2*)(proj + tok * NPROJ + 1536 + h * 128 + 16 * vt + 4 * g);
      f16x8 qf[4], qs[4];
#pragma unroll
      for (int kk = 0; kk < 4; ++kk) { qf[kk] = *(const LAS f16x8*)(lds + QC + (16 * w + l16) * ST + (32 * kk + 8 * g) * 2); qs[kk] = qf[kk] * (_Float16)wi; }
      f32x4 sa[8];
#pragma unroll
      for (int st = 0; st < 8; ++st) { sa[st] = (f32x4){0.f, 0.f, 0.f, 0.f};
          if (st <= w) { f16x8 kf[4];
#pragma unroll
              for (int kk = 0; kk < 4; ++kk) kf[kk] = *(const LAS f16x8*)(lds + KC + (16 * st + l16) * ST + (32 * kk + 8 * g) * 2);
              __builtin_amdgcn_sched_barrier(0);
#pragma unroll
              for (int kk = 0; kk < 4; ++kk) sa[st] = ML_MFMA(kf[kk], qf[kk], sa[st]);
              __builtin_amdgcn_sched_barrier(0); } }
      float den = 0.f;
#pragma unroll
      for (int st = 0; st < 8; ++st) { const f32x4 gv = *(const LAS f32x4*)(gL + 16 * st + 4 * g);
#pragma unroll
          for (int r = 0; r < 4; ++r) { const int s_ = 16 * st + 4 * g + r; const float p = (s_ <= t) ? sa[st][r] * __expf(gv[r] - Mt) : 0.f; den += p; sa[st][r] = p; } }
      f16x8 Pf[4];
#pragma unroll
      for (int ks = 0; ks < 4; ++ks) Pf[ks] = sbat::cvt8(sa[2 * ks][0], sa[2 * ks][1], sa[2 * ks][2], sa[2 * ks][3], sa[2 * ks + 1][0], sa[2 * ks + 1][1], sa[2 * ks + 1][2], sa[2 * ks + 1][3]);
      f32x4 nt[8];
#pragma unroll
      for (int vt = 0; vt < 8; ++vt) { nt[vt] = (f32x4){0.f, 0.f, 0.f, 0.f}; f16x8 vf[4], cf[4];
#pragma unroll
          for (int ks = 0; ks < 4; ++ks) if (32 * ks <= 16 * w + 15) vf[ks] = tr8(lds + VC + (32 * ks + 4 * g + q4) * ST + (16 * vt + 4 * p4) * 2, 16 * ST);
#pragma unroll
          for (int kk = 0; kk < 4; ++kk) cf[kk] = tr8(lds + CT + (32 * kk + 8 * g + q4) * ST + (16 * vt + 4 * p4) * 2, 4 * ST);
          __builtin_amdgcn_sched_barrier(0);
#pragma unroll
          for (int ks = 0; ks < 4; ++ks) if (32 * ks <= 16 * w + 15) nt[vt] = ML_MFMA(vf[ks], Pf[ks], nt[vt]);
#pragma unroll
          for (int kk = 0; kk < 4; ++kk) nt[vt] = ML_MFMA(cf[kk], qs[kk], nt[vt]);
          __builtin_amdgcn_sched_barrier(0); }
      den = xor16_sum(den); den = xor32_sum(den);
      float nq = 0.f;
#pragma unroll
      for (int kk = 0; kk < 4; ++kk) { const f32x4 n0 = *(const LAS f32x4*)(nL + 32 * kk + 8 * g), n1 = *(const LAS f32x4*)(nL + 32 * kk + 8 * g + 4);
          nq += n0[0] * (float)qf[kk][0] + n0[1] * (float)qf[kk][1] + n0[2] * (float)qf[kk][2] + n0[3] * (float)qf[kk][3] + n1[0] * (float)qf[kk][4] + n1[1] * (float)qf[kk][5] + n1[2] * (float)qf[kk][6] + n1[3] * (float)qf[kk][7]; }
      nq = xor16_sum(nq); nq = xor32_sum(nq);
      den += wi * nq;
      const float dn_ = __builtin_amdgcn_rcpf(fmaxf(fabsf(den), __expf(-(bt + Mt)))); float ss = 0.f;
#pragma unroll
      for (int vt = 0; vt < 8; ++vt)
#pragma unroll
          for (int r = 0; r < 4; ++r) { nt[vt][r] *= dn_; ss += nt[vt][r] * nt[vt][r]; }
      ss = xor16_sum(ss); ss = xor32_sum(ss); const float rr = rsqrtf(ss * (1.0f / 128) + EPS);
#pragma unroll
      for (int vt = 0; vt < 8; ++vt) { const int v0 = 16 * vt + 4 * g; const u32x2 mo = mo8[vt]; const f32x4 gg = *(const f32x4*)(hg + v0);
          u32x2 o_; o_.x = pk2(sigmf(bflo(mo.x)) * nt[vt][0] * rr * gg[0], sigmf(bfhi(mo.x)) * nt[vt][1] * rr * gg[1]); o_.y = pk2(sigmf(bflo(mo.y)) * nt[vt][2] * rr * gg[2], sigmf(bfhi(mo.y)) * nt[vt][3] * rr * gg[3]);
          *(u32x2*)(y + tok * D + h * 128 + v0) = o_; } }
    __syncthreads();
}

__device__ __forceinline__ void phase_mixer(Frame& F, int l, int qidx, int mode) {
    volatile LAS int* qs = (volatile LAS int*)(F.lds + MISC_OFF + 64); unsigned* qc = F.ctl + CW_Q + qidx;
    int ahead = 0; if (F.tid == 0) ahead = (int)atomicAdd(qc, 1u);
    for (;;) {
        if (F.tid == 0) *qs = ahead;
        __syncthreads();
        const int it = __builtin_amdgcn_readfirstlane(*qs);
        __syncthreads();
        if (it >= 512 + 1024) break;
        if (F.tid == 0) ahead = (int)atomicAdd(qc, 1u);
        if (mode == 1 && it < 512) continue;
        if (mode == 3 && it >= 512) break;
        Frame G = F;
        { int t_ = F.tid; asm volatile("" : "+v"(t_)); G.tid = t_; G.lane = t_ & 63; G.wave = __builtin_amdgcn_readfirstlane(t_ >> 6);
          unsigned lb_ = 0; asm volatile("" : "+s"(lb_)); G.lds = F.lds + lb_;
          GAS unsigned char* w_ = (GAS unsigned char*)F.ws; asm volatile("" : "+s"(w_)); G.ws = (unsigned char*)w_; }
        if (it >= 512) ml_x1(G, l, it - 512);
        else sb_unit(G, l, it & 63, 7 - (it >> 6));
    }
}

namespace xat {
constexpr int KST = 272, VST = 320, BUFB = 64 * VST, OST = 272;
typedef __amdgpu_buffer_rsrc_t rsrc_t;
__device__ __forceinline__ float xor32_max(float x) { auto t = __builtin_amdgcn_permlane32_swap(__float_as_uint(x), __float_as_uint(x), false, false); return fmaxf(__uint_as_float(t[0]), __uint_as_float(t[1])); }
template <int S> struct Step { static constexpr int isV = S >= 8, tile = isV ? ((S - 8) & 3) : (S >> 1), dh = isV ? ((S - 8) >> 2) : (S & 1), buf = S % 3; };
template <int S> __device__ __forceinline__ void ld(u32x4 (&r)[2], rsrc_t kvr, unsigned loff) {
    if constexpr (S < 16) {
#pragma unroll
        for (int i = 0; i < 2; ++i) r[i] = __builtin_bit_cast(u32x4, __builtin_amdgcn_raw_buffer_load_b128(kvr, loff, ((64 * Step<S>::tile + 32 * i) * 2048 + Step<S>::isV * 1024 + Step<S>::dh * 128) * 2, 0)); }
}
template <int S> __device__ __forceinline__ void st(const u32x4 (&r)[2], LAS unsigned char* lds, unsigned lk, unsigned lv) {
    if constexpr (S < 16) { constexpr int ST = Step<S>::isV ? VST : KST;
#pragma unroll
        for (int i = 0; i < 2; ++i) *(LAS u32x4*)(lds + (Step<S>::isV ? lv : lk) + Step<S>::buf * BUFB + 32 * i * ST) = r[i]; }
}
template <int S> __device__ __forceinline__ void qk(f32x16& S0, f32x16& S1, const f16x8 (&qf)[16], const LAS unsigned char* lds, int t32, int hi) {
#pragma unroll
    for (int kk = 0; kk < 8; ++kk) { const f16x8 k0 = *(const LAS f16x8*)(lds + Step<S>::buf * BUFB + t32 * KST + 32 * kk + 16 * hi); const f16x8 k1 = *(const LAS f16x8*)(lds + Step<S>::buf * BUFB + (32 + t32) * KST + 32 * kk + 16 * hi);
        S0 = SB_MFMA(k0, qf[8 * Step<S>::dh + kk], S0); S1 = SB_MFMA(k1, qf[8 * Step<S>::dh + kk], S1); }
}
template <int TILE> __device__ __forceinline__ void smax(f32x16& S0, f32x16& S1, f16x8 (&Pf)[8][2], float (&mt)[4], float& m, float& sum) {
    float tm = fmaxf(S0[0], S1[0]);
#pragma unroll
    for (int r = 1; r < 16; ++r) tm = fmaxf(tm, fmaxf(S0[r], S1[r]));
    tm = xor32_max(tm);
    const float mn = fmaxf(m, tm); sum *= __builtin_amdgcn_exp2f(m - mn); m = mn; mt[TILE] = mn;
    float ps = 0.f;
#pragma unroll
    for (int r = 0; r < 16; ++r) { S0[r] = __builtin_amdgcn_exp2f(S0[r] - mn); S1[r] = __builtin_amdgcn_exp2f(S1[r] - mn); ps += S0[r] + S1[r]; }
    sum += ps;
    Pf[2 * TILE][0] = sbat::cvt8(S0[0], S0[1], S0[2], S0[3], S0[4], S0[5], S0[6], S0[7]); Pf[2 * TILE][1] = sbat::cvt8(S0[8], S0[9], S0[10], S0[11], S0[12], S0[13], S0[14], S0[15]);
    Pf[2 * TILE + 1][0] = sbat::cvt8(S1[0], S1[1], S1[2], S1[3], S1[4], S1[5], S1[6], S1[7]); Pf[2 * TILE + 1][1] = sbat::cvt8(S1[8], S1[9], S1[10], S1[11], S1[12], S1[13], S1[14], S1[15]);
#pragma unroll
    for (int r = 0; r < 16; ++r) { S0[r] = 0.f; S1[r] = 0.f; }
}
template <int S> __device__ __forceinline__ void pv(f32x16 (&O)[4], const f16x8 (&Pf)[8][2], const LAS unsigned char* lds, int lane, int hi) {
    const int i16 = lane & 15, dhalf = (lane >> 4) & 1;
    const LAS unsigned char* va = lds + Step<S>::buf * BUFB + (4 * hi + (i16 >> 2)) * VST + (dhalf * 16 + 4 * (i16 & 3)) * 2;
#pragma unroll
    for (int dblk = 0; dblk < 4; ++dblk)
#pragma unroll
        for (int sb = 0; sb < 2; ++sb)
#pragma unroll
            for (int sp = 0; sp < 2; ++sp) { const LAS unsigned char* pp = va + (32 * sb + 16 * sp) * VST + dblk * 64; const s16x4 lo = sbat::vtr(pp), h4 = sbat::vtr(pp + 8 * VST);
                const bf16x8 vf = (bf16x8){lo[0], lo[1], lo[2], lo[3], h4[0], h4[1], h4[2], h4[3]};
                O[dblk] = SB_MFMA(__builtin_bit_cast(f16x8, vf), Pf[2 * Step<S>::tile + sb][sp], O[dblk]); }
}
}
__device__ __forceinline__ void phase_xattn(Frame& F) {
    using namespace xat;
    unsigned char* ws = F.ws; const bf16* q = (const bf16*)(ws + WS_Q); const bf16* kv = (const bf16*)(ws + WS_KV); bf16* o = (bf16*)(ws + WS_O);
    const int tid = F.tid, lane = F.lane, w = F.wave, t32 = lane & 31, hi = lane >> 5; LAS unsigned char* lds = F.lds;
    const unsigned loff = (unsigned)((tid >> 4) * 2048 + (tid & 15) * 8) * 2u, lk = (unsigned)((tid >> 4) * KST + (tid & 15) * 16), lv = (unsigned)((tid >> 4) * VST + (tid & 15) * 16);
    for (int unit = F.bx; unit < 512; unit += F.G) {
        const int bh = (unit & 255) >> 2, qblk = ((unit & 3) << 1) | (unit >> 8), b = bh >> 2, hd = bh & 3;
        const size_t tok0 = (size_t)b * SEQ + qblk * 256 + 32 * w;
        const bf16* kvb = kv + (size_t)b * MEML * 2048 + hd * 256;
        const rsrc_t kvr = __builtin_amdgcn_make_buffer_rsrc((void*)kvb, 0, 0x7fffffff, 0x00020000);
        f16x8 qf[16];
        { const bf16* qrow = q + (tok0 + t32) * D + hd * 256 + 8 * hi;
#pragma unroll
          for (int kk = 0; kk < 16; ++kk) qf[kk] = *(const f16x8*)(qrow + 16 * kk); }
        f16x8 Pf[8][2]; float mt[4]; float m = -INFINITY, sum = 0.f;
        f32x16 S0, S1;
#pragma unroll
        for (int r = 0; r < 16; ++r) { S0[r] = 0.f; S1[r] = 0.f; }
        u32x4 rA[2], rB[2];
        ld<0>(rA, kvr, loff); st<0>(rA, lds, lk, lv); ld<1>(rB, kvr, loff); __syncthreads();
#define XA_KSTEP(S_, RL, RS) ld<S_ + 2>(RL, kvr, loff); qk<S_>(S0, S1, qf, lds, t32, hi); if ((S_) & 1) smax<((S_) / 2)>(S0, S1, Pf, mt, m, sum); st<S_ + 1>(RS, lds, lk, lv); __syncthreads();
        XA_KSTEP(0, rA, rB) XA_KSTEP(1, rB, rA) XA_KSTEP(2, rA, rB) XA_KSTEP(3, rB, rA) XA_KSTEP(4, rA, rB) XA_KSTEP(5, rB, rA) XA_KSTEP(6, rA, rB) XA_KSTEP(7, rB, rA)
#undef XA_KSTEP
#pragma unroll
        for (int t = 0; t < 3; ++t) { const _Float16 f = (_Float16)__builtin_amdgcn_exp2f(mt[t] - m);
#pragma unroll
            for (int sb = 0; sb < 2; ++sb)
#pragma unroll
                for (int sp = 0; sp < 2; ++sp) Pf[2 * t + sb][sp] = Pf[2 * t + sb][sp] * f; }
        sum = xor32_sum(sum); const float inv = 1.0f / sum;
        LAS unsigned char* stg = lds + 3 * BUFB + w * (32 * OST);
#define XA_VSTEP(S_, RL, RS) ld<S_ + 2>(RL, kvr, loff); pv<S_>(O, Pf, lds, lane, hi); st<S_ + 1>(RS, lds, lk, lv); __syncthreads();
#pragma unroll
        for (int dh = 0; dh < 2; ++dh) {
            f32x16 O[4];
#pragma unroll
            for (int dblk = 0; dblk < 4; ++dblk)
#pragma unroll
                for (int r = 0; r < 16; ++r) O[dblk][r] = 0.f;
            if (dh == 0) { XA_VSTEP(8, rA, rB) XA_VSTEP(9, rB, rA) XA_VSTEP(10, rA, rB) XA_VSTEP(11, rB, rA) }
            else         { XA_VSTEP(12, rA, rB) XA_VSTEP(13, rB, rA) XA_VSTEP(14, rA, rB) XA_VSTEP(15, rB, rA) }
            int le = lane; asm volatile("" : "+v"(le));
            const int t32e = le & 31, hie = le >> 5;
#pragma unroll
            for (int db = 0; db < 4; ++db)
#pragma unroll
                for (int rq = 0; rq < 4; ++rq) { u32x2 v; v.x = pk2(O[db][4 * rq] * inv, O[db][4 * rq + 1] * inv); v.y = pk2(O[db][4 * rq + 2] * inv, O[db][4 * rq + 3] * inv);
                    *(LAS u32x2*)(stg + t32e * OST + (db * 32 + 8 * rq + 4 * hie) * 2) = v; }
            LDS_WAIT();
            const int ch = le & 15;
#pragma unroll
            for (int i = 0; i < 8; ++i) { const int row = i * 4 + (le >> 4); const u32x4 v = *(const LAS u32x4*)(stg + row * OST + ch * 16);
                *(u32x4*)(o + (tok0 + row) * D + hd * 256 + dh * 128 + ch * 8) = v; }
            LDS_WAIT();
        }
#undef XA_VSTEP
    }
}


namespace xat2 {
#define XA2_NPARK 7
__device__ __forceinline__ int lane_now() { int l; asm volatile("v_mbcnt_lo_u32_b32 %0, -1, 0\n\tv_mbcnt_hi_u32_b32 %0, -1, %0" : "=v"(l)); return l; }
__device__ __forceinline__ void dma_kv(const char* src0, LAS unsigned char* lds, int w, unsigned gofs) {
#pragma unroll
    for (int i = 0; i < 16; ++i) __builtin_amdgcn_global_load_lds((const unsigned*)(src0 + gofs + (size_t)i * 16 * 4096), (LAS unsigned*)(lds + (w + 8 * i) * 1024), 16, 0, 0);
}
}
__device__ __forceinline__ void phase_xattn2(Frame& F) {
    using namespace xat;
    unsigned char* ws = F.ws; const bf16* q = (const bf16*)(ws + WS_Q); const bf16* kv = (const bf16*)(ws + WS_KV); bf16* o = (bf16*)(ws + WS_O);
    const int w = F.wave; LAS unsigned char* lds = F.lds;
#define XA2_GOFS(L) ((unsigned)(2 * w + ((L) >> 5)) * 4096u + 16u * (unsigned)(((L) & 31) ^ (((2 * (w & 1) + ((L) >> 5)) << 2) | ((w >> 1) & 3))))
    for (int cu = F.bx; cu < 256; cu += F.G) {
        const int bh = cu >> 2, qp = cu & 3, b = bh >> 2, hd = bh & 3;
        const char* kvb = (const char*)(kv + (size_t)b * MEML * 2048 + hd * 256);
        const size_t tokA = (size_t)b * SEQ + 512 * qp + 32 * w;
        int lane = xat2::lane_now();
        xat2::dma_kv(kvb, lds, w, XA2_GOFS(lane));
        lane = xat2::lane_now();
        const int t32 = lane & 31, hi = lane >> 5;
        const int kA = t32 * 512 + ((hi ^ (((t32 & 3) << 2) | ((t32 >> 2) & 3))) << 4);
        f16x8 PfA[8][2], PfB[8][2]; float invA = 0.f, invB = 0.f;
#define XA2_LOADQ(TOK0) { const bf16* qrow = q + ((TOK0) + t32) * D + hd * 256 + 8 * hi; _Pragma("unroll") for (int kk = 0; kk < 16; ++kk) qf[kk] = *(const f16x8*)(qrow + 16 * kk); }
#define XA2_QK(PF, INV) do { \
            float mt[4]; float m = -INFINITY, sum = 0.f; f32x16 S0, S1; _Pragma("unroll") for (int r = 0; r < 16; ++r) { S0[r] = 0.f; S1[r] = 0.f; } \
            XA2_QKT(PF, 0) XA2_QKT(PF, 1) XA2_QKT(PF, 2) XA2_QKT(PF, 3) \
            _Pragma("unroll") for (int t = 0; t < 3; ++t) { const _Float16 f = (_Float16)__builtin_amdgcn_exp2f(mt[t] - m); _Pragma("unroll") for (int sb = 0; sb < 2; ++sb) _Pragma("unroll") for (int sp = 0; sp < 2; ++sp) PF[2 * t + sb][sp] = PF[2 * t + sb][sp] * f; } \
            sum = xor32_sum(sum); INV = 1.0f / sum; } while (0)
#define XA2_RDB(G) { _Pragma("unroll") for (int j = 0; j < XA2_NB; ++j) { const int kk = (G) * XA2_NB + j; kb[(G) & XA2_PIPE][j][0] = *(const LAS f16x8*)(lds + (kAt ^ (32 * kk))); kb[(G) & XA2_PIPE][j][1] = *(const LAS f16x8*)(lds + ((kAt + 32 * 512) ^ (32 * kk))); } }
#define XA2_QKT(PF, T) { int kAt = kA + (64 * (T)) * 512; asm volatile("" : "+v"(kAt)); f16x8 kb[XA2_PIPE + 1][XA2_NB][2]; \
            if (XA2_PIPE) { XA2_RDB(0) } \
            _Pragma("unroll") for (int g = 0; g < 16 / XA2_NB; ++g) { \
                if (XA2_PIPE) { if (g + 1 < 16 / XA2_NB) { XA2_RDB(g + 1) } } else { XA2_RDB(g) } \
                __builtin_amdgcn_sched_barrier(0); \
                _Pragma("unroll") for (int j = 0; j < XA2_NB; ++j) { S0 = SB_MFMA(kb[g & XA2_PIPE][j][0], qf[g * XA2_NB + j], S0); S1 = SB_MFMA(kb[g & XA2_PIPE][j][1], qf[g * XA2_NB + j], S1); } \
                __builtin_amdgcn_sched_barrier(0); } \
            smax<T>(S0, S1, PF, mt, m, sum); __builtin_amdgcn_sched_barrier(0); }
        f16x8 qf[16];
        XA2_LOADQ(tokA);
        asm volatile("s_waitcnt vmcnt(0)" ::: "memory"); __syncthreads();
#define XA2_NB 4
#define XA2_PIPE 1
        XA2_QK(PfA, invA);
#undef XA2_NB
#undef XA2_PIPE
#define XA2_NB 2
#define XA2_PIPE 0
        XA2_LOADQ(tokA + 256);
        u32x4* pscr = (u32x4*)(ws + WS_QCV) + (size_t)cu * XA2_NPARK * NTHREADS + (w * 64 + xat2::lane_now());
#pragma unroll
        for (int i = 0; i < XA2_NPARK; ++i) pscr[i * NTHREADS] = __builtin_bit_cast(u32x4, PfA[i >> 1][i & 1]);
        XA2_QK(PfB, invB);
#undef XA2_NB
#undef XA2_PIPE
#undef XA2_RDB
#undef XA2_QK
#undef XA2_LOADQ
#undef XA2_QKT
        __syncthreads();
        { const int l2 = xat2::lane_now(); xat2::dma_kv(kvb + 2048, lds, w, XA2_GOFS(l2)); }
        asm volatile("s_waitcnt vmcnt(0)" ::: "memory"); __syncthreads();
        const int l3 = xat2::lane_now();
        const int i16 = l3 & 15, q4 = i16 >> 2, p4 = i16 & 3, dhalf = (l3 >> 4) & 1, hi3 = l3 >> 5;
        const int vA = (4 * hi3 + q4) * 512 + ((q4 << 6) | ((((dhalf << 1) | (p4 >> 1)) ^ hi3) << 4) | ((p4 & 1) << 3));
        LAS unsigned char* stg = lds + RING_BYTES + w * 2560;
#define XA2_PV(PF, INV, TOK0) do { _Pragma("unroll") for (int dh = 0; dh < 2; ++dh) { f32x16 O[4]; _Pragma("unroll") for (int db = 0; db < 4; ++db) _Pragma("unroll") for (int r = 0; r < 16; ++r) O[db][r] = 0.f; \
            _Pragma("unroll") for (int T = 0; T < 4; ++T) { int vAt = vA + 64 * T * 512; asm volatile("" : "+v"(vAt)); _Pragma("unroll") for (int db = 0; db < 4; ++db) _Pragma("unroll") for (int sb = 0; sb < 2; ++sb) _Pragma("unroll") for (int sp = 0; sp < 2; ++sp) { \
                const int rows0 = (32 * sb + 16 * sp) * 512, dx = (4 * dh + db) * 64; \
                const s16x4 lo = sbat::vtr(lds + ((vAt + rows0) ^ dx)), h4 = sbat::vtr(lds + ((vAt + rows0 + 8 * 512) ^ dx ^ 32)); \
                const bf16x8 vf = (bf16x8){lo[0], lo[1], lo[2], lo[3], h4[0], h4[1], h4[2], h4[3]}; \
                O[db] = SB_MFMA(__builtin_bit_cast(f16x8, vf), PF[2 * T + sb][sp], O[db]); if (sb == 1 && sp == 1) __builtin_amdgcn_sched_barrier(0); } } \
            const int le = xat2::lane_now(); const int t32e = le & 31, hie = le >> 5; \
            _Pragma("unroll") for (int db = 0; db < 4; ++db) { \
              if (F8_MO) { \
                _Pragma("unroll") for (int rq = 0; rq < 4; ++rq) *(LAS unsigned*)(stg + t32e * 48 + 8 * rq + 4 * hie) = f8x4(O[db][4 * rq] * ((INV) * F8_HSCALE), O[db][4 * rq + 1] * ((INV) * F8_HSCALE), O[db][4 * rq + 2] * ((INV) * F8_HSCALE), O[db][4 * rq + 3] * ((INV) * F8_HSCALE)); \
                LDS_WAIT(); \
                { const int row = le >> 1, hf = le & 1; const u32x4 v = *(const LAS u32x4*)(stg + row * 48 + hf * 16); \
                    *(u32x4*)((unsigned char*)o + ((TOK0) + row) * D + hd * 256 + (4 * dh + db) * 32 + hf * 16) = v; } \
                LDS_WAIT(); \
              } else { \
                _Pragma("unroll") for (int rq = 0; rq < 4; ++rq) { u32x2 v; v.x = pk2(O[db][4 * rq] * (INV), O[db][4 * rq + 1] * (INV)); v.y = pk2(O[db][4 * rq + 2] * (INV), O[db][4 * rq + 3] * (INV)); \
                    *(LAS u32x2*)(stg + t32e * 80 + (8 * rq + 4 * hie) * 2) = v; } \
                LDS_WAIT(); \
                _Pragma("unroll") for (int i = 0; i < 2; ++i) { const int row = (le >> 2) + 16 * i, ch = le & 3; const u32x4 v = *(const LAS u32x4*)(stg + row * 80 + ch * 16); \
                    *(u32x4*)(o + ((TOK0) + row) * D + hd * 256 + (4 * dh + db) * 32 + ch * 8) = v; } \
                LDS_WAIT(); } } } } while (0)
        XA2_PV(PfB, invB, tokA + 256);
#pragma unroll
        for (int i = 0; i < XA2_NPARK; ++i) PfA[i >> 1][i & 1] = __builtin_bit_cast(f16x8, pscr[i * NTHREADS]);
        XA2_PV(PfA, invA, tokA);
#undef XA2_PV
#undef XA2_GOFS
        __syncthreads();
    }
}

__device__ __forceinline__ void phase_gates(Frame& F) {
    unsigned char* ws = F.ws; const bf16* xbp = (const bf16*)(ws + WS_XB); const bf16* wg = (const bf16*)(ws + WS_WIN) + (size_t)NPROJ * D; const float* ssq = (const float*)(ws + WS_SSQ); float* gates = (float*)(ws + WS_GATES);
    const int tid = F.tid, lane = F.lane, w = F.wave, l16 = lane & 15, g = lane >> 4, tpb = NTOK / F.G; LAS unsigned char* lds = F.lds;
    constexpr int WST = 2064;
    for (int e = tid; e < 16 * 128; e += NTHREADS) { const int n = e >> 7, k8 = (e & 127) * 8; u32x4 o_ = (u32x4){0u, 0u, 0u, 0u}; if (n < 8) o_ = *(const u32x4*)(wg + (size_t)n * D + k8); *(LAS u32x4*)(lds + n * WST + k8 * 2) = o_; }
    __syncthreads();
    for (int t0 = w * 16; t0 < tpb; t0 += NWAVES * 16) { const int tokb = F.bx * tpb + t0;
        f32x4 acc = (f32x4){0.f, 0.f, 0.f, 0.f}; const bf16* xrow = xbp + (size_t)(tokb + l16) * D + 8 * g;
#pragma unroll
        for (int kb = 0; kb < 2; ++kb) { f16x8 af[16];
#pragma unroll
            for (int j = 0; j < 16; ++j) af[j] = *(const f16x8*)(xrow + 32 * (16 * kb + j));
#pragma unroll
            for (int j = 0; j < 16; ++j) { const int kk = 16 * kb + j; const f16x8 b0 = *(const LAS f16x8*)(lds + l16 * WST + (32 * kk + 8 * g) * 2); acc = ML_MFMA(af[j], b0, acc); } }
        if (l16 < 8) {
#pragma unroll
            for (int r = 0; r < 4; ++r) gates[(size_t)(tokb + 4 * g + r) * 8 + l16] = acc[r] * pg8::rstd_from_ssq(ssq, tokb + 4 * g + r); } }
    __syncthreads();
}

__device__ __forceinline__ void phase_router1(Frame& F, int l) {
    unsigned char* ws = F.ws; const bf16* xbp = (const bf16*)(ws + WS_XB); const float* wr = (const float*)(ws + WS_WR); const float* ssq = (const float*)(ws + WS_SSQ);
    u32x4* tokinfo = (u32x4*)(ws + WS_TOKINFO); int* cntb = (int*)(ws + WS_CNTB); unsigned char* xq8 = ws + WS_XQ8; const bool f8 = layer_f8(l);
    const int tid = F.tid, lane = F.lane, w = F.wave, l16 = lane & 15, g = lane >> 4, tpb = NTOK / F.G; LAS unsigned char* lds = F.lds;
    constexpr int WST = 2064;
    LAS int* clsL = (LAS int*)(lds + SCR_OFF); LAS float* fL = (LAS float*)(lds + SCR_OFF + 2048); LAS float* lgL = (LAS float*)(lds + 32 * WST) + w * 512;
    for (int e = tid; e < 32 * 128; e += NTHREADS) { const int n = e >> 7, k8 = (e & 127) * 8; u32x4 o_ = (u32x4){0u, 0u, 0u, 0u};
        if (n < 20) { const f32x4 a0 = *(const f32x4*)(wr + n * D + k8), a1 = *(const f32x4*)(wr + n * D + k8 + 4); o_.x = pk2(a0[0], a0[1]); o_.y = pk2(a0[2], a0[3]); o_.z = pk2(a1[0], a1[1]); o_.w = pk2(a1[2], a1[3]); }
        *(LAS u32x4*)(lds + n * WST + k8 * 2) = o_; }
    __syncthreads();
    for (int t0 = w * 16; t0 < tpb; t0 += NWAVES * 16) { const int tokb = F.bx * tpb + t0;
        f32x4 acc0 = (f32x4){0.f, 0.f, 0.f, 0.f}, acc1 = acc0; const bf16* xrow = xbp + (size_t)(tokb + l16) * D + 8 * g;
#pragma unroll
        for (int kb = 0; kb < 4; ++kb) { f16x8 af[8];
#pragma unroll
            for (int j = 0; j < 8; ++j) af[j] = *(const f16x8*)(xrow + 32 * (8 * kb + j));
            if (f8) {
#pragma unroll
                for (int j = 0; j < 8; ++j) { u32x2 o; o.x = f8x4((float)af[j][0], (float)af[j][1], (float)af[j][2], (float)af[j][3]); o.y = f8x4((float)af[j][4], (float)af[j][5], (float)af[j][6], (float)af[j][7]);
                    *(u32x2*)(xq8 + (size_t)(tokb + l16) * D + 32 * (8 * kb + j) + 8 * g) = o; } }
#pragma unroll
            for (int j = 0; j < 8; ++j) { const int kk = 8 * kb + j; const f16x8 b0 = *(const LAS f16x8*)(lds + l16 * WST + (32 * kk + 8 * g) * 2), b1 = *(const LAS f16x8*)(lds + (16 + l16) * WST + (32 * kk + 8 * g) * 2);
                acc0 = ML_MFMA(af[j], b0, acc0); acc1 = ML_MFMA(af[j], b1, acc1); } }
        const float bias0 = wr[20 * D + l16], bias1 = l16 < 4 ? wr[20 * D + 16 + l16] : 0.f;
#pragma unroll
        for (int r = 0; r < 4; ++r) { const float rs = pg8::rstd_from_ssq(ssq, tokb + 4 * g + r); lgL[(4 * g + r) * 32 + l16] = acc0[r] * rs + bias0; lgL[(4 * g + r) * 32 + 16 + l16] = acc1[r] * rs + bias1; }
        LDS_WAIT();
        if (lane < 16) { const LAS float* lp = lgL + lane * 32; const f32x4 lg = *(const LAS f32x4*)lp; const int tok = tokb + lane;
            int gs = 0; float gm = lg[0];
#pragma unroll
            for (int j = 1; j < 4; ++j) if (lg[j] > gm) { gm = lg[j]; gs = j; }
            float gsum = 0.f;
#pragma unroll
            for (int j = 0; j < 4; ++j) gsum += __expf(lg[j] - gm);
            const float psel = 1.f / gsum; const f32x4 es = *(const LAS f32x4*)(lp + 4 + 4 * gs);
            int i0 = 0; float m0 = es[0];
#pragma unroll
            for (int e = 1; e < 4; ++e) if (es[e] > m0) { m0 = es[e]; i0 = e; }
            int i1 = -1; float m1 = -INFINITY;
#pragma unroll
            for (int e = 0; e < 4; ++e) if (e != i0 && es[e] > m1) { m1 = es[e]; i1 = e; }
            const float e1 = __expf(m1 - m0); const float w0 = 1.f / (1.f + e1), w1 = e1 / (1.f + e1);
            const int ea = i0 < i1 ? i0 : i1, eb = i0 < i1 ? i1 : i0; const float ga = psel * (i0 < i1 ? w0 : w1), gb = psel * (i0 < i1 ? w1 : w0);
            const int lt = t0 + lane; clsL[lt] = gs * 6 + pair_index(ea, eb); fL[lt] = ga; fL[tpb + lt] = gb; fL[2 * tpb + lt] = pg8::rstd_from_ssq(ssq, tok); }
        LDS_WAIT(); }
    __syncthreads();
    if (F.tid < tpb) { const int c = clsL[F.tid]; int rank = 0; for (int t = 0; t < F.tid; ++t) rank += (clsL[t] == c) ? 1 : 0;
        tokinfo[F.bx * tpb + F.tid] = (u32x4){(unsigned)c | ((unsigned)rank << 8), __float_as_uint(fL[F.tid]), __float_as_uint(fL[tpb + F.tid]), __float_as_uint(fL[2 * tpb + F.tid])}; }
    if (F.tid >= 256 && F.tid < 256 + 32) { const int c = F.tid - 256; int n = 0; if (c < NCLS) for (int t = 0; t < tpb; ++t) n += (clsL[t] == c) ? 1 : 0; cntb[F.bx * 32 + c] = n; }
}
__device__ __forceinline__ void phase_router2(Frame& F, int l) {
    unsigned char* ws = F.ws; const u32x4* tokinfo = (const u32x4*)(ws + WS_TOKINFO); const int* cntb = (const int*)(ws + WS_CNTB);
    int* tokl = (int*)(ws + WS_SLOT); float* gwa = (float*)(ws + WS_SLOT + SLOT_ARR); float* gwb = (float*)(ws + WS_SLOT + 2 * SLOT_ARR); float* rsl = (float*)(ws + WS_SLOT + 3 * SLOT_ARR);
    const int tpb = NTOK / F.G; LAS int* baseL = (LAS int*)(F.lds + SCR_OFF);
    { const int c = F.tid & 31, part = F.tid >> 5; int acc = 0; for (int b2 = part; b2 < F.bx; b2 += 16) acc += cntb[b2 * 32 + c];
      ((LAS int*)(F.lds + SCR_OFF + 1024))[part * 32 + c] = acc; }
    __syncthreads();
    if (F.tid < 32) { int acc = 0;
#pragma unroll
        for (int part = 0; part < 16; ++part) acc += ((LAS int*)(F.lds + SCR_OFF + 1024))[part * 32 + F.tid]; baseL[F.tid] = acc;
        if (F.bx == F.G - 1 && F.tid < NCLS) F.ctl[CW_CNT + l * 32 + F.tid] = (unsigned)(acc + cntb[F.bx * 32 + F.tid]); }
    __syncthreads();
    if (F.tid < tpb) { const int tok = F.bx * tpb + F.tid; const u32x4 inf = tokinfo[tok]; const int cls = inf.x & 255, rank = inf.x >> 8;
        const size_t o = (size_t)cls * CLSCAP + baseL[cls] + rank; tokl[o] = tok; gwa[o] = __uint_as_float(inf.y); gwb[o] = __uint_as_float(inf.z); rsl[o] = __uint_as_float(inf.w); }
}

__device__ __forceinline__ const char* uni_ptr(const char* p) { const unsigned long long v = (unsigned long long)p; const unsigned lo = __builtin_amdgcn_readfirstlane((unsigned)v), hi = __builtin_amdgcn_readfirstlane((unsigned)(v >> 32)); return (const char*)(((unsigned long long)hi << 32) | lo); }
struct SchedMoe {
    const LAS int* tb; const unsigned* cnt; const char* A; const char* B; const int* tokl; int ncol, G, c, nwg; bool up; int eb;
    __device__ __forceinline__ bool next(int i, pg8::Unit& u) const {
        const long L = (long)i * G + c; if (L >= nwg) return false;
        const int id = pg8::xcd_remap((int)L, nwg); const int rt = id / ncol, ct = id % ncol;
        int cls = 0;
#pragma unroll 1
        for (int k = 1; k < NCLS; ++k) if (rt >= tb[k]) cls = k;
        const int slot0 = (rt - tb[cls]) * 256; const int g = cls / 6, pr = cls % 6;
        const int ea = pr < 3 ? 0 : (pr < 5 ? 1 : 2), eb = pr < 3 ? pr + 1 : (pr < 5 ? pr - 1 : 3);
        u.pm = rt; u.pn = ct; u.cls = cls; u.slot0 = slot0; u.nvalid = (int)cnt[cls] - slot0; u.rows = tokl + (size_t)cls * CLSCAP + slot0;
        if (up) { const int ge = g * 4 + (ct < 4 ? ea : eb); u.a = A; u.b = B + ((size_t)ge * 1024 + (ct & 3) * 256) * (size_t)(D * this->eb); }
        else { u.a = A + (size_t)rt * 256 * 1024 * this->eb; u.b = B + ((size_t)cls * 1024 + ct * 256) * (size_t)(1024 * this->eb); }
        u.a = uni_ptr(u.a); u.b = uni_ptr(u.b); u.rows = (const int*)uni_ptr((const char*)u.rows);
        u.pm = __builtin_amdgcn_readfirstlane(u.pm); u.pn = __builtin_amdgcn_readfirstlane(u.pn); u.cls = __builtin_amdgcn_readfirstlane(u.cls); u.slot0 = __builtin_amdgcn_readfirstlane(u.slot0); u.nvalid = __builtin_amdgcn_readfirstlane(u.nvalid);
        return true;
    }
};

__global__ void __launch_bounds__(NTHREADS, 2) hyb_fwd(Args args) {
    extern __shared__ __attribute__((aligned(16))) unsigned char lds[];
    Frame F;
    F.lds = (LAS unsigned char*)lds; F.MISC = (volatile LAS unsigned*)(F.lds + MISC_OFF);
    F.tid = threadIdx.x; F.lane = F.tid & 63; F.wave = __builtin_amdgcn_readfirstlane(F.tid >> 6); F.G = gridDim.x; F.bx = blockIdx.x;
    F.ws = args.ws; F.ctl = (unsigned*)(args.ws + WS_CTL); F.out = args.out;
    for (int u = F.tid; u < (PTAB_OFF - LDSCTL_OFF) / 4; u += NTHREADS) ((LAS unsigned*)(F.lds + LDSCTL_OFF))[u] = 0u;
    if (F.tid == 0) {
#pragma unroll
        for (int i = 0; i < 26; ++i) ((LAS unsigned long long*)(F.lds + PTAB_OFF))[i] = (unsigned long long)args.in[i]; }
    __syncthreads();
    XcdBarrier bar; bar.bar = F.ctl + CW_BAR; bar.x = 0; bar.st = nullptr;
    const bool one_launch = (args.ph_hi - args.ph_lo) > 1;
    if (one_launch) bar = xcd_barrier_post(F.ctl + CW_BAR, F.MISC + 8);
    const int wave0 = __builtin_amdgcn_readfirstlane((int)threadIdx.x >> 6);
    for (int ph = args.ph_lo; ph < args.ph_hi; ++ph) {
        {
          GAS unsigned char* w_ = (GAS unsigned char*)args.ws; asm volatile("" : "+s"(w_)); F.ws = (unsigned char*)w_; F.ctl = (unsigned*)(F.ws + WS_CTL);
          GAS float* o_ = (GAS float*)args.out; asm volatile("" : "+s"(o_)); F.out = (float*)o_;
          unsigned lb_ = 0; asm volatile("" : "+s"(lb_)); F.lds = (LAS unsigned char*)lds + lb_; F.MISC = (volatile LAS unsigned*)(F.lds + MISC_OFF);
          int g_ = gridDim.x, b_ = blockIdx.x; asm volatile("" : "+s"(g_), "+s"(b_)); F.G = g_; F.bx = b_; }
        unsigned char* ws = F.ws;
        bf16* xb = (bf16*)(ws + WS_XB); float* ssq = (float*)(ws + WS_SSQ);
        const int l = ph / PH_PER_LAYER, p = ph % PH_PER_LAYER;
#define PH_BEGIN() do { int wv_ = wave0; unsigned z_ = 0u; asm volatile("" : "+s"(wv_), "+s"(z_)); F.lane = (int)__builtin_amdgcn_mbcnt_hi(~0u, __builtin_amdgcn_mbcnt_lo(~0u, z_)); F.wave = wv_; F.tid = wv_ * 64 + F.lane; } while (0)
        if (ph == PH_FINAL) {
            PH_BEGIN();
            const float* g = F.in_(25); const int gw = F.bx * NWAVES + F.wave, NGW = F.G * NWAVES;
            for (int m = gw; m < NTOK; m += NGW) { const u32x4* xr = (const u32x4*)(xb + (size_t)m * D) + F.lane; float v[16]; float s_ = 0.f;
#pragma unroll
                for (int j = 0; j < 2; ++j) { const u32x4 q_ = xr[64 * j]; v[8 * j] = bflo(q_.x); v[8 * j + 1] = bfhi(q_.x); v[8 * j + 2] = bflo(q_.y); v[8 * j + 3] = bfhi(q_.y); v[8 * j + 4] = bflo(q_.z); v[8 * j + 5] = bfhi(q_.z); v[8 * j + 6] = bflo(q_.w); v[8 * j + 7] = bfhi(q_.w); }
#pragma unroll
                for (int e = 0; e < 16; ++e) s_ += v[e] * v[e];
                const float r = rsqrtf(wave_sum(s_) * (1.0f / D) + EPS);
#pragma unroll
                for (int j = 0; j < 2; ++j) { const f32x4 g0 = ((const f32x4*)g)[128 * j + 2 * F.lane], g1 = ((const f32x4*)g)[128 * j + 2 * F.lane + 1]; f32x4* op = (f32x4*)(F.out + (size_t)m * D) + 128 * j + 2 * F.lane;
                    op[0] = (f32x4){v[8 * j] * r * g0[0], v[8 * j + 1] * r * g0[1], v[8 * j + 2] * r * g0[2], v[8 * j + 3] * r * g0[3]}; op[1] = (f32x4){v[8 * j + 4] * r * g1[0], v[8 * j + 5] * r * g1[1], v[8 * j + 6] * r * g1[2], v[8 * j + 7] * r * g1[3]}; } }
        } else if (p == 0) {
            PH_BEGIN(); phase_convert(F, l);
        } else if (p == 1) {
            PH_BEGIN();
            const bool gates_first = ((xb_xcc_id() & 1u) == 0u);
            if (l > 0 && gates_first) phase_gates(F);
            { pg8::SchedInKv S; S.A = (const char*)xb; S.B = (const char*)(ws + WS_WIN); S.A2 = (const char*)(ws + WS_MEMB); S.B2 = (const char*)(ws + WS_WMKV); S.G = F.G; S.c = F.bx; S.tstep = (size_t)256 * D * 2;
              S.ncol = l > 0 ? 14 : 15; S.nkv = l > 0 ? 0 : 128;
              pg8::EpiScaleBf16 E{(bf16*)(ws + WS_PROJ), NPROJ, ssq, nullptr, (float*)(ws + WS_GATES), 14, (bf16*)(ws + WS_KV), 2048, (const float*)(ws + WS_MEMR)};
              pg8::gemm_phase<pg8::EpiScaleBf16, pg8::SchedInKv, false>(F.lds, F.tid, D, S, E); }
            if (l > 0 && !gates_first) { __syncthreads(); phase_gates(F); }
        } else if (p == 2) {
            PH_BEGIN(); phase_mixer(F, l, l, args.mode);
        } else if (p == 3) {
            PH_BEGIN(); phase_ml_scan(F);
        } else if (p == 4) {
            PH_BEGIN();
            X3Pf pf; x3_load(F, F.bx, pf);
            for (int it = F.bx; it < 1024; it += F.G) { Frame G = F;
                { int t_ = F.wave * 64 + pg8::lane_fresh(); G.tid = t_; G.lane = t_ & 63; G.wave = __builtin_amdgcn_readfirstlane(t_ >> 6);
                  unsigned lb_ = 0; asm volatile("" : "+s"(lb_)); G.lds = F.lds + lb_;
                  GAS unsigned char* w_ = (GAS unsigned char*)F.ws; asm volatile("" : "+s"(w_)); G.ws = (unsigned char*)w_; }
                ml_x3(G, l, it, pf, (it + F.G < 1024) ? it + F.G : -1); }
        } else if (p == 5 || p == 8) {
            PH_BEGIN();
            if (p == 8 && F8_MO) { pg8::SchedDense S; S.init(ws + WS_O, ws + WS_WMO, NTOK, D, D / 2, F.G, F.bx);
                pg8::EpiRes<false, true> E{xb, ssq, args.mode == 2};
                pg8::gemm_phase<pg8::EpiRes<false, true>, pg8::SchedDense, false, true>(F.lds, F.tid, D / 2, S, E); }
            else { pg8::SchedDense S; S.init(p == 5 ? ws + WS_Y : ws + WS_O, p == 5 ? ws + WS_WOUT : ws + WS_WMO, NTOK, D, D, F.G, F.bx);
                pg8::EpiRes<false> E{xb, ssq, args.mode == 2, (p == 5 && F8_Q) ? ws + WS_XQ8 : nullptr};
                pg8::gemm_phase<pg8::EpiRes<false>, pg8::SchedDense, false>(F.lds, F.tid, D, S, E); }
        } else if (p == 6) {
            PH_BEGIN();
            if (F8_Q) { pg8::SchedDense S; S.init(ws + WS_XQ8, ws + WS_WMQ, NTOK, D, D / 2, F.G, F.bx);
                pg8::EpiScaleBf16 E{(bf16*)(ws + WS_Q), D, ssq, nullptr, nullptr, 1 << 30, nullptr, 0, nullptr, 1.0f / F8_WSCALE};
                pg8::gemm_phase<pg8::EpiScaleBf16, pg8::SchedDense, false, true>(F.lds, F.tid, D / 2, S, E); }
            else { pg8::SchedDense S; S.init(xb, ws + WS_WMQ, NTOK, D, D, F.G, F.bx);
                pg8::EpiScaleBf16 E{(bf16*)(ws + WS_Q), D, ssq, nullptr, nullptr, 1 << 30, nullptr, 0, nullptr};
                pg8::gemm_phase<pg8::EpiScaleBf16, pg8::SchedDense, false>(F.lds, F.tid, D, S, E); }
        } else if (p == 7) {
            PH_BEGIN(); phase_xattn2(F);
        } else if (p == 9) {
            PH_BEGIN(); phase_router1(F, l);
        } else if (p == 10) {
            PH_BEGIN(); phase_router2(F, l);
        } else {
            PH_BEGIN();
            LAS int* tb = (LAS int*)(F.lds + SCR_OFF); const unsigned* cnt = F.ctl + CW_CNT + l * 32;
            __syncthreads();
            if (F.tid == 0) { int acc = 0; for (int k = 0; k < NCLS; ++k) { tb[k] = acc; acc += ((int)__hip_atomic_load(cnt + k, RLX_AGENT) + 255) >> 8; } tb[NCLS] = acc; }
            __syncthreads();
            SchedMoe S; S.tb = tb; S.cnt = cnt; S.tokl = (const int*)(ws + WS_SLOT); S.G = F.G; S.c = F.bx; S.up = (p == 11);
            const bool f8 = layer_f8(l); S.eb = f8 ? 1 : 2;
            if (p == 11) { S.ncol = 8; S.nwg = tb[NCLS] * 8; S.A = f8 ? (const char*)(ws + WS_XQ8) : (const char*)xb; S.B = (const char*)(ws + WS_W13);
                if (f8) { pg8::EpiMoe1<true> E{(bf16*)(ws + WS_HID), (const float*)(ws + WS_SLOT + 3 * SLOT_ARR), (const float*)(ws + WS_SLOT + SLOT_ARR), (const float*)(ws + WS_SLOT + 2 * SLOT_ARR)};
                    pg8::gemm_phase<pg8::EpiMoe1<true>, SchedMoe, true, true>(F.lds, F.tid, D / 2, S, E); }
                else { pg8::EpiMoe1<false> E{(bf16*)(ws + WS_HID), (const float*)(ws + WS_SLOT + 3 * SLOT_ARR), (const float*)(ws + WS_SLOT + SLOT_ARR), (const float*)(ws + WS_SLOT + 2 * SLOT_ARR)};
                    pg8::gemm_phase<pg8::EpiMoe1<false>, SchedMoe, true, false>(F.lds, F.tid, D, S, E); } }
            else { S.ncol = 4; S.nwg = tb[NCLS] * 4; S.A = (const char*)(ws + WS_HID); S.B = (const char*)(ws + WS_W2C);
                if (f8) { pg8::EpiRes<true, true> E{xb, ssq, args.mode == 2}; pg8::gemm_phase<pg8::EpiRes<true, true>, SchedMoe, false, true>(F.lds, F.tid, 512, S, E); }
                else { pg8::EpiRes<true, false> E{xb, ssq, args.mode == 2}; pg8::gemm_phase<pg8::EpiRes<true, false>, SchedMoe, false, false>(F.lds, F.tid, 1024, S, E); }
                if (l + 1 < DEPTH) {
                    pg8::SchedKv K; K.A2 = (const char*)(ws + WS_MEMB8); K.B2 = (const char*)(ws + (((l + 1) & 1) ? WS_WMKV2 : WS_WMKV)); K.G = F.G; K.c = F.bx; K.tstep = (size_t)256 * D;
                    pg8::EpiScaleBf16 EK{nullptr, 0, ssq, nullptr, nullptr, 14, (bf16*)(ws + WS_KV), 2048, (const float*)(ws + WS_MEMR), 1.0f / F8_WSCALE};
                    int t2 = F.tid; asm volatile("" : "+v"(t2));
                    pg8::gemm_phase<pg8::EpiScaleBf16, pg8::SchedKv, false, true>(F.lds, t2, D / 2, K, EK); } }
            __syncthreads();
        }
        if (ph + 1 < args.ph_hi) xcd_barrier(bar);
    }
}

extern "C" void kernel_launch(void* const* d_in, const int* in_sizes, int n_in, void* d_out, int out_size, void* d_ws, size_t ws_size, hipStream_t stream) {
    static int grid = 0;
    if (grid == 0) {
        if (n_in != 26 || in_sizes[0] != NTOK * D || out_size != NTOK * D || ws_size < WS_END) { fprintf(stderr, "kernel_launch: unexpected shapes (n_in %d, in0 %d, out %d, ws %zu, need %zu); nothing launched\n", n_in, n_in > 0 ? in_sizes[0] : -1, out_size, ws_size, (size_t)WS_END); grid = -1; return; }
        int dev = 0, cus = 0;
        if (hipGetDevice(&dev) != hipSuccess || hipDeviceGetAttribute(&cus, hipDeviceAttributeMultiprocessorCount, dev) != hipSuccess) { grid = -1; return; }
        if (hipFuncSetAttribute((const void*)hyb_fwd, hipFuncAttributeMaxDynamicSharedMemorySize, LDS_BYTES) != hipSuccess) { fprintf(stderr, "kernel_launch: hipFuncSetAttribute failed\n"); grid = -1; return; }
        int per_cu = 0;
        if (hipOccupancyMaxActiveBlocksPerMultiprocessor(&per_cu, (const void*)hyb_fwd, NTHREADS, LDS_BYTES) != hipSuccess || per_cu < 1) fprintf(stderr, "kernel_launch: occupancy query reports %d\n", per_cu);
        (void)hipGetLastError();
        grid = cus >= 256 ? 256 : (cus >= 128 ? 128 : 64);
    }
    if (grid < 0) return;
    (void)hipMemsetAsync((char*)d_ws + WS_CTL, 0, CTL_ZERO_BYTES, stream);
    Args a{};
    for (int i = 0; i < 26; ++i) a.in[i] = (const float*)d_in[i];
    a.out = (float*)d_out; a.ws = (unsigned char*)d_ws;
#if MK_N_LAUNCHES == 1
    a.ph_lo = 0; a.ph_hi = N_PHASES;
    hipLaunchKernelGGL(hyb_fwd, dim3(grid), dim3(NTHREADS), LDS_BYTES, stream, a);
#else
    for (int ph = 0; ph < N_PHASES; ++ph) {
        a.ph_lo = ph; a.ph_hi = ph + 1; hipLaunchKernelGGL(hyb_fwd, dim3(grid), dim3(NTHREADS), LDS_BYTES, stream, a);
        if (MK_REPEAT_P >= 0 && ph != PH_FINAL && ph % PH_PER_LAYER == MK_REPEAT_P) {
            if (MK_REPEAT_P == 2) (void)hipMemsetD32Async((hipDeviceptr_t)((char*)d_ws + WS_CTL + (CW_Q + ph / PH_PER_LAYER) * 4), MK_PROBE_QSTART, 1, stream);
            a.mode = MK_PROBE_MODE; hipLaunchKernelGGL(hyb_fwd, dim3(grid), dim3(NTHREADS), LDS_BYTES, stream, a); a.mode = 0; } }
#endif
}
```

```cpp
#include <hip/hip_runtime.h>
#include <cstdio>
#include <cstdint>

#ifndef MK_N_LAUNCHES
#define MK_N_LAUNCHES 1
#endif

#ifndef MK_PROBE_QSTART
#define MK_PROBE_QSTART 0
#endif
#ifndef MK_PROBE_MODE
#define MK_PROBE_MODE 0
#endif
#ifndef MK_REPEAT_P
#define MK_REPEAT_P (-1)
#endif
#define LAS __attribute__((address_space(3)))
#define GAS __attribute__((address_space(1)))
typedef unsigned short bf16;
typedef short bf16x8 __attribute__((ext_vector_type(8)));
typedef float f32x4 __attribute__((ext_vector_type(4)));
typedef float f32x2 __attribute__((ext_vector_type(2)));
typedef unsigned u32x4 __attribute__((ext_vector_type(4)));
typedef unsigned u32x2 __attribute__((ext_vector_type(2)));

constexpr int D = 1024, BATCH = 16, SEQ = 2048, DEPTH = 4, NTOK = BATCH * SEQ, MEML = 256, NMEM = BATCH * MEML;
constexpr int MLH = 4, DH = 128, MLW = 512, DIN = 3592, NPROJ = 3584, NINP = 3840;
constexpr int XAH = 4, XAD = 256, NG = 4, NE = 4, DEXP = 512, NCLS = 24, CLSCAP = NTOK;
constexpr float EPS = 1e-6f;
constexpr int NWAVES = 8, NTHREADS = 512;
constexpr int PH_PER_LAYER = 13, PH_FINAL = DEPTH * PH_PER_LAYER, N_PHASES = PH_FINAL + 1;

constexpr size_t MiB = 1u << 20;
constexpr size_t WS_CTL = 0, CTL_ZERO_BYTES = 64 * 1024;
constexpr size_t WS_WR = 1 * MiB;
constexpr size_t WS_WIN = 2 * MiB;
constexpr size_t WS_WOUT = WS_WIN + (size_t)NINP * D * 2;
constexpr size_t WS_WMQ = WS_WOUT + 2 * MiB;
constexpr size_t WS_WMKV = WS_WMQ + 2 * MiB;
constexpr size_t WS_WMO = WS_WMKV + 4 * MiB;
constexpr size_t WS_W13 = WS_WMO + 2 * MiB;
constexpr size_t WS_W2C = WS_W13 + 32 * MiB;
constexpr size_t WS_XB = WS_W2C + 48 * MiB;
constexpr size_t WS_SSQ = WS_XB + 64 * MiB;
constexpr size_t WS_MEMB = WS_SSQ + 2 * MiB;
constexpr size_t WS_MEMR = WS_MEMB + 8 * MiB;
constexpr size_t WS_TOKINFO = WS_MEMR + 64 * 1024, WS_CNTB = WS_MEMR + 640 * 1024;
constexpr size_t WS_RTAB = WS_MEMR + 704 * 1024;
constexpr size_t WS_KV = WS_MEMR + 1 * MiB;
constexpr size_t WS_GATES = WS_KV + 16 * MiB;
constexpr size_t WS_Y = WS_GATES + 1 * MiB;
constexpr size_t WS_SLOT = WS_Y + 64 * MiB;
constexpr size_t SLOT_ARR = (size_t)NCLS * CLSCAP * 4;
constexpr size_t WS_PROJ = WS_SLOT + 4 * SLOT_ARR;
constexpr size_t WS_Q = WS_PROJ, WS_O = WS_PROJ + 64 * MiB, WS_HID = WS_PROJ + 128 * MiB;
constexpr size_t WS_QCV = WS_PROJ + (size_t)NTOK * NPROJ * 2;
constexpr size_t WS_KCV = WS_QCV + 32 * MiB, WS_DC = WS_KCV + 32 * MiB, WS_CPREV = WS_DC + 32 * MiB, WS_GBUF = WS_CPREV + 32 * MiB;
constexpr size_t WS_DN = WS_GBUF + 2 * MiB, WS_NPREV = WS_DN + 512 * 1024, WS_SCAL = WS_NPREV + 512 * 1024;
constexpr size_t WS_END = WS_SCAL + 64 * 1024;
constexpr size_t WS_WMKV2 = WS_W13 + 16 * MiB;
constexpr size_t WS_MEMB8 = WS_WMKV2 + 4 * MiB;
constexpr size_t WS_XQ8 = WS_QCV;
static_assert(WS_HID + (size_t)(128 + NCLS) * 256 * 1024 * 2 <= WS_END, "hidden overlay fits in proj");
constexpr int CW_TMO = 0, CW_CODE = 1, CW_BAR = 4096, CW_CNT = 8192, CW_CVQ = 8192 + 200, CW_Q = 8192 + 256;

constexpr int LDS_BYTES = 163840;
constexpr int RING_BYTES = 131072, SCR_OFF = RING_BYTES, LDSCTL_OFF = LDS_BYTES - 1024, MISC_OFF = LDSCTL_OFF + 320, PTAB_OFF = LDSCTL_OFF + 512;

#define RLX_AGENT __ATOMIC_RELAXED, __HIP_MEMORY_SCOPE_AGENT
typedef _Float16 f16x2 __attribute__((ext_vector_type(2)));
typedef _Float16 f16x8 __attribute__((ext_vector_type(8)));
__device__ __forceinline__ unsigned f2bf(float f) { return (unsigned)__builtin_bit_cast(unsigned short, (_Float16)f); }
__device__ __forceinline__ unsigned pk2(float lo, float hi) { const f32x2 v = {lo, hi}; return __builtin_bit_cast(unsigned, __builtin_convertvector(v, f16x2)); }
__device__ __forceinline__ float bf2f(unsigned short b) { return (float)__builtin_bit_cast(_Float16, b); }
__device__ __forceinline__ float bflo(unsigned w) { return (float)__builtin_bit_cast(_Float16, (unsigned short)(w & 0xffffu)); }
__device__ __forceinline__ float bfhi(unsigned w) { return (float)__builtin_bit_cast(_Float16, (unsigned short)(w >> 16)); }
#define DPPF(old_, src_, ctrl_, rm_) __builtin_bit_cast(float, __builtin_amdgcn_update_dpp(__builtin_bit_cast(int, (float)(old_)), __builtin_bit_cast(int, (float)(src_)), (ctrl_), (rm_), 0xF, false))
__device__ __forceinline__ float wave_sum(float v) {
    v += DPPF(0.f, v, 0xB1, 0xF); v += DPPF(0.f, v, 0x4E, 0xF); v += DPPF(0.f, v, 0x141, 0xF); v += DPPF(0.f, v, 0x140, 0xF);
    v += DPPF(0.f, v, 0x142, 0xA); v += DPPF(0.f, v, 0x143, 0xC);
    return __builtin_bit_cast(float, __builtin_amdgcn_readlane(__builtin_bit_cast(int, v), 63));
}
__device__ __forceinline__ float wave_max(float v) {
    v = fmaxf(v, DPPF(v, v, 0xB1, 0xF)); v = fmaxf(v, DPPF(v, v, 0x4E, 0xF)); v = fmaxf(v, DPPF(v, v, 0x141, 0xF)); v = fmaxf(v, DPPF(v, v, 0x140, 0xF));
    v = fmaxf(v, DPPF(v, v, 0x142, 0xA)); v = fmaxf(v, DPPF(v, v, 0x143, 0xC));
    return __builtin_bit_cast(float, __builtin_amdgcn_readlane(__builtin_bit_cast(int, v), 63));
}
__device__ __forceinline__ float xor16_sum(float x) { auto s = __builtin_amdgcn_permlane16_swap(__float_as_uint(x), __float_as_uint(x), false, false); return __uint_as_float(s[0]) + __uint_as_float(s[1]); }
__device__ __forceinline__ float xor32_sum(float x) { auto t = __builtin_amdgcn_permlane32_swap(__float_as_uint(x), __float_as_uint(x), false, false); return __uint_as_float(t[0]) + __uint_as_float(t[1]); }
__device__ __forceinline__ float bperm(int srclane, float v) { return __builtin_bit_cast(float, __builtin_amdgcn_ds_bpermute(srclane << 2, __builtin_bit_cast(int, v))); }
__device__ __forceinline__ float softplusf(float z) { return fmaxf(z, 0.f) + 0.6931471805599453f * __builtin_amdgcn_logf(1.0f + __builtin_amdgcn_exp2f(-1.4426950408889634f * fabsf(z))); }
__device__ __forceinline__ float siluf(float a) { return a * __builtin_amdgcn_rcpf(1.f + __builtin_amdgcn_exp2f(-1.4426950408889634f * a)); }
__device__ __forceinline__ float sigmf(float a) { return __builtin_amdgcn_rcpf(1.f + __builtin_amdgcn_exp2f(-1.4426950408889634f * a)); }

namespace pg8 {
constexpr int BM = 256, BK = 64, HALF = 128, HTB = HALF * BK * 2, STAGE_BYTES = 8 * HTB, NXCD = 8, WGM = 8;
__host__ __device__ __forceinline__ int lds_byte(int r, int c) { const int st = (r >> 4) * 2 + (c >> 5), rr = r & 15, cc = c & 31, ob = rr * 64 + cc * 2; return st * 1024 + (ob ^ (((ob >> 9) & 1) << 5)); }
__host__ __device__ __forceinline__ void stage_rc(int b, int& R, int& C) { const int st = b / 1024, sb = b % 1024, swz = sb ^ (((sb >> 9) & 1) << 5); R = (st >> 1) * 16 + swz / 64; C = (st & 1) * 32 + (swz % 64) / 2; }
__host__ __device__ __forceinline__ int perm32(int rho) { const int n = rho >> 4, i = rho & 15; return 8 * (i >> 2) + 4 * n + (i & 3); }

struct Unit { int pm, pn; const char* a; const char* b; const int* rows; int nvalid; int cls; int slot0; };

__device__ __forceinline__ unsigned cvt_pk_bf16(float lo, float hi) { return pk2(lo, hi); }
__device__ __forceinline__ int lane_fresh() { int l; asm volatile("v_mbcnt_lo_u32_b32 %0, -1, 0\n\tv_mbcnt_hi_u32_b32 %0, -1, %0" : "=v"(l)); return l; }
#ifndef FP8_FROM
#define FP8_FROM 0
#endif
#ifndef F8_MO
#define F8_MO 1
#endif
#ifndef F8_Q
#define F8_Q 1
#endif
static_assert(FP8_FROM == 0, "WS_WMKV2 lives in the half of WS_W13 that only the fp8 expert weights leave free");
constexpr float F8_WSCALE = 64.0f, F8_HSCALE = 16.0f;
__device__ __forceinline__ float f8clamp(float x) { return __builtin_amdgcn_fmed3f(x, -448.0f, 448.0f); }
__device__ __forceinline__ unsigned f8x4(float a, float b, float c, float d) { int v = __builtin_amdgcn_cvt_pk_fp8_f32(f8clamp(a), f8clamp(b), 0, false); v = __builtin_amdgcn_cvt_pk_fp8_f32(f8clamp(c), f8clamp(d), v, true); return (unsigned)v; }
__device__ __forceinline__ bool layer_f8(int l) { return FP8_FROM <= 0 ? true : (FP8_FROM >= DEPTH ? false : l >= FP8_FROM); }

__device__ __forceinline__ int xcd_remap(int L, int nwg) { const int q = nwg / NXCD, r = nwg % NXCD, xcd = L % NXCD, off = L / NXCD; return (xcd < r ? xcd * (q + 1) : r * (q + 1) + (xcd - r) * q) + off; }

struct SchedInKv {
    const char* A; const char* B; const char* A2; const char* B2; int G, c; size_t tstep; int ncol, nkv;
    __device__ __forceinline__ bool next(int i, Unit& u) const {
        const int nin = 128 * ncol;
        const long L = (long)i * G + c; if (L >= nin + nkv) return false;
        u.rows = nullptr; u.nvalid = 256; u.slot0 = 0;
        if (L < nin) { const int wgid = xcd_remap((int)L, nin); const int nig = WGM * ncol, gid = wgid / nig, fm = gid * WGM;
            u.pm = fm + ((wgid % nig) % WGM); u.pn = (wgid % nig) / WGM; u.a = A + (size_t)u.pm * tstep; u.b = B + (size_t)u.pn * tstep; u.cls = 0; }
        else { const int id = (int)L - nin; u.pm = id >> 3; u.pn = id & 7; u.a = A2 + (size_t)u.pm * tstep; u.b = B2 + (size_t)u.pn * tstep; u.cls = 1; }
        return true;
    }
};
struct SchedKv {
    const char* A2; const char* B2; int G, c; size_t tstep;
    __device__ __forceinline__ bool next(int i, Unit& u) const {
        const long L = (long)i * G + (G - 1 - c); if (L >= 128) return false;
        const int id = (int)L; u.pm = id >> 3; u.pn = id & 7; u.a = A2 + (size_t)u.pm * tstep; u.b = B2 + (size_t)u.pn * tstep; u.cls = 1; u.rows = nullptr; u.nvalid = 256; u.slot0 = 0; return true;
    }
};
struct SchedDense {
    const char* A; const char* B; int nM, nN, nwg, G, c; size_t tstep;
    __device__ void init(const void* A_, const void* B_, int M, int N, int K, int G_, int c_) { A = (const char*)A_; B = (const char*)B_; nM = M / BM; nN = N / BM; nwg = nM * nN; G = G_; c = c_; tstep = (size_t)BM * K * 2; }
    __device__ __forceinline__ bool next(int i, Unit& u) const {
        const long L = (long)i * G + c; if (L >= nwg) return false;
        const int wgid = xcd_remap((int)L, nwg);
        const int nig = WGM * nN, gid = wgid / nig, fm = gid * WGM, gsz = (nM - fm) < WGM ? (nM - fm) : WGM;
        u.pm = fm + ((wgid % nig) % gsz); u.pn = (wgid % nig) / gsz;
        u.a = A + (size_t)u.pm * tstep; u.b = B + (size_t)u.pn * tstep; u.rows = nullptr; u.nvalid = 256; u.cls = 0; u.slot0 = 0; return true;
    }
};

typedef int v8i_t __attribute__((ext_vector_type(8)));
typedef int i32x4_t __attribute__((ext_vector_type(4)));
template <class Epi, class Sched, bool GATHER, bool F8 = false>
__device__ __forceinline__ void gemm_phase(LAS unsigned char* lds, const int tid, const int K, const Sched& S, const Epi& E) {
    const int wid = __builtin_amdgcn_readfirstlane(tid >> 6), lane = tid & 63, wr = wid >> 2, wc = wid & 3, fr = lane & 15, fq = lane >> 4;
    const int nt = K / BK;
    unsigned voffB[2], va[2][2]; int van[2][2];
#pragma unroll
    for (int i = 0; i < 2; ++i) { int R, C; stage_rc(tid * 16 + i * 8192, R, C); const int Rb = Epi::PERM ? ((R & ~31) + perm32(R & 31)) : R;
        voffB[i] = (unsigned)(Rb * K + C) * 2u; va[0][i] = (unsigned)(R * K + C) * 2u; va[1][i] = (unsigned)((R + HALF) * K + C) * 2u; }
    const size_t kstep = (size_t)(BK * 2);
    const size_t hstep = (size_t)HALF * K * 2;
    const unsigned ldsw = (unsigned)wid * 1024u;
    const int aoff = lds_byte(wr * 64 + fr, fq * 8), boff = lds_byte(wc * 32 + fr, fq * 8);
#define PG8_SA(b, h) (((b) * 2 + (h)) * HTB)
#define PG8_SB(b, h) ((4 + (b) * 2 + (h)) * HTB)
#define PG8_STAGEB(bufoff, gbase) do { if constexpr (F8) { const __amdgpu_buffer_rsrc_t _r = __builtin_amdgcn_make_buffer_rsrc((void*)(gbase), 0, 0x7fffffff, 0x00020000); _Pragma("unroll") for (int _i = 0; _i < 2; ++_i) \
        __builtin_amdgcn_raw_ptr_buffer_load_lds(_r, (LAS void*)(lds + (bufoff) + ldsw + _i * 8192), 16, (int)voffB[_i], 0, 0, 0); } else { _Pragma("unroll") for (int _i = 0; _i < 2; ++_i) \
        __builtin_amdgcn_global_load_lds((const unsigned*)((const char*)(gbase) + voffB[_i]), (LAS unsigned*)(lds + (bufoff) + ldsw + _i * 8192), 16, 0, 0); } } while (0)
#define PG8_STAGEA(bufoff, gbase, h) do { if constexpr (F8) { const __amdgpu_buffer_rsrc_t _r = __builtin_amdgcn_make_buffer_rsrc((void*)(gbase), 0, 0x7fffffff, 0x00020000); _Pragma("unroll") for (int _i = 0; _i < 2; ++_i) \
        __builtin_amdgcn_raw_ptr_buffer_load_lds(_r, (LAS void*)(lds + (bufoff) + ldsw + _i * 8192), 16, (int)va[h][_i], 0, 0, 0); } else { _Pragma("unroll") for (int _i = 0; _i < 2; ++_i) \
        __builtin_amdgcn_global_load_lds((const unsigned*)((const char*)(gbase) + va[h][_i]), (LAS unsigned*)(lds + (bufoff) + ldsw + _i * 8192), 16, 0, 0); } } while (0)
#define PG8_LDA(dst, b, h) do { _Pragma("unroll") for (int m = 0; m < 4; ++m) _Pragma("unroll") for (int k = 0; k < 2; ++k) dst[m][k] = *(const LAS bf16x8*)(lds + PG8_SA(b, h) + aoff + m * 2048 + k * 1024); } while (0)
#define PG8_LDB(dst, b, h) do { _Pragma("unroll") for (int n = 0; n < 2; ++n) _Pragma("unroll") for (int k = 0; k < 2; ++k) dst[n][k] = *(const LAS bf16x8*)(lds + PG8_SB(b, h) + boff + n * 2048 + k * 1024); } while (0)
#define PG8_MMA(ai, bj, At, Bt) do { __builtin_amdgcn_s_setprio(1); _Pragma("unroll") for (int m = 0; m < 4; ++m) _Pragma("unroll") for (int n = 0; n < 2; ++n) { \
        if constexpr (F8) { const v8i_t fb = __builtin_shufflevector(__builtin_bit_cast(i32x4_t, Bt[n][0]), __builtin_bit_cast(i32x4_t, Bt[n][1]), 0, 1, 2, 3, 4, 5, 6, 7), fa = __builtin_shufflevector(__builtin_bit_cast(i32x4_t, At[m][0]), __builtin_bit_cast(i32x4_t, At[m][1]), 0, 1, 2, 3, 4, 5, 6, 7); \
            acc[ai][bj][m][n] = __builtin_amdgcn_mfma_scale_f32_16x16x128_f8f6f4(fb, fa, acc[ai][bj][m][n], 0, 0, 0, 0x7f7f7f7f, 0, 0x7f7f7f7f); } \
        else { _Pragma("unroll") for (int k = 0; k < 2; ++k) acc[ai][bj][m][n] = __builtin_amdgcn_mfma_f32_16x16x32_f16(__builtin_bit_cast(f16x8, Bt[n][k]), __builtin_bit_cast(f16x8, At[m][k]), acc[ai][bj][m][n], 0, 0, 0); } } \
        __builtin_amdgcn_s_setprio(0); } while (0)
#define PG8_LDA8(dst, b, h, m0) do { _Pragma("unroll") for (int m = 0; m < 2; ++m) _Pragma("unroll") for (int k = 0; k < 2; ++k) dst[m][k] = *(const LAS bf16x8*)(lds + PG8_SA(b, h) + aoff + ((m0) + m) * 2048 + k * 1024); } while (0)
#define PG8_MMA8(ai, mm, Am, B0_, B1_) do { _Pragma("unroll") for (int bj = 0; bj < 2; ++bj) _Pragma("unroll") for (int n = 0; n < 2; ++n) { \
        const v8i_t fb = bj ? __builtin_shufflevector(__builtin_bit_cast(i32x4_t, B1_[n][0]), __builtin_bit_cast(i32x4_t, B1_[n][1]), 0, 1, 2, 3, 4, 5, 6, 7) : __builtin_shufflevector(__builtin_bit_cast(i32x4_t, B0_[n][0]), __builtin_bit_cast(i32x4_t, B0_[n][1]), 0, 1, 2, 3, 4, 5, 6, 7); \
        const v8i_t fa = __builtin_shufflevector(__builtin_bit_cast(i32x4_t, Am[0]), __builtin_bit_cast(i32x4_t, Am[1]), 0, 1, 2, 3, 4, 5, 6, 7); \
        acc[ai][bj][mm][n] = __builtin_amdgcn_mfma_scale_f32_16x16x128_f8f6f4(fb, fa, acc[ai][bj][mm][n], 0, 0, 0, 0x7f7f7f7f, 0, 0x7f7f7f7f); } } while (0)
#define PG8_PHASE8(ai, b, h) do { PG8_WAIT_L(0); PG8_BAR; __builtin_amdgcn_s_setprio(1); PG8_MMA8(ai, 0, At[0], B0, B1); PG8_SCHED; { _Pragma("unroll") for (int k = 0; k < 2; ++k) At[0][k] = *(const LAS bf16x8*)(lds + PG8_SA(b, h) + aoff + 2 * 2048 + k * 1024); } PG8_SCHED; \
        PG8_MMA8(ai, 1, At[1], B0, B1); PG8_SCHED; { _Pragma("unroll") for (int k = 0; k < 2; ++k) At[1][k] = *(const LAS bf16x8*)(lds + PG8_SA(b, h) + aoff + 3 * 2048 + k * 1024); } PG8_SCHED; \
        PG8_MMA8(ai, 2, At[0], B0, B1); PG8_MMA8(ai, 3, At[1], B0, B1); __builtin_amdgcn_s_setprio(0); PG8_WAIT_L(0); PG8_BAR; PG8_SCHED; } while (0)
#define PG8_WAIT_V(n) asm volatile("s_waitcnt vmcnt(" #n ")" ::: "memory")
#define PG8_WAIT_L(n) asm volatile("s_waitcnt lgkmcnt(" #n ")" ::: "memory")
#define PG8_BAR __builtin_amdgcn_s_barrier()
#define PG8_SCHED __builtin_amdgcn_sched_barrier(0)
#define PG8_LOADVA(u, dst) do { int _t = tid; asm volatile("" : "+v"(_t)); _Pragma("unroll") for (int _i = 0; _i < 2; ++_i) { int _R, _C; stage_rc(_t * 16 + _i * 8192, _R, _C); \
        _Pragma("unroll") for (int _h = 0; _h < 2; ++_h) { const int _s = _h * HALF + _R; \
        const int _r0 = ((const GAS int*)(u).rows)[_s < (u).nvalid ? _s : 0]; const int _r = (_s < (u).nvalid) ? _r0 : 0;     \
        dst[_h][_i] = (unsigned)(_r * K + _C) * 2u; } } } while (0)
#define PG8_LOADVA_RAW(u, raw) do { int _t = tid; asm volatile("" : "+v"(_t)); _Pragma("unroll") for (int _i = 0; _i < 2; ++_i) { int _R, _C; stage_rc(_t * 16 + _i * 8192, _R, _C); \
        _Pragma("unroll") for (int _h = 0; _h < 2; ++_h) { const int _s = _h * HALF + _R; raw[_h][_i] = ((const GAS int*)(u).rows)[_s < (u).nvalid ? _s : 0]; } } } while (0)
#define PG8_LOADVA_FIN(u, raw, dst) do { int _t = tid; asm volatile("" : "+v"(_t), "+v"(raw[0][0]), "+v"(raw[0][1]), "+v"(raw[1][0]), "+v"(raw[1][1])); _Pragma("unroll") for (int _i = 0; _i < 2; ++_i) { int _R, _C; stage_rc(_t * 16 + _i * 8192, _R, _C); \
        _Pragma("unroll") for (int _h = 0; _h < 2; ++_h) { const int _s = _h * HALF + _R; const int _r = (_s < (u).nvalid) ? raw[_h][_i] : 0; dst[_h][_i] = (unsigned)(_r * K + _C) * 2u; } } } while (0)
    Unit cur, nxt; int ui = 0;
    if (!S.next(0, cur)) return;
    f32x4 acc[2][2][4][2];
#pragma unroll
    for (int a = 0; a < 2; ++a)
#pragma unroll
        for (int b = 0; b < 2; ++b)
#pragma unroll
            for (int m = 0; m < 4; ++m)
#pragma unroll
                for (int n = 0; n < 2; ++n) acc[a][b][m][n] = (f32x4){0.f, 0.f, 0.f, 0.f};
    bf16x8 At[F8 ? 2 : 4][2], B0[2][2], B1[2][2];
    const char* cA = cur.a; const char* cB = cur.b;
    if constexpr (GATHER) { PG8_LOADVA(cur, va); }
    PG8_STAGEB(PG8_SB(0, 0), cB); PG8_STAGEB(PG8_SB(0, 1), cB + hstep); PG8_STAGEA(PG8_SA(0, 0), cA, 0); PG8_STAGEA(PG8_SA(0, 1), cA, 1);
    if (wr == 1) PG8_BAR;
    PG8_WAIT_V(2); PG8_BAR;
    PG8_STAGEB(PG8_SB(1, 0), cB + kstep); PG8_STAGEA(PG8_SA(1, 0), cA + kstep, 0); PG8_STAGEB(PG8_SB(1, 1), cB + hstep + kstep);
    PG8_WAIT_V(6); PG8_BAR;
    float rpre[8] = {0.f, 0.f, 0.f, 0.f, 0.f, 0.f, 0.f, 0.f};
    for (;;) {
        const bool has_next = S.next(ui + 1, nxt);
        const char* nA = has_next ? nxt.a : cA; const char* nB = has_next ? nxt.b : cB;
#pragma unroll 1
        for (int t = 0; t < nt; t += 2) {
            const bool last = (t == nt - 2);
            if constexpr (Epi::PRE && !F8) { if (last) E.pre(cur, wr, rpre); }
            const char* a1 = cA + (size_t)(t + 1) * kstep;
            const char* a2 = last ? nA : cA + (size_t)(t + 2) * kstep; const char* b2 = last ? nB : cB + (size_t)(t + 2) * kstep;
            const char* a3 = a2 + kstep; const char* b3 = b2 + kstep;
            if constexpr (F8) {
            PG8_LDB(B0, 0, 0); PG8_LDB(B1, 0, 1); PG8_SCHED; PG8_LDA8(At, 0, 0, 0); PG8_STAGEA(PG8_SA(1, 1), a1, 1);
            if constexpr (GATHER) { if (t == 0 && has_next) { PG8_LOADVA_RAW(nxt, van); }
                if (last && has_next) { PG8_LOADVA_FIN(nxt, van, va); } }
            PG8_WAIT_V(8); PG8_PHASE8(0, 0, 0);
            PG8_LDA8(At, 0, 1, 0); PG8_STAGEB(PG8_SB(0, 0), b2); PG8_STAGEB(PG8_SB(0, 1), b2 + hstep); PG8_STAGEA(PG8_SA(0, 0), a2, 0);
            PG8_WAIT_V(8); PG8_PHASE8(1, 0, 1);
            PG8_LDB(B0, 1, 0); PG8_LDB(B1, 1, 1); PG8_SCHED; PG8_LDA8(At, 1, 0, 0); PG8_STAGEA(PG8_SA(0, 1), a2, 1);
            PG8_WAIT_V(8); PG8_PHASE8(0, 1, 0);
            PG8_LDA8(At, 1, 1, 0); PG8_STAGEB(PG8_SB(1, 0), b3); PG8_STAGEB(PG8_SB(1, 1), b3 + hstep); PG8_STAGEA(PG8_SA(1, 0), a3, 0);
            PG8_WAIT_V(8); PG8_PHASE8(1, 1, 1);
            } else {
            PG8_LDB(B0, 0, 0); PG8_LDB(B1, 0, 1); PG8_SCHED; PG8_LDA(At, 0, 0); PG8_STAGEA(PG8_SA(1, 1), a1, 1);
            if constexpr (GATHER) { if (t == 0 && has_next) { PG8_LOADVA_RAW(nxt, van); }
                if (last && has_next) { PG8_LOADVA_FIN(nxt, van, va); } }
            PG8_WAIT_V(8); PG8_WAIT_L(0); PG8_BAR; PG8_MMA(0, 0, At, B0); PG8_MMA(0, 1, At, B1); PG8_BAR; PG8_SCHED;
            PG8_LDA(At, 0, 1); PG8_STAGEB(PG8_SB(0, 0), b2); PG8_STAGEB(PG8_SB(0, 1), b2 + hstep); PG8_STAGEA(PG8_SA(0, 0), a2, 0);
            PG8_WAIT_V(8); PG8_WAIT_L(0); PG8_BAR; PG8_MMA(1, 0, At, B0); PG8_MMA(1, 1, At, B1); PG8_BAR; PG8_SCHED;
            PG8_LDB(B0, 1, 0); PG8_LDB(B1, 1, 1); PG8_SCHED; PG8_LDA(At, 1, 0); PG8_STAGEA(PG8_SA(0, 1), a2, 1);
            PG8_WAIT_V(8); PG8_WAIT_L(0); PG8_BAR; PG8_MMA(0, 0, At, B0); PG8_MMA(0, 1, At, B1); PG8_BAR; PG8_SCHED;
            PG8_LDA(At, 1, 1); PG8_STAGEB(PG8_SB(1, 0), b3); PG8_STAGEB(PG8_SB(1, 1), b3 + hstep); PG8_STAGEA(PG8_SA(1, 0), a3, 0);
            PG8_WAIT_V(8); PG8_WAIT_L(0); PG8_BAR; PG8_MMA(1, 0, At, B0); PG8_MMA(1, 1, At, B1); PG8_BAR; PG8_SCHED;
            }
        }
        if (wr == 0) PG8_BAR;
        { Unit ce = cur; ce.pm = __builtin_amdgcn_readfirstlane(cur.pm); ce.pn = __builtin_amdgcn_readfirstlane(cur.pn); ce.cls = __builtin_amdgcn_readfirstlane(cur.cls); ce.slot0 = __builtin_amdgcn_readfirstlane(cur.slot0); ce.nvalid = __builtin_amdgcn_readfirstlane(cur.nvalid);
          asm volatile("" : "+s"(ce.pm), "+s"(ce.pn), "+s"(ce.cls), "+s"(ce.slot0), "+s"(ce.nvalid));
          if constexpr (Epi::PRE) E(acc, ce, wr, wc, fr, fq, rpre, !F8); else E(acc, ce, wr, wc, fr, fq); }
        if (!has_next) break;
#pragma unroll
        for (int a = 0; a < 2; ++a)
#pragma unroll
            for (int b = 0; b < 2; ++b)
#pragma unroll
                for (int m = 0; m < 4; ++m)
#pragma unroll
                    for (int n = 0; n < 2; ++n) acc[a][b][m][n] = (f32x4){0.f, 0.f, 0.f, 0.f};
        cur = nxt; cA = nA; cB = nB; ++ui;
        if (wr == 1) PG8_BAR;
    }
    PG8_WAIT_V(0);
    PG8_BAR;
#undef PG8_SA
#undef PG8_SB
#undef PG8_STAGEA
#undef PG8_STAGEB
#undef PG8_LDA
#undef PG8_LDB
#undef PG8_MMA
#undef PG8_WAIT_V
#undef PG8_LOADVA_RAW
#undef PG8_LOADVA_FIN
#undef PG8_LDA8
#undef PG8_MMA8
#undef PG8_PHASE8
#undef PG8_WAIT_L
#undef PG8_BAR
#undef PG8_SCHED
#undef PG8_LOADVA
}

__device__ __forceinline__ float rstd_from_ssq(const float* ssq, int row) {
    const f32x4* p = (const f32x4*)(ssq + (size_t)row * 16); const f32x4 a = p[0], b = p[1], c = p[2], d = p[3];
    const float s = ((a[0] + a[1]) + (a[2] + a[3])) + ((b[0] + b[1]) + (b[2] + b[3])) + ((c[0] + c[1]) + (c[2] + c[3])) + ((d[0] + d[1]) + (d[2] + d[3]));
    return rsqrtf(s * (1.0f / D) + EPS);
}
struct EpiScaleBf16 {
    static constexpr bool PERM = true; static constexpr bool PRE = true;
    bf16* O; int ldc; const float* ssq; const float* rtab; float* gates; int gate_pn; bf16* O2; int ldc2; const float* rtab2;
    float osc = 1.0f;
    __device__ __forceinline__ void pre(const Unit& u, int wr, float (&p)[8]) const {
        const int fr = lane_fresh() & 15; const int row0 = u.pm * BM + wr * 64 + fr; const float* tb_ = (u.cls == 1) ? rtab2 : rtab;
        if (tb_) {
#pragma unroll
            for (int i = 0; i < 8; ++i) p[i] = tb_[row0 + (i >> 2) * HALF + (i & 3) * 16]; } }
    __device__ __forceinline__ void operator()(const f32x4 (&acc)[2][2][4][2], const Unit& u, int wr, int wc, int fr, int fq, const float (&prs)[8], const bool have) const {
        { const int ln_ = lane_fresh(); fr = ln_ & 15; fq = ln_ >> 4; }
        const int row0 = u.pm * BM + wr * 64 + fr; const int col0 = u.pn * BM + wc * 32 + 8 * fq;
        float rs8[8];
        if (u.cls == 1) {
#pragma unroll
            for (int i = 0; i < 8; ++i) rs8[i] = have ? prs[i] : rtab2[row0 + (i >> 2) * HALF + (i & 3) * 16];
#pragma unroll
            for (int i = 0; i < 8; ++i) rs8[i] *= osc;
#pragma unroll
            for (int ai = 0; ai < 2; ++ai)
#pragma unroll
                for (int m = 0; m < 4; ++m) { const int row = row0 + ai * HALF + m * 16; const float rs = rs8[ai * 4 + m]; bf16* rowp = O2 + (size_t)row * ldc2 + col0;
#pragma unroll
                    for (int bj = 0; bj < 2; ++bj) { const f32x4 v0 = acc[ai][bj][m][0] * rs, v1 = acc[ai][bj][m][1] * rs; u32x4 w; w.x = cvt_pk_bf16(v0[0], v0[1]); w.y = cvt_pk_bf16(v0[2], v0[3]); w.z = cvt_pk_bf16(v1[0], v1[1]); w.w = cvt_pk_bf16(v1[2], v1[3]);
                        *(u32x4*)(rowp + bj * HALF) = w; } }
            return; }
        if (rtab) {
#pragma unroll
            for (int i = 0; i < 8; ++i) rs8[i] = have ? prs[i] : rtab[row0 + (i >> 2) * HALF + (i & 3) * 16];
        } else {
            f32x4 t[8];
#pragma unroll
            for (int i = 0; i < 8; ++i) t[i] = ((const f32x4*)(ssq + (size_t)(row0 + (i >> 2) * HALF + (i & 3) * 16) * 16))[fq];
#pragma unroll
            for (int i = 0; i < 8; ++i) { float s_ = (t[i][0] + t[i][1]) + (t[i][2] + t[i][3]); s_ = xor16_sum(s_); s_ = xor32_sum(s_); rs8[i] = rsqrtf(s_ * (1.0f / D) + EPS); }
        }
#pragma unroll
        for (int i = 0; i < 8; ++i) rs8[i] *= osc;
#pragma unroll
        for (int ai = 0; ai < 2; ++ai)
#pragma unroll
            for (int m = 0; m < 4; ++m) { const int row = row0 + ai * HALF + m * 16; const float rs = rs8[ai * 4 + m];
                if (u.pn < gate_pn) { bf16* rowp = O + (size_t)row * ldc + col0;
#pragma unroll
                    for (int bj = 0; bj < 2; ++bj) { const f32x4 v0 = acc[ai][bj][m][0] * rs, v1 = acc[ai][bj][m][1] * rs; u32x4 w; w.x = cvt_pk_bf16(v0[0], v0[1]); w.y = cvt_pk_bf16(v0[2], v0[3]); w.z = cvt_pk_bf16(v1[0], v1[1]); w.w = cvt_pk_bf16(v1[2], v1[3]);
                        *(u32x4*)(rowp + bj * HALF) = w; } }
                else if (wc == 0 && fq == 0) { *(GAS f32x4*)(gates + (size_t)row * 8) = acc[ai][0][m][0] * rs; *(GAS f32x4*)(gates + (size_t)row * 8 + 4) = acc[ai][0][m][1] * rs; } }
    }
};
template <bool SCATTER, bool F8 = false> struct EpiRes {
    static constexpr bool PERM = true; static constexpr bool PRE = false;
    bf16* xb; float* ssq; int probe; unsigned char* x8 = nullptr;
    __device__ __forceinline__ void operator()(const f32x4 (&acc)[2][2][4][2], const Unit& u, int wr, int wc, int fr, int fq) const {
        { const int ln_ = lane_fresh(); fr = ln_ & 15; fq = ln_ >> 4; }
        const int col0 = u.pn * BM + wc * 32 + 8 * fq;
        int rows[8]; bool oks[8];
#pragma unroll
        for (int i = 0; i < 8; ++i) { const int lr = wr * 64 + fr + (i >> 2) * HALF + (i & 3) * 16;
            if constexpr (SCATTER) { oks[i] = lr < u.nvalid; rows[i] = ((const GAS int*)u.rows)[oks[i] ? lr : 0]; } else { oks[i] = true; rows[i] = u.pm * BM + lr; } }
        if constexpr (SCATTER) { __builtin_amdgcn_sched_barrier(0);
#pragma unroll
            for (int i = 0; i < 8; ++i) rows[i] = oks[i] ? rows[i] : 0; }
        constexpr float ASC = F8 ? 1.0f / (F8_WSCALE * F8_HSCALE) : 1.0f;
        u32x4 oldv[4][2], wv[4][2]; u32x2 w8v[4][2]; float ssv[4];
#pragma unroll
        for (int ai = 0; ai < 2; ++ai) {
#pragma unroll
            for (int m = 0; m < 4; ++m)
#pragma unroll
                for (int bj = 0; bj < 2; ++bj) oldv[m][bj] = *(const GAS u32x4*)(xb + (size_t)rows[ai * 4 + m] * D + col0 + bj * HALF);
            if (ai == 1) {
#pragma unroll
                for (int m = 0; m < 4; ++m) { const int row = rows[m]; const bool ok = oks[m];
#pragma unroll
                    for (int bj = 0; bj < 2; ++bj) { if (ok) *(GAS u32x4*)(xb + (size_t)row * D + col0 + bj * HALF) = wv[m][bj];
                        if constexpr (!SCATTER) { if (x8) *(GAS u32x2*)(x8 + (size_t)row * D + col0 + bj * HALF) = w8v[m][bj]; } }
                    if (fq == 0 && ok) ((GAS float*)ssq)[(size_t)row * 16 + u.pn * 4 + wc] = ssv[m]; } }
#pragma unroll
            for (int m = 0; m < 4; ++m) { float ss = 0.f;
#pragma unroll
                for (int bj = 0; bj < 2; ++bj) { const u32x4 v = oldv[m][bj]; const f32x4 a0 = acc[ai][bj][m][0] * ASC, a1 = acc[ai][bj][m][1] * ASC;
                    float o[8] = {bflo(v.x), bfhi(v.x), bflo(v.y), bfhi(v.y), bflo(v.z), bfhi(v.z), bflo(v.w), bfhi(v.w)};
                    if (!probe) { o[0] += a0[0]; o[1] += a0[1]; o[2] += a0[2]; o[3] += a0[3]; o[4] += a1[0]; o[5] += a1[1]; o[6] += a1[2]; o[7] += a1[3]; }
                    ss += (o[0] * o[0] + o[1] * o[1]) + (o[2] * o[2] + o[3] * o[3]) + (o[4] * o[4] + o[5] * o[5]) + (o[6] * o[6] + o[7] * o[7]);
                    u32x4 w; w.x = cvt_pk_bf16(o[0], o[1]); w.y = cvt_pk_bf16(o[2], o[3]); w.z = cvt_pk_bf16(o[4], o[5]); w.w = cvt_pk_bf16(o[6], o[7]); wv[m][bj] = w;
                    if constexpr (!SCATTER) { if (x8) { u32x2 w8; w8.x = f8x4(o[0], o[1], o[2], o[3]); w8.y = f8x4(o[4], o[5], o[6], o[7]); w8v[m][bj] = w8; } } }
                ss = xor16_sum(ss); ssv[m] = xor32_sum(ss); }
        }
#pragma unroll
        for (int m = 0; m < 4; ++m) { const int row = rows[4 + m]; const bool ok = oks[4 + m];
#pragma unroll
            for (int bj = 0; bj < 2; ++bj) { if (ok) *(GAS u32x4*)(xb + (size_t)row * D + col0 + bj * HALF) = wv[m][bj];
                if constexpr (!SCATTER) { if (x8) *(GAS u32x2*)(x8 + (size_t)row * D + col0 + bj * HALF) = w8v[m][bj]; } }
            if (fq == 0 && ok) ((GAS float*)ssq)[(size_t)row * 16 + u.pn * 4 + wc] = ssv[m]; }
    }
};
template <bool F8 = false> struct EpiMoe1 {
    static constexpr bool PERM = true; static constexpr bool PRE = false;
    bf16* hid; const float* rs; const float* gwa; const float* gwb;
    __device__ __forceinline__ void operator()(const f32x4 (&acc)[2][2][4][2], const Unit& u, int wr, int wc, int fr, int fq) const {
        { const int ln_ = lane_fresh(); fr = ln_ & 15; fq = ln_ >> 4; }
        const float* gw = (u.pn < 4 ? gwa : gwb) + (size_t)u.cls * CLSCAP + u.slot0; const float* rsp = rs + (size_t)u.cls * CLSCAP + u.slot0;
        const int col0 = (u.pn >> 2) * 512 + (u.pn & 3) * 128 + wc * 32 + 8 * fq;
        float rs8[8], gw8[8];
#pragma unroll
        for (int i = 0; i < 8; ++i) { const int lr = wr * 64 + fr + (i >> 2) * HALF + (i & 3) * 16; rs8[i] = rsp[lr]; gw8[i] = gw[lr]; }
#pragma unroll
        for (int ai = 0; ai < 2; ++ai)
#pragma unroll
            for (int m = 0; m < 4; ++m) { const int lr = wr * 64 + fr + ai * HALF + m * 16; const float r = rs8[ai * 4 + m] * (F8 ? 1.0f / F8_WSCALE : 1.0f), ru = F8 ? r * F8_HSCALE : r, g = gw8[ai * 4 + m]; float h[8];
#pragma unroll
                for (int n = 0; n < 2; ++n)
#pragma unroll
                    for (int j = 0; j < 4; ++j) { const float a = acc[ai][0][m][n][j] * r, uu = acc[ai][1][m][n][j] * ru; h[n * 4 + j] = siluf(a) * uu * g; }
                u32x4 w; w.x = cvt_pk_bf16(h[0], h[1]); w.y = cvt_pk_bf16(h[2], h[3]); w.z = cvt_pk_bf16(h[4], h[5]); w.w = cvt_pk_bf16(h[6], h[7]);
                if constexpr (F8) { u32x2 w8; w8.x = f8x4(h[0], h[1], h[2], h[3]); w8.y = f8x4(h[4], h[5], h[6], h[7]); *(u32x2*)((unsigned char*)hid + ((size_t)u.pm * BM + lr) * 1024 + col0) = w8; }
                else *(u32x4*)(hid + ((size_t)u.pm * BM + lr) * 1024 + col0) = w; }
    }
};
}
using pg8::f8x4; using pg8::layer_f8; using pg8::F8_WSCALE; using pg8::F8_HSCALE;

#define XB_TMO      128
#define XB_XCNT(j)  (256  + 64 * (j))
#define XB_XSUB(j)  (1280 + 64 * (j))
#define XB_XGEN(j)  (2304 + 64 * (j))
#define XB_TOP      3328
#define XB_TOPGEN   3392
#define XCD_BAR_WORDS 3456
#define XB_SPIN_CAP (1u << 20)
__device__ __forceinline__ unsigned xb_ld(unsigned* p)              { return __hip_atomic_load((GAS unsigned*)p, __ATOMIC_RELAXED, __HIP_MEMORY_SCOPE_AGENT); }
__device__ __forceinline__ unsigned xb_add(unsigned* p, unsigned v) { return __hip_atomic_fetch_add((GAS unsigned*)p, v, __ATOMIC_RELAXED, __HIP_MEMORY_SCOPE_AGENT); }
__device__ __forceinline__ unsigned xb_xcc_id() { return (unsigned)__builtin_amdgcn_s_getreg((3 << 11) | 20) & 0xFu; }
#define XB_SPIN(cond, bar) do { unsigned _sp = 0; while (cond) { __builtin_amdgcn_s_sleep(1); \
    if ((++_sp & 255u) == 0u) { if (xb_ld(&(bar)[XB_TMO])) break; if (_sp > XB_SPIN_CAP) { atomicAdd(&(bar)[XB_TMO], 1u); break; } } } } while (0)
struct XcdBarrier { unsigned* bar; unsigned x; volatile LAS unsigned* st; };
__device__ __forceinline__ XcdBarrier xcd_barrier_post(unsigned* bar, volatile LAS unsigned* st) {
    XcdBarrier b; b.bar = bar; b.x = xb_xcc_id(); b.st = st;
    if (threadIdx.x == 0) (void)xb_add(&bar[XB_XCNT(b.x)], 1u);
    return b;
}
__device__ __forceinline__ void xcd_barrier_complete(unsigned* bar, unsigned x, unsigned& nloc, unsigned& nx) {
    const unsigned G = gridDim.x * gridDim.y * gridDim.z;
    unsigned sum, cnt, mine, sp = 0u;
    for (;;) {
        sum = 0u; cnt = 0u; mine = 0u;
#pragma unroll 1
        for (unsigned j = 0; j < 16; ++j) { const unsigned c = xb_ld(&bar[XB_XCNT(j)]); sum += c; cnt += (c > 0u) ? 1u : 0u; mine = (j == x) ? c : mine; }
        if (sum == G) break;
        __builtin_amdgcn_s_sleep(1);
        if ((++sp & 255u) == 0u) { if (xb_ld(&bar[XB_TMO])) break; if (sp > XB_SPIN_CAP) { atomicAdd(&bar[XB_TMO], 1u); break; } }
    }
    nloc = mine > 0u ? mine : 1u; nx = cnt > 0u ? cnt : 1u;
}
__device__ __forceinline__ void xcd_barrier(const XcdBarrier& b) {
    asm volatile("s_waitcnt vmcnt(0)" ::: "memory");
    __syncthreads();
    if (threadIdx.x == 0) {
        unsigned* bar = b.bar; asm volatile("" : "+s"(bar));
        __builtin_amdgcn_s_waitcnt(0);
        unsigned nloc = b.st[0], nx = b.st[1];
        if (nloc == 0u) { xcd_barrier_complete(bar, b.x, nloc, nx); b.st[0] = nloc; b.st[1] = nx; }
        const unsigned old = xb_add(&bar[XB_XSUB(b.x)], 1u);
        const unsigned gen = old / nloc;
        if (old + 1u == (gen + 1u) * nloc) {
            __builtin_amdgcn_fence(__ATOMIC_RELEASE, "agent");
            asm volatile("s_waitcnt vmcnt(0)" ::: "memory");
            const unsigned og = xb_add(&bar[XB_TOP], 1u);
            const unsigned tg = og / nx;
            __builtin_amdgcn_fence(__ATOMIC_ACQUIRE, "agent");
            if (og + 1u != (tg + 1u) * nx) XB_SPIN(xb_ld(&bar[XB_TOP]) < (tg + 1u) * nx, bar);
            xb_add(&bar[XB_XGEN(b.x)], 1u);
            asm volatile("s_waitcnt vmcnt(0)" ::: "memory");
        } else {
            __builtin_amdgcn_fence(__ATOMIC_ACQUIRE, "agent");
            XB_SPIN(xb_ld(&bar[XB_XGEN(b.x)]) == gen, bar);
            asm volatile("s_waitcnt vmcnt(0)" ::: "memory");
        }
    }
    __syncthreads();
}

struct Args { const float* in[26]; float* out; unsigned char* ws; int ph_lo, ph_hi, mode, pad; };
struct Frame {
    LAS unsigned char* lds; volatile LAS unsigned* MISC; unsigned* ctl; unsigned char* ws;
    int tid, lane, wave, G, bx;
    float* out;
    __device__ __forceinline__ const float* in_(int i) const { const LAS unsigned* t = (const LAS unsigned*)(lds + PTAB_OFF); const unsigned lo = __builtin_amdgcn_readfirstlane(t[2 * i]), hi = __builtin_amdgcn_readfirstlane(t[2 * i + 1]); return (const float*)(const GAS float*)(((unsigned long long)hi << 32) | lo); }
};
#define LDS_WAIT() asm volatile("s_waitcnt lgkmcnt(0)" ::: "memory")

__device__ __forceinline__ void tr_item(const float* W, int ldw, int k0, int n0, int ncols, const float* g, float cs, bf16* dst0, bf16* dst1, bf16* dst2, int ldd, LAS float* scr, int lane) {
    const int nl = lane & 31;
#pragma unroll 8
    for (int i = 0; i < 32; ++i) { const int kk = 2 * i + (lane >> 5); float v = 0.f; if (nl < ncols) v = W[(size_t)(k0 + kk) * ldw + n0 + nl] * (g ? g[k0 + kk] * cs : cs); scr[kk * 33 + nl] = v; }
    LDS_WAIT(); asm volatile("" ::: "memory");
    const int c = lane & 7;
#pragma unroll
    for (int j = 0; j < 4; ++j) { const int n = (lane >> 3) + 8 * j; const LAS float* s = scr + (8 * c) * 33 + n;
        u32x4 o; o.x = pk2(s[0 * 33], s[1 * 33]); o.y = pk2(s[2 * 33], s[3 * 33]); o.z = pk2(s[4 * 33], s[5 * 33]); o.w = pk2(s[6 * 33], s[7 * 33]);
        if (n < ncols) { *(u32x4*)(dst0 + (size_t)n * ldd + 8 * c) = o; if (dst1) *(u32x4*)(dst1 + (size_t)n * ldd + 8 * c) = o; if (dst2) *(u32x4*)(dst2 + (size_t)n * ldd + 8 * c) = o; } }
    LDS_WAIT(); asm volatile("" ::: "memory");
}
__device__ __forceinline__ void tr_item64(const float* W, int ldw, int k0, int n0, const float* g, float cs, bf16* dst0, bf16* dst1, bf16* dst2, int ldd, LAS float* scr, int lane) {
    const int r4 = lane >> 4, c4 = (lane & 15) * 4;
    f32x4 v[16]; float gs[16]; const float* gp = g ? g : W;
#pragma unroll
    for (int i = 0; i < 16; ++i) { const int kk = 4 * i + r4; v[i] = __builtin_nontemporal_load((const f32x4*)(W + (size_t)(k0 + kk) * ldw + n0 + c4));   gs[i] = gp[k0 + kk]; }
    __builtin_amdgcn_sched_barrier(0);
#pragma unroll
    for (int i = 0; i < 16; ++i) { const int kk = 4 * i + r4; const float sc = g ? gs[i] * cs : cs; *(LAS f32x4*)(scr + kk * 68 + c4) = v[i] * sc; }
    LDS_WAIT(); asm volatile("" ::: "memory");
    const int c = lane & 7;
#pragma unroll
    for (int j = 0; j < 8; ++j) { const int n = (lane >> 3) + 8 * j; const LAS float* s_ = scr + (8 * c) * 68 + n;
        u32x4 o; o.x = pk2(s_[0 * 68], s_[1 * 68]); o.y = pk2(s_[2 * 68], s_[3 * 68]); o.z = pk2(s_[4 * 68], s_[5 * 68]); o.w = pk2(s_[6 * 68], s_[7 * 68]);
        *(u32x4*)(dst0 + (size_t)n * ldd + 8 * c) = o; if (dst1) *(u32x4*)(dst1 + (size_t)n * ldd + 8 * c) = o; if (dst2) *(u32x4*)(dst2 + (size_t)n * ldd + 8 * c) = o; }
    LDS_WAIT(); asm volatile("" ::: "memory");
}
__device__ __forceinline__ void tr_item64_f8(const float* W, int ldw, int k0, int n0, const float* g, float cs, unsigned char* dst0, unsigned char* dst1, unsigned char* dst2, int ldd, LAS float* scr, int lane) {
    const int r4 = lane >> 4, c4 = (lane & 15) * 4;
    f32x4 v[16]; float gs[16]; const float* gp = g ? g : W;
#pragma unroll
    for (int i = 0; i < 16; ++i) { const int kk = 4 * i + r4; v[i] = __builtin_nontemporal_load((const f32x4*)(W + (size_t)(k0 + kk) * ldw + n0 + c4)); gs[i] = gp[k0 + kk]; }
    __builtin_amdgcn_sched_barrier(0);
#pragma unroll
    for (int i = 0; i < 16; ++i) { const int kk = 4 * i + r4; const float sc = g ? gs[i] * cs : cs; *(LAS f32x4*)(scr + kk * 68 + c4) = v[i] * sc; }
    LDS_WAIT(); asm volatile("" ::: "memory");
    const int c = lane & 7;
#pragma unroll
    for (int j = 0; j < 8; ++j) { const int n = (lane >> 3) + 8 * j; const LAS float* s_ = scr + (8 * c) * 68 + n;
        u32x2 o; o.x = f8x4(s_[0 * 68], s_[1 * 68], s_[2 * 68], s_[3 * 68]); o.y = f8x4(s_[4 * 68], s_[5 * 68], s_[6 * 68], s_[7 * 68]);
        *(u32x2*)(dst0 + (size_t)n * ldd + 8 * c) = o; if (dst1) *(u32x2*)(dst1 + (size_t)n * ldd + 8 * c) = o; if (dst2) *(u32x2*)(dst2 + (size_t)n * ldd + 8 * c) = o; }
    LDS_WAIT(); asm volatile("" ::: "memory");
}
__device__ __forceinline__ int pair_index(int a, int b) { return a == 0 ? (b - 1) : (a == 1 ? (b + 1) : 5); }

__device__ __forceinline__ void phase_convert(Frame& F, int l, const int part) {
    LAS float* scr = (LAS float*)(F.lds + F.wave * (64 * 68 * 4));
    const int gw = F.bx * NWAVES + F.wave, NGW = F.G * NWAVES, lane = F.lane;
    unsigned char* ws = F.ws;
    bf16* Win = (bf16*)(ws + WS_WIN); bf16* Wout = (bf16*)(ws + WS_WOUT); bf16* Wmq = (bf16*)(ws + WS_WMQ); bf16* Wmkv = (bf16*)(ws + WS_WMKV); bf16* Wmo = (bf16*)(ws + WS_WMO);
    bf16* W13 = (bf16*)(ws + WS_W13); bf16* W2c = (bf16*)(ws + WS_W2C);
    const float* w_in = F.in_(3) + (size_t)l * D * DIN; const float* ln_mix = F.in_(2) + l * D;
    const float* w_out = F.in_(10) + (size_t)l * D * D;
    const float* ln_mem = F.in_(11) + l * D; const float* ln_memkv = F.in_(12) + l * D;
    const float* w_mq = F.in_(13) + (size_t)l * D * D; const float* w_mk = F.in_(14) + (size_t)l * D * D; const float* w_mv = F.in_(15) + (size_t)l * D * D; const float* w_mo = F.in_(16) + (size_t)l * D * D;
    const float* ln_ffn = F.in_(17) + l * D;
    const float* w_e1 = F.in_(22) + (size_t)l * 16 * D * DEXP; const float* w_e3 = F.in_(23) + (size_t)l * 16 * D * DEXP; const float* w_e2 = F.in_(24) + (size_t)l * 16 * DEXP * D;
    constexpr int I_SEG = 128;
    constexpr int I_IN = 7 * I_SEG, I_GATE = 16, I_SQ = 256, I_E13 = 32 * I_SEG, I_E2 = 16 * 128;
    const int kvp = (l == 0) ? 2 : (l + 1 < DEPTH ? 1 : 0); const int I_SQS = (3 + 2 * kvp) * I_SQ;
    const int NITEMS = I_IN + I_GATE + I_SQS + I_E13 + I_E2;
    auto item = [&](const int it) {
        int r = it;
        if (r < I_IN) { const int seg = r / I_SEG, q = r % I_SEG, kb = q / 8, nb = q % 8;
            const int srcc = seg < 4 ? seg * 512 : 2056 + (seg - 4) * 512; const int dstr = seg * 512; const float cs = (seg == 4) ? (0.08838834764831845f * 1.4426950408889634f) : 1.0f;
            tr_item64(w_in, DIN, kb * 64, srcc + nb * 64, ln_mix, cs, Win + (size_t)(dstr + nb * 64) * D + kb * 64, nullptr, nullptr, D, scr, lane); return; }
        r -= I_IN;
        if (r < I_GATE) { tr_item(w_in, DIN, r * 64, 2048, 8, ln_mix, 1.0f, Win + (size_t)NPROJ * D + r * 64, nullptr, nullptr, D, scr, lane); return; }
        r -= I_GATE;
        if (r < I_SQS) { const int m5 = r / I_SQ, q = r % I_SQ, kb = q / 16, nb = q % 16;
            const int mat = m5 < 3 ? (m5 == 2 ? 4 : m5) : 2 + ((m5 - 3) & 1);
            const int lk = m5 < 3 ? l : ((l == 0) ? ((m5 - 3) >> 1) : l + 1);
            const float* W = mat == 0 ? w_out : mat == 1 ? w_mq : mat == 2 ? F.in_(14) + (size_t)lk * D * D : mat == 3 ? F.in_(15) + (size_t)lk * D * D : w_mo;
            const float* g = mat == 1 ? ln_mem : (mat == 2 || mat == 3) ? F.in_(12) + lk * D : nullptr;
            const float cs = (mat == 1) ? (0.0625f * 1.4426950408889634f) : 1.0f;
            bf16* Wkv = (lk & 1) ? (bf16*)(ws + WS_WMKV2) : Wmkv;
            bf16* dst = mat == 0 ? Wout : mat == 1 ? Wmq : mat == 2 ? Wkv : mat == 3 ? (Wkv + (size_t)1024 * D) : Wmo;
            if ((mat == 1 && F8_Q) || (mat == 4 && F8_MO) || ((mat == 2 || mat == 3) && lk > 0)) tr_item64_f8(W, D, kb * 64, nb * 64, g, cs * F8_WSCALE, (mat == 3 ? (unsigned char*)Wkv + (size_t)1024 * D : (unsigned char*)dst) + (size_t)(nb * 64) * D + kb * 64, nullptr, nullptr, D, scr, lane);
            else tr_item64(W, D, kb * 64, nb * 64, g, cs, dst + (size_t)(nb * 64) * D + kb * 64, nullptr, nullptr, D, scr, lane);
            return; }
        r -= I_SQS;
        if (r < I_E13) { const int mat = r / I_SEG, q = r % I_SEG, kb = q / 8, nb = q % 8; const int ge = mat >> 1, which = mat & 1;
            const float* W = (which ? w_e3 : w_e1) + (size_t)ge * D * DEXP; const int c0 = nb * 64;
            bf16* dst = W13 + ((size_t)ge * 1024 + (c0 >> 7) * 256 + which * 128 + (c0 & 127)) * D + kb * 64;
            if (layer_f8(l)) tr_item64_f8(W, DEXP, kb * 64, c0, ln_ffn, F8_WSCALE, (unsigned char*)W13 + ((size_t)ge * 1024 + (c0 >> 7) * 256 + which * 128 + (c0 & 127)) * D + kb * 64, nullptr, nullptr, D, scr, lane);
            else tr_item64(W, DEXP, kb * 64, c0, ln_ffn, 1.0f, dst, nullptr, nullptr, D, scr, lane);
            return; }
        r -= I_E13;
        { const int ge = r / 128, q = r % 128, kb = q / 16, nb = q % 16; const int g = ge >> 2, e = ge & 3;
            const float* W = w_e2 + (size_t)ge * DEXP * D; bf16* dd[3];
#pragma unroll
            for (int j = 0; j < 3; ++j) { const int o = (e + 1 + j) & 3; const int a = o < e ? o : e, b = o < e ? e : o; const int cls = g * 6 + pair_index(a, b); const int pos = (e == b) ? 1 : 0;
                dd[j] = W2c + ((size_t)cls * 1024 + nb * 64) * 1024 + pos * 512 + kb * 64; }
            if (layer_f8(l)) { unsigned char* d8[3];
#pragma unroll
                for (int j = 0; j < 3; ++j) d8[j] = (unsigned char*)W2c + (size_t)(dd[j] - W2c);
                tr_item64_f8(W, D, kb * 64, nb * 64, nullptr, F8_WSCALE, d8[0], d8[1], d8[2], 1024, scr, lane); }
            else tr_item64(W, D, kb * 64, nb * 64, nullptr, 1.0f, dd[0], dd[1], dd[2], 1024, scr, lane); }
    };
    if (part == 1) {
        volatile LAS int* qs = (volatile LAS int*)(F.lds + NWAVES * 64 * 68 * 4); const int NIT1 = NITEMS - I_E2;
        GAS unsigned* ctr = (GAS unsigned*)(F.ctl + CW_CVQ + l);
        if (F.tid == 0) qs[0] = (int)__hip_atomic_fetch_add(ctr, 8u, __ATOMIC_RELAXED, __HIP_MEMORY_SCOPE_AGENT);
        __syncthreads();
        int cur = __builtin_amdgcn_readfirstlane(qs[0]); int slot = 1;
        while (cur < NIT1) {
            int nxt = 0; if (F.tid == 0) nxt = (int)__hip_atomic_fetch_add(ctr, 8u, __ATOMIC_RELAXED, __HIP_MEMORY_SCOPE_AGENT);
            const int it = cur + F.wave; if (it < NIT1) item(it);
            if (F.tid == 0) qs[slot] = nxt;
            __syncthreads();
            cur = __builtin_amdgcn_readfirstlane(qs[slot]); slot ^= 1;
        }
    } else for (int it = gw + (part == 2 ? NITEMS - I_E2 : 0); it < NITEMS; it += NGW) item(it);
    if (part == 2) return;
    { float* wr = (float*)(ws + WS_WR); const float* w_rg = F.in_(18) + (size_t)l * D * NG; const float* w_re = F.in_(20) + (size_t)l * D * 16;
      const float* b_rg = F.in_(19) + l * NG; const float* b_re = F.in_(21) + l * 16;
      const int gt = F.bx * NTHREADS + F.tid, NT = F.G * NTHREADS;
      for (int e = gt; e < 20 * D; e += NT) { const int j = e / D, k = e % D; wr[e] = ln_ffn[k] * (j < 4 ? w_rg[k * NG + j] : w_re[k * 16 + (j - 4)]); }
      if (gt < 20) wr[20 * D + gt] = gt < 4 ? b_rg[gt] : b_re[gt - 4]; }
    if (l == 0) {
        const float* x = F.in_(0); const float* mem = F.in_(1); bf16* xb = (bf16*)(ws + WS_XB); float* ssq = (float*)(ws + WS_SSQ); bf16* memb = (bf16*)(ws + WS_MEMB); float* memr = (float*)(ws + WS_MEMR);
        constexpr int RB = 4;
        for (int m0 = gw; m0 < NTOK + NMEM; m0 += RB * NGW) {
            f32x4 v[RB][4];
#pragma unroll
            for (int r = 0; r < RB; ++r) { const int mm = m0 + r * NGW; const int m = mm < NTOK + NMEM ? mm : NTOK + NMEM - 1; const bool ism = m >= NTOK; const int row = ism ? m - NTOK : m;
                const f32x4* xr = (const f32x4*)((ism ? mem : x) + (size_t)row * D) + lane;
#pragma unroll
                for (int j = 0; j < 4; ++j) v[r][j] = xr[64 * j]; }
            __builtin_amdgcn_sched_barrier(0);
#pragma unroll
            for (int r = 0; r < RB; ++r) { const int m = m0 + r * NGW; if (m < NTOK + NMEM) { const bool ism = m >= NTOK; const int row = ism ? m - NTOK : m;
                unsigned long long* o8 = (unsigned long long*)((ism ? memb : xb) + (size_t)row * D) + lane;
                float s = 0.f;
#pragma unroll
                for (int j = 0; j < 4; ++j) { const f32x4 w = v[r][j]; s += (w[0] * w[0] + w[1] * w[1]) + (w[2] * w[2] + w[3] * w[3]); o8[64 * j] = (unsigned long long)pk2(w[0], w[1]) | ((unsigned long long)pk2(w[2], w[3]) << 32);
                    if (ism) ((unsigned*)(ws + WS_MEMB8 + (size_t)row * D))[lane + 64 * j] = f8x4(w[0], w[1], w[2], w[3]); }
                s = wave_sum(s);
                if (ism) { if (lane == 0) memr[row] = rsqrtf(s * (1.0f / D) + EPS); }
                else if (lane == 0) ((float*)(ws + WS_RTAB))[row] = rsqrtf(s * (1.0f / D) + EPS);
                else if (lane < 16) ssq[(size_t)row * 16 + lane] = lane == 0 ? s : 0.f; } }
        }
    }
}

typedef float f32x16 __attribute__((ext_vector_type(16)));
typedef short s16x4 __attribute__((ext_vector_type(4)));
namespace sbat {
constexpr int KST = 272, VST = 320, KBUF = 64 * KST, VBUF = 64 * VST, STG = KBUF + VBUF, OST = 272;
__device__ __forceinline__ f16x8 cvt8(float a, float b, float c, float d, float e, float f, float g, float h) { u32x4 w; w.x = pk2(a, b); w.y = pk2(c, d); w.z = pk2(e, f); w.w = pk2(g, h); return __builtin_bit_cast(f16x8, w); }
typedef short v4i16_t __attribute__((ext_vector_type(4)));
__device__ __forceinline__ s16x4 vtr(const LAS unsigned char* p) { return __builtin_bit_cast(s16x4, __builtin_amdgcn_ds_read_tr16_b64_v4i16((LAS v4i16_t*)p)); }
#define SB_MFMA(a, b, c) __builtin_amdgcn_mfma_f32_32x32x16_f16((a), (b), (c), 0, 0, 0)
}
__device__ __forceinline__ void sb_unit(Frame& F, int l, const int bh, const int qb) {
    using namespace sbat;
    unsigned char* ws = F.ws; const bf16* proj = (const bf16*)(ws + WS_PROJ); bf16* y = (bf16*)(ws + WS_Y); const float* sg = F.in_(9) + l * 512;
    const int tid = F.tid, lane = F.lane, w = F.wave, t32 = lane & 31, hi = lane >> 5;
    LAS unsigned char* lds = F.lds;
    f16x8 tri0, tri1, ones;
#pragma unroll
    for (int j = 0; j < 8; ++j) { const int k0 = 8 * (j >> 2) + 4 * hi + (j & 3); tri0[j] = (k0 > t32) ? (_Float16)1.0f : (_Float16)0.0f; tri1[j] = (16 + k0 > t32) ? (_Float16)1.0f : (_Float16)0.0f; ones[j] = (_Float16)1.0f; }
    {
        const int b = bh >> 2, hh = bh & 3;
        const size_t tokb = (size_t)b * SEQ; const int q0 = qb * 256, t0w = q0 + 32 * w, tg = t0w + t32;
        f16x8 qf[8];
        { const bf16* qrow = proj + (tokb + tg) * NPROJ + 2048 + hh * 128 + 8 * hi;
#pragma unroll
          for (int kk = 0; kk < 8; ++kk) qf[kk] = *(const f16x8*)(qrow + 16 * kk); }
        f32x16 O[4]; f32x16 Rv;
#pragma unroll
        for (int r = 0; r < 16; ++r) { O[0][r] = 0.f; O[1][r] = 0.f; O[2][r] = 0.f; O[3][r] = 0.f; Rv[r] = 0.f; }
        const int njt = 4 * qb + 4;
        LAS float* rmaxL = (LAS float*)(lds + 2 * STG);
        const int rowL = tid >> 4, chunk = tid & 15;
        const bf16* kg = proj + (tokb + rowL) * NPROJ + 2560 + hh * 128 + chunk * 8; const bf16* vg = kg + 512;
        const int kdst = rowL * KST + chunk * 16, vdst = KBUF + rowL * VST + chunk * 16;
        u32x4 kr0, kr1, vr0, vr1;
        { const size_t o = (size_t)(64 * (njt - 1)) * NPROJ; kr0 = *(const u32x4*)(kg + o); kr1 = *(const u32x4*)(kg + o + 32 * NPROJ); vr0 = *(const u32x4*)(vg + o); vr1 = *(const u32x4*)(vg + o + 32 * NPROJ); }
        *(LAS u32x4*)(lds + kdst) = kr0; *(LAS u32x4*)(lds + kdst + 32 * KST) = kr1; *(LAS u32x4*)(lds + vdst) = vr0; *(LAS u32x4*)(lds + vdst + 32 * VST) = vr1;
        __syncthreads();
        int cur = 0;
        for (int jt = njt - 1; jt >= 0; --jt) {
            const bool act = (64 * jt <= t0w);
            const LAS unsigned char* Kb = lds + cur * STG; const LAS unsigned char* Vb = Kb + KBUF;
            f16x8 Af[2][2];
            if (act) {
                f32x16 p0, p1;
#pragma unroll
                for (int r = 0; r < 16; ++r) { p0[r] = 0.f; p1[r] = 0.f; }
#pragma unroll
                for (int kk = 0; kk < 8; ++kk) { const f16x8 k0 = *(const LAS f16x8*)(Kb + t32 * KST + 32 * kk + 16 * hi); const f16x8 k1 = *(const LAS f16x8*)(Kb + (t32 + 32) * KST + 32 * kk + 16 * hi);
                    p0 = SB_MFMA(k0, qf[kk], p0); p1 = SB_MFMA(k1, qf[kk], p1); }
                const bool diag = (64 * jt + 63 >= t0w);
                float L0[16], L1[16];
#pragma unroll
                for (int r = 0; r < 16; ++r) { const int sl = 64 * jt + (r & 3) + 8 * (r >> 2) + 4 * hi;
                    { const float z = fminf(p0[r], 115.f); const float lg = __builtin_amdgcn_logf(1.0f + __builtin_amdgcn_exp2f(z)); float Lv = -lg, lb = z - lg; if (diag && !(sl < tg)) { Lv = 0.f; lb = -1e30f; } L0[r] = Lv; p0[r] = lb; }
                    { const float z = fminf(p1[r], 115.f); const float lg = __builtin_amdgcn_logf(1.0f + __builtin_amdgcn_exp2f(z)); float Lv = -lg, lb = z - lg; if (diag && !(sl + 32 < tg)) { Lv = 0.f; lb = -1e30f; } L1[r] = Lv; p1[r] = lb; } }
                const f16x8 X0a = cvt8(L0[0], L0[1], L0[2], L0[3], L0[4], L0[5], L0[6], L0[7]), X0b = cvt8(L0[8], L0[9], L0[10], L0[11], L0[12], L0[13], L0[14], L0[15]);
                const f16x8 X1a = cvt8(L1[0], L1[1], L1[2], L1[3], L1[4], L1[5], L1[6], L1[7]), X1b = cvt8(L1[8], L1[9], L1[10], L1[11], L1[12], L1[13], L1[14], L1[15]);
                f32x16 Y1 = SB_MFMA(tri0, X1a, Rv); Y1 = SB_MFMA(tri1, X1b, Y1);
                f32x16 U = SB_MFMA(ones, X1a, Rv); U = SB_MFMA(ones, X1b, U);
                f32x16 Y0 = SB_MFMA(tri0, X0a, U); Y0 = SB_MFMA(tri1, X0b, Y0);
                Rv = SB_MFMA(ones, X0a, U); Rv = SB_MFMA(ones, X0b, Rv);
#pragma unroll
                for (int r = 0; r < 16; ++r) { p0[r] = __builtin_amdgcn_exp2f(p0[r] + Y0[r]); p1[r] = __builtin_amdgcn_exp2f(p1[r] + Y1[r]); }
                Af[0][0] = cvt8(p0[0], p0[1], p0[2], p0[3], p0[4], p0[5], p0[6], p0[7]); Af[0][1] = cvt8(p0[8], p0[9], p0[10], p0[11], p0[12], p0[13], p0[14], p0[15]);
                Af[1][0] = cvt8(p1[0], p1[1], p1[2], p1[3], p1[4], p1[5], p1[6], p1[7]); Af[1][1] = cvt8(p1[8], p1[9], p1[10], p1[11], p1[12], p1[13], p1[14], p1[15]);
            }
            if (jt > 0) { const size_t o = (size_t)(64 * (jt - 1)) * NPROJ; kr0 = *(const u32x4*)(kg + o); kr1 = *(const u32x4*)(kg + o + 32 * NPROJ); vr0 = *(const u32x4*)(vg + o); vr1 = *(const u32x4*)(vg + o + 32 * NPROJ); }
            if (act) {
                const int i16 = lane & 15, dhalf = (lane >> 4) & 1;
                const LAS unsigned char* va = Vb + (4 * hi + (i16 >> 2)) * VST + (dhalf * 16 + 4 * (i16 & 3)) * 2;
#pragma unroll
                for (int dblk = 0; dblk < 4; ++dblk)
#pragma unroll
                    for (int sb = 0; sb < 2; ++sb)
#pragma unroll
                        for (int sp = 0; sp < 2; ++sp) { const LAS unsigned char* pp = va + (32 * sb + 16 * sp) * VST + dblk * 64; const s16x4 lo = vtr(pp), h4 = vtr(pp + 8 * VST);
                            const bf16x8 vf = (bf16x8){lo[0], lo[1], lo[2], lo[3], h4[0], h4[1], h4[2], h4[3]};
                            O[dblk] = SB_MFMA(__builtin_bit_cast(f16x8, vf), Af[sb][sp], O[dblk]); }
            }
            if (jt > 0) { const int nb = (cur ^ 1) * STG; *(LAS u32x4*)(lds + nb + kdst) = kr0; *(LAS u32x4*)(lds + nb + kdst + 32 * KST) = kr1; *(LAS u32x4*)(lds + nb + vdst) = vr0; *(LAS u32x4*)(lds + nb + vdst + 32 * VST) = vr1; }
            { const float rw = wave_max(Rv[0]); if (lane == 0) rmaxL[(jt & 1) * 8 + w] = rw; }
            __syncthreads(); cur ^= 1;
            { const f32x4 ra = *(const LAS f32x4*)(rmaxL + (jt & 1) * 8), rb = *(const LAS f32x4*)(rmaxL + (jt & 1) * 8 + 4);
              const float rm = fmaxf(fmaxf(fmaxf(ra[0], ra[1]), fmaxf(ra[2], ra[3])), fmaxf(fmaxf(rb[0], rb[1]), fmaxf(rb[2], rb[3])));
              if (rm < -27.0f) break; }
        }
        { float ss = 0.f;
#pragma unroll
          for (int dblk = 0; dblk < 4; ++dblk)
#pragma unroll
              for (int r = 0; r < 16; ++r) ss += O[dblk][r] * O[dblk][r];
          ss = xor32_sum(ss); const float rr = rsqrtf(ss * (1.0f / 128) + EPS);
          LAS unsigned char* st = lds + w * (32 * OST);
#pragma unroll
          for (int dblk = 0; dblk < 4; ++dblk)
#pragma unroll
              for (int rq = 0; rq < 4; ++rq) { u32x2 v; v.x = pk2(O[dblk][4 * rq] * rr, O[dblk][4 * rq + 1] * rr); v.y = pk2(O[dblk][4 * rq + 2] * rr, O[dblk][4 * rq + 3] * rr);
                  *(LAS u32x2*)(st + t32 * OST + (dblk * 32 + 8 * rq + 4 * hi) * 2) = v; }
          LDS_WAIT();
          int le = lane; asm volatile("" : "+v"(le));
          const int ch = le & 15; const f32x4 g0 = *(const f32x4*)(sg + hh * 128 + ch * 8), g1 = *(const f32x4*)(sg + hh * 128 + ch * 8 + 4);
#pragma unroll
          for (int i = 0; i < 8; ++i) { const int row = i * 4 + (le >> 4); const u32x4 v = *(const LAS u32x4*)(st + row * OST + ch * 16); u32x4 o;
              o.x = pk2(bflo(v.x) * g0[0], bfhi(v.x) * g0[1]); o.y = pk2(bflo(v.y) * g0[2], bfhi(v.y) * g0[3]); o.z = pk2(bflo(v.z) * g1[0], bfhi(v.z) * g1[1]); o.w = pk2(bflo(v.w) * g1[2], bfhi(v.w) * g1[3]);
              *(u32x4*)(y + (tokb + t0w + row) * D + 512 + hh * 128 + ch * 8) = o; }
        }
        __syncthreads();
    }
}


namespace mls {
constexpr int ST = 272, KC = 0, VC = 128 * ST, CT = 2 * 128 * ST, QC = 3 * 128 * ST, GB = 4 * 128 * ST, CWX = 81920;
static_assert(CWX >= 2 * 128 * ST && CWX + 5 * 1024 * 4 <= GB, "X1 conv-weight copy must not touch KC / VC / GB");
static_assert(GB + 2560 <= LDSCTL_OFF, "mLSTM LDS map");
#define ML_MFMA(a, b, c) __builtin_amdgcn_mfma_f32_16x16x32_f16((a), (b), (c), 0, 0, 0)
__device__ __forceinline__ f16x8 tr8(const LAS unsigned char* p, int second_off) { const s16x4 lo = sbat::vtr(p), h4 = sbat::vtr(p + second_off); const bf16x8 v = (bf16x8){lo[0], lo[1], lo[2], lo[3], h4[0], h4[1], h4[2], h4[3]}; return __builtin_bit_cast(f16x8, v); }
}
__device__ __forceinline__ void ml_x1(Frame& F, int l, const int item) {
    using namespace mls;
    unsigned char* ws = F.ws; const bf16* proj = (const bf16*)(ws + WS_PROJ); const float* gates = (const float*)(ws + WS_GATES);
    const int tid = F.tid, lane = F.lane, w = F.wave, l16 = lane & 15, g = lane >> 4; LAS unsigned char* lds = F.lds;
    const int chain = item >> 4, c = item & 15, b = chain >> 2, h = chain & 3;
    const float* convw = F.in_(4) + (size_t)l * 4 * 1024; const float* convb = F.in_(5) + l * 1024; const float ib = F.in_(6)[l * 4 + h], fb = F.in_(7)[l * 4 + h];
    bf16* qcv = (bf16*)(ws + WS_QCV) + (size_t)item * 16384; bf16* kcv = (bf16*)(ws + WS_KCV) + (size_t)item * 16384; bf16* dC = (bf16*)(ws + WS_DC) + (size_t)item * 16384;
    float* gbuf = (float*)(ws + WS_GBUF) + (size_t)item * 384; float* dn = (float*)(ws + WS_DN) + (size_t)item * 128; float* scal = (float*)(ws + WS_SCAL) + (size_t)item * 4;
    LAS float* gL = (LAS float*)(lds + GB) + 128; LAS _Float16* wS = (LAS _Float16*)(lds + GB + 2048);
    const int ts0 = c * 128; const size_t tokc = (size_t)b * SEQ + ts0; const int q4 = l16 >> 2, p4 = l16 & 3;
    { const int cg = tid & 15, r0 = 4 * (tid >> 4);
#pragma unroll
      for (int qk = 0; qk < 2; ++qk) { const int ch = qk * 512 + h * 128 + cg * 8; u32x4 raw[7];
#pragma unroll
          for (int j = 0; j < 7; ++j) { const int tt = ts0 + r0 - 3 + j; const int ttc = tt < 0 ? 0 : tt; u32x4 r_ = *(const u32x4*)(proj + ((size_t)b * SEQ + ttc) * NPROJ + ch);
              if (tt < 0) r_ = (u32x4){0u, 0u, 0u, 0u}; raw[j] = r_; }
          float wv[4][8], bv[8];
#pragma unroll
          for (int e4 = 0; e4 < 2; ++e4) { const f32x4 t_ = *(const LAS f32x4*)(lds + CWX + (4 * 1024 + ch + 4 * e4) * 4); bv[4 * e4] = t_[0]; bv[4 * e4 + 1] = t_[1]; bv[4 * e4 + 2] = t_[2]; bv[4 * e4 + 3] = t_[3];
#pragma unroll
              for (int tap = 0; tap < 4; ++tap) { const f32x4 u_ = *(const LAS f32x4*)(lds + CWX + (tap * 1024 + ch + 4 * e4) * 4); wv[tap][4 * e4] = u_[0]; wv[tap][4 * e4 + 1] = u_[1]; wv[tap][4 * e4 + 2] = u_[2]; wv[tap][4 * e4 + 3] = u_[3]; } }
          const float sc = qk ? 0.08838834764831845f : 1.0f;
#pragma unroll
          for (int r = 0; r < 4; ++r) { float a[8];
#pragma unroll
              for (int e = 0; e < 8; ++e) a[e] = bv[e];
#pragma unroll
              for (int tap = 0; tap < 4; ++tap) { const u32x4 r_ = raw[r + tap];
                  a[0] += wv[tap][0] * bflo(r_.x); a[1] += wv[tap][1] * bfhi(r_.x); a[2] += wv[tap][2] * bflo(r_.y); a[3] += wv[tap][3] * bfhi(r_.y);
                  a[4] += wv[tap][4] * bflo(r_.z); a[5] += wv[tap][5] * bfhi(r_.z); a[6] += wv[tap][6] * bflo(r_.w); a[7] += wv[tap][7] * bfhi(r_.w); }
              u32x4 o_; o_.x = pk2(siluf(a[0]) * sc, siluf(a[1]) * sc); o_.y = pk2(siluf(a[2]) * sc, siluf(a[3]) * sc); o_.z = pk2(siluf(a[4]) * sc, siluf(a[5]) * sc); o_.w = pk2(siluf(a[6]) * sc, siluf(a[7]) * sc);
              *(u32x4*)((qk ? kcv : qcv) + (r0 + r) * 128 + cg * 8) = o_;
              if (qk) *(LAS u32x4*)(lds + KC + (r0 + r) * ST + cg * 16) = o_; } }
#pragma unroll
      for (int r = 0; r < 4; ++r) *(LAS u32x4*)(lds + VC + (r0 + r) * ST + cg * 16) = *(const u32x4*)(proj + (tokc + r0 + r) * NPROJ + 1024 + h * 128 + cg * 8); }
    if (w == 0) { const int t0 = 2 * lane; const float* gp = gates + (tokc + t0) * 8;
        const float i0 = gp[h] + ib, f0 = gp[4 + h] + fb, i1 = gp[8 + h] + ib, f1 = gp[12 + h] + fb;
        const float lf0 = -softplusf(-f0), lf1 = -softplusf(-f1); const float s2 = lf0 + lf1; float incl = s2;
        incl += DPPF(0.f, incl, 0x111, 0xF); incl += DPPF(0.f, incl, 0x112, 0xF); incl += DPPF(0.f, incl, 0x114, 0xF); incl += DPPF(0.f, incl, 0x118, 0xF);
        incl += DPPF(0.f, incl, 0x142, 0xA); incl += DPPF(0.f, incl, 0x143, 0xC);
        const float b0 = incl - s2 + lf0, b1 = b0 + lf1; const float g0 = i0 - b0, g1 = i1 - b1; float pm = fmaxf(g0, g1);
        pm = fmaxf(pm, DPPF(-INFINITY, pm, 0x111, 0xF)); pm = fmaxf(pm, DPPF(-INFINITY, pm, 0x112, 0xF)); pm = fmaxf(pm, DPPF(-INFINITY, pm, 0x114, 0xF)); pm = fmaxf(pm, DPPF(-INFINITY, pm, 0x118, 0xF));
        pm = fmaxf(pm, DPPF(-INFINITY, pm, 0x142, 0xA)); pm = fmaxf(pm, DPPF(-INFINITY, pm, 0x143, 0xC));
        const float pe = DPPF(-INFINITY, pm, 0x138, 0xF);
        const float G0 = fmaxf(pe, g0), G1 = fmaxf(G0, g1);
        const float Gmax = __builtin_bit_cast(float, __builtin_amdgcn_readlane(__builtin_bit_cast(int, G1), 63)), blast = __builtin_bit_cast(float, __builtin_amdgcn_readlane(__builtin_bit_cast(int, b1), 63));
        *(f32x2*)(gbuf + t0) = (f32x2){b0, b1}; *(f32x2*)(gbuf + 128 + t0) = (f32x2){g0, g1}; *(f32x2*)(gbuf + 256 + t0) = (f32x2){G0, G1};
        wS[t0] = (_Float16)__expf(g0 - Gmax); wS[t0 + 1] = (_Float16)__expf(g1 - Gmax);
        if (lane == 0) { scal[0] = blast; scal[1] = Gmax; } }
    __syncthreads();
    { f32x4 Cacc[8]; f32x4 Cn = (f32x4){0.f, 0.f, 0.f, 0.f};
#pragma unroll
      for (int vt = 0; vt < 8; ++vt) Cacc[vt] = (f32x4){0.f, 0.f, 0.f, 0.f};
#pragma unroll
      for (int ks = 0; ks < 4; ++ks) { const f16x8 kb = tr8(lds + KC + (32 * ks + 4 * g + q4) * ST + (16 * w + 4 * p4) * 2, 16 * ST);
          const u32x2 wa = *(const LAS u32x2*)(wS + 32 * ks + 4 * g), wb = *(const LAS u32x2*)(wS + 32 * ks + 16 + 4 * g); const u32x4 w4 = (u32x4){wa.x, wa.y, wb.x, wb.y}; const f16x8 wf = __builtin_bit_cast(f16x8, w4);
          Cn = ML_MFMA(wf, kb, Cn);
          f16x8 vfb[8];
#pragma unroll
          for (int vt = 0; vt < 8; ++vt) vfb[vt] = tr8(lds + VC + (32 * ks + 4 * g + q4) * ST + (16 * vt + 4 * p4) * 2, 16 * ST);
          __builtin_amdgcn_sched_barrier(0);
#pragma unroll
          for (int vt = 0; vt < 8; ++vt) Cacc[vt] = ML_MFMA(vfb[vt] * wf, kb, Cacc[vt]);
          __builtin_amdgcn_sched_barrier(0); }
#pragma unroll
      for (int vt = 0; vt < 8; ++vt) { u32x2 o_; o_.x = pk2(Cacc[vt][0], Cacc[vt][1]); o_.y = pk2(Cacc[vt][2], Cacc[vt][3]); *(u32x2*)(dC + (16 * w + l16) * 128 + 16 * vt + 4 * g) = o_; }
      if (g == 0) dn[16 * w + l16] = Cn[0]; }
    __syncthreads();
}
__device__ __forceinline__ void phase_ml_scan(Frame& F) {
    unsigned char* ws = F.ws; const int tid = F.tid;
    for (int u = F.bx; u < 256; u += F.G) { const int chain = u >> 2, qtr = u & 3; const size_t e0 = (size_t)qtr * 4096 + tid * 8;
        const bf16* dC = (const bf16*)(ws + WS_DC) + (size_t)chain * 16 * 16384 + e0; bf16* Cp = (bf16*)(ws + WS_CPREV) + (size_t)chain * 16 * 16384 + e0;
        const float* dn = (const float*)(ws + WS_DN) + (size_t)chain * 16 * 128; float* np = (float*)(ws + WS_NPREV) + (size_t)chain * 16 * 128; float* scal = (float*)(ws + WS_SCAL) + (size_t)chain * 16 * 4;
        float z0 = 0.f; asm volatile("" : "+v"(z0));
        float C[8] = {z0, z0, z0, z0, z0, z0, z0, z0}; float nn = z0; float m = z0; const bool don = (qtr == 0 && tid < 128);
        u32x4 dall[16]; float dnall[16]; f32x2 scall[16];
#pragma unroll
        for (int c = 0; c < 16; ++c) { dall[c] = *(const u32x4*)(dC + (size_t)c * 16384); dnall[c] = don ? dn[c * 128 + tid] : z0; scall[c] = *(const f32x2*)(scal + c * 4); }
#pragma unroll
        for (int c = 0; c < 16; ++c) { const u32x4 dcur = dall[c]; const float dncur = dnall[c]; const f32x2 sc = scall[c];
            u32x4 o_; o_.x = pk2(C[0], C[1]); o_.y = pk2(C[2], C[3]); o_.z = pk2(C[4], C[5]); o_.w = pk2(C[6], C[7]); *(u32x4*)(Cp + (size_t)c * 16384) = o_;
            if (don) np[c * 128 + tid] = nn;
            if (qtr == 0 && tid == 0) scal[c * 4 + 2] = m;
            const float Mlast = fmaxf(m, sc[1]), wold = __expf(m - Mlast), wloc = __expf(sc[1] - Mlast);
            C[0] = wold * C[0] + wloc * bflo(dcur.x); C[1] = wold * C[1] + wloc * bfhi(dcur.x); C[2] = wold * C[2] + wloc * bflo(dcur.y); C[3] = wold * C[3] + wloc * bfhi(dcur.y);
            C[4] = wold * C[4] + wloc * bflo(dcur.z); C[5] = wold * C[5] + wloc * bfhi(dcur.z); C[6] = wold * C[6] + wloc * bflo(dcur.w); C[7] = wold * C[7] + wloc * bfhi(dcur.w);
            nn = wold * nn + wloc * dncur; m = sc[0] + Mlast; } }
}
struct X3Pf { u32x4 q[4], k[4], c[4], v[4]; f32x4 g; float mp; };
__device__ __forceinline__ void x3_load(Frame& F, const int item, X3Pf& pf) {
    unsigned char* ws = F.ws; const bf16* proj = (const bf16*)(ws + WS_PROJ); const int tid = F.wave * 64 + pg8::lane_fresh();
    const int chain = item >> 4, c = item & 15, b = chain >> 2, h = chain & 3; const size_t tokc = (size_t)b * SEQ + c * 128;
    const bf16* qcv = (const bf16*)(ws + WS_QCV) + (size_t)item * 16384; const bf16* kcv = (const bf16*)(ws + WS_KCV) + (size_t)item * 16384; const bf16* Cp = (const bf16*)(ws + WS_CPREV) + (size_t)item * 16384;
    const float* gbuf = (const float*)(ws + WS_GBUF) + (size_t)item * 384; const float* np = (const float*)(ws + WS_NPREV) + (size_t)item * 128; const float* scal = (const float*)(ws + WS_SCAL) + (size_t)item * 4;
    const int cg = tid & 15, r0 = tid >> 4;
#pragma unroll
    for (int i = 0; i < 4; ++i) { const int row = r0 + 32 * i;
        pf.q[i] = *(const u32x4*)(qcv + row * 128 + cg * 8); pf.k[i] = *(const u32x4*)(kcv + row * 128 + cg * 8);
        pf.c[i] = *(const u32x4*)(Cp + row * 128 + cg * 8); pf.v[i] = *(const u32x4*)(proj + (tokc + row) * NPROJ + 1024 + h * 128 + cg * 8); }
    pf.g = (f32x4){0.f, 0.f, 0.f, 0.f};
    if (tid < 96) pf.g = *(const f32x4*)(gbuf + 4 * tid); else if (tid < 128) pf.g = *(const f32x4*)(np + 4 * (tid - 96));
    pf.mp = scal[2];
}
__device__ __forceinline__ void ml_x3(Frame& F, int l, const int item, X3Pf& pf, const int next_item) {
    using namespace mls;
    unsigned char* ws = F.ws; const bf16* proj = (const bf16*)(ws + WS_PROJ); bf16* y = (bf16*)(ws + WS_Y);
    const int tid = F.tid, lane = F.lane, w = F.wave, l16 = lane & 15, g = lane >> 4; LAS unsigned char* lds = F.lds;
    const int chain = item >> 4, c = item & 15, b = chain >> 2, h = chain & 3;
    const float* hg = F.in_(8) + l * 512 + h * 128;
    const bf16* qcv = (const bf16*)(ws + WS_QCV) + (size_t)item * 16384; const bf16* kcv = (const bf16*)(ws + WS_KCV) + (size_t)item * 16384; const bf16* Cp = (const bf16*)(ws + WS_CPREV) + (size_t)item * 16384;
    const float* gbuf = (const float*)(ws + WS_GBUF) + (size_t)item * 384; const float* np = (const float*)(ws + WS_NPREV) + (size_t)item * 128; const float* scal = (const float*)(ws + WS_SCAL) + (size_t)item * 4;
    LAS float* bL = (LAS float*)(lds + GB); LAS float* gL = bL + 128; LAS float* GL = bL + 256; LAS float* nL = bL + 384;
    const size_t tokc = (size_t)b * SEQ + c * 128; const int q4 = l16 >> 2, p4 = l16 & 3;
    { const int cg = tid & 15, r0 = tid >> 4;
#pragma unroll
      for (int i = 0; i < 4; ++i) { const int row = r0 + 32 * i;
          *(LAS u32x4*)(lds + QC + row * ST + cg * 16) = pf.q[i]; *(LAS u32x4*)(lds + KC + row * ST + cg * 16) = pf.k[i];
          *(LAS u32x4*)(lds + CT + row * ST + cg * 16) = pf.c[i]; *(LAS u32x4*)(lds + VC + row * ST + cg * 16) = pf.v[i]; }
      if (tid < 96) *(LAS f32x4*)(bL + 4 * tid) = pf.g;
      else if (tid < 128) *(LAS f32x4*)(nL + 4 * (tid - 96)) = pf.g; }
    const float mp = pf.mp;
    __syncthreads();
    if (next_item >= 0) x3_load(F, next_item, pf);
    { const int t = 16 * w + l16; const size_t tok = tokc + t; const float Mt = fmaxf(mp, GL[t]), bt = bL[t]; const float wi = __expf(mp - Mt);
      u32x2 mo8[8];
#pragma unroll
      for (int vt = 0; vt < 8; ++vt) mo8[vt] = *(const u32x2*)(proj + tok * NPROJ + 1536 + h * 128 + 16 * vt + 4 * g);
      f16x8 qf[4], qs[4];
#pragma unroll
      for (int kk = 0; kk < 4; ++kk) { qf[kk] = *(const LAS f16x8*)(lds + QC + (16 * w + l16) * ST + (32 * kk + 8 * g) * 2); qs[kk] = qf[kk] * (_Float16)wi; }
      f32x4 sa[8];
#pragma unroll
      for (int st = 0; st < 8; ++st) { sa[st] = (f32x4){0.f, 0.f, 0.f, 0.f};
          if (st <= w) { f16x8 kf[4];
#pragma unroll
              for (int kk = 0; kk < 4; ++kk) kf[kk] = *(const LAS f16x8*)(lds + KC + (16 * st + l16) * ST + (32 * kk + 8 * g) * 2);
              __builtin_amdgcn_sched_barrier(0);
#pragma unroll
              for (int kk = 0; kk < 4; ++kk) sa[st] = ML_MFMA(kf[kk], qf[kk], sa[st]);
              __builtin_amdgcn_sched_barrier(0); } }
      float den = 0.f;
#pragma unroll
      for (int st = 0; st < 8; ++st) { const f32x4 gv = *(const LAS f32x4*)(gL + 16 * st + 4 * g);
#pragma unroll
          for (int r = 0; r < 4; ++r) { const int s_ = 16 * st + 4 * g + r; const float p = (s_ <= t) ? sa[st][r] * __expf(gv[r] - Mt) : 0.f; den += p; sa[st][r] = p; } }
      f16x8 Pf[4];
#pragma unroll
      for (int ks = 0; ks < 4; ++ks) Pf[ks] = sbat::cvt8(sa[2 * ks][0], sa[2 * ks][1], sa[2 * ks][2], sa[2 * ks][3], sa[2 * ks + 1][0], sa[2 * ks + 1][1], sa[2 * ks + 1][2], sa[2 * ks + 1][3]);
      f32x4 nt[8];
#pragma unroll
      for (int vt = 0; vt < 8; ++vt) { nt[vt] = (f32x4){0.f, 0.f, 0.f, 0.f}; f16x8 vf[4], cf[4];
#pragma unroll
          for (int ks = 0; ks < 4; ++ks) if (32 * ks <= 16 * w + 15) vf[ks] = tr8(lds + VC + (32 * ks + 4 * g + q4) * ST + (16 * vt + 4 * p4) * 2, 16 * ST);
#pragma unroll
          for (int kk = 0; kk < 4; ++kk) cf[kk] = tr8(lds + CT + (32 * kk + 8 * g + q4) * ST + (16 * vt + 4 * p4) * 2, 4 * ST);
          __builtin_amdgcn_sched_barrier(0);
#pragma unroll
          for (int ks = 0; ks < 4; ++ks) if (32 * ks <= 16 * w + 15) nt[vt] = ML_MFMA(vf[ks], Pf[ks], nt[vt]);
#pragma unroll
          for (int kk = 0; kk < 4; ++kk) nt[vt] = ML_MFMA(cf[kk], qs[kk], nt[vt]);
          __builtin_amdgcn_sched_barrier(0); }
      den = xor16_sum(den); den = xor32_sum(den);
      float nq = 0.f;
#pragma unroll
      for (int kk = 0; kk < 4; ++kk) { const f32x4 n0 = *(const LAS f32x4*)(nL + 32 * kk + 8 * g), n1 = *(const LAS f32x4*)(nL + 32 * kk + 8 * g + 4);
          nq += n0[0] * (float)qf[kk][0] + n0[1] * (float)qf[kk][1] + n0[2] * (float)qf[kk][2] + n0[3] * (float)qf[kk][3] + n1[0] * (float)qf[kk][4] + n1[1] * (float)qf[kk][5] + n1[2] * (float)qf[kk][6] + n1[3] * (float)qf[kk][7]; }
      nq = xor16_sum(nq); nq = xor32_sum(nq);
      den += wi * nq;
      const float dn_ = __builtin_amdgcn_rcpf(fmaxf(fabsf(den), __expf(-(bt + Mt)))); float ss = 0.f;
#pragma unroll
      for (int vt = 0; vt < 8; ++vt)
#pragma unroll
          for (int r = 0; r < 4; ++r) { nt[vt][r] *= dn_; ss += nt[vt][r] * nt[vt][r]; }
      ss = xor16_sum(ss); ss = xor32_sum(ss); const float rr = rsqrtf(ss * (1.0f / 128) + EPS);
      f32x4 gg8[8];
#pragma unroll
      for (int vt = 0; vt < 8; ++vt) gg8[vt] = *(const f32x4*)(hg + 16 * vt + 4 * g);
#pragma unroll
      for (int vt = 0; vt < 8; ++vt) { const int v0 = 16 * vt + 4 * g; const u32x2 mo = mo8[vt]; const f32x4 gg = gg8[vt];
          u32x2 o_; o_.x = pk2(sigmf(bflo(mo.x)) * nt[vt][0] * rr * gg[0], sigmf(bfhi(mo.x)) * nt[vt][1] * rr * gg[1]); o_.y = pk2(sigmf(bflo(mo.y)) * nt[vt][2] * rr * gg[2], sigmf(bfhi(mo.y)) * nt[vt][3] * rr * gg[3]);
          *(u32x2*)(y + tok * D + h * 128 + v0) = o_; } }
    __syncthreads();
}

__device__ __forceinline__ void phase_mixer(Frame& F, int l, int qidx, int mode) {
    volatile LAS int* qs = (volatile LAS int*)(F.lds + MISC_OFF + 64); unsigned* qc = F.ctl + CW_Q + qidx;
    { const float* convw = F.in_(4) + (size_t)l * 4 * 1024; const float* convb = F.in_(5) + l * 1024; LAS float* cw = (LAS float*)(F.lds + mls::CWX);
      for (int e = F.tid; e < 5 * 256; e += NTHREADS) { const int t = e >> 8, c4 = (e & 255) * 4; *(LAS f32x4*)(cw + t * 1024 + c4) = *(const f32x4*)((t < 4 ? convw + t * 1024 : convb) + c4); }
      __syncthreads(); }
    int ahead = 0; if (F.tid == 0) ahead = (int)atomicAdd(qc, 1u);
    auto next_item = [&]() -> int {
        if (F.tid == 0) *qs = ahead;
        __syncthreads();
        const int it_ = __builtin_amdgcn_readfirstlane(*qs);
        __syncthreads();
        if (it_ < 512 + 1024 && F.tid == 0) ahead = (int)atomicAdd(qc, 1u);
        return it_; };
#define MIX_LAUNDER() Frame G = F; { int t_ = F.tid; asm volatile("" : "+v"(t_)); G.tid = t_; G.lane = t_ & 63; G.wave = __builtin_amdgcn_readfirstlane(t_ >> 6); \
          unsigned lb_ = 0; asm volatile("" : "+s"(lb_)); G.lds = F.lds + lb_; \
          GAS unsigned char* w_ = (GAS unsigned char*)F.ws; asm volatile("" : "+s"(w_)); G.ws = (unsigned char*)w_; }
    int it = next_item();
    if (mode == 1) { while (it < 512) it = next_item(); }
    while (it < 512) { { MIX_LAUNDER(); sb_unit(G, l, it & 63, 7 - (it >> 6)); } it = next_item(); }
    if (mode == 3) return;
    while (it < 512 + 1024) { { MIX_LAUNDER(); ml_x1(G, l, it - 512); } it = next_item(); }
#undef MIX_LAUNDER
}

namespace xat {
constexpr int KST = 272, VST = 320, BUFB = 64 * VST, OST = 272;
typedef __amdgpu_buffer_rsrc_t rsrc_t;
__device__ __forceinline__ float xor32_max(float x) { auto t = __builtin_amdgcn_permlane32_swap(__float_as_uint(x), __float_as_uint(x), false, false); return fmaxf(__uint_as_float(t[0]), __uint_as_float(t[1])); }
template <int S> struct Step { static constexpr int isV = S >= 8, tile = isV ? ((S - 8) & 3) : (S >> 1), dh = isV ? ((S - 8) >> 2) : (S & 1), buf = S % 3; };
template <int S> __device__ __forceinline__ void ld(u32x4 (&r)[2], rsrc_t kvr, unsigned loff) {
    if constexpr (S < 16) {
#pragma unroll
        for (int i = 0; i < 2; ++i) r[i] = __builtin_bit_cast(u32x4, __builtin_amdgcn_raw_buffer_load_b128(kvr, loff, ((64 * Step<S>::tile + 32 * i) * 2048 + Step<S>::isV * 1024 + Step<S>::dh * 128) * 2, 0)); }
}
template <int S> __device__ __forceinline__ void st(const u32x4 (&r)[2], LAS unsigned char* lds, unsigned lk, unsigned lv) {
    if constexpr (S < 16) { constexpr int ST = Step<S>::isV ? VST : KST;
#pragma unroll
        for (int i = 0; i < 2; ++i) *(LAS u32x4*)(lds + (Step<S>::isV ? lv : lk) + Step<S>::buf * BUFB + 32 * i * ST) = r[i]; }
}
template <int S> __device__ __forceinline__ void qk(f32x16& S0, f32x16& S1, const f16x8 (&qf)[16], const LAS unsigned char* lds, int t32, int hi) {
#pragma unroll
    for (int kk = 0; kk < 8; ++kk) { const f16x8 k0 = *(const LAS f16x8*)(lds + Step<S>::buf * BUFB + t32 * KST + 32 * kk + 16 * hi); const f16x8 k1 = *(const LAS f16x8*)(lds + Step<S>::buf * BUFB + (32 + t32) * KST + 32 * kk + 16 * hi);
        S0 = SB_MFMA(k0, qf[8 * Step<S>::dh + kk], S0); S1 = SB_MFMA(k1, qf[8 * Step<S>::dh + kk], S1); }
}
template <int TILE> __device__ __forceinline__ void smax(f32x16& S0, f32x16& S1, f16x8 (&Pf)[8][2], float (&mt)[4], float& m, float& sum) {
    float tm = fmaxf(S0[0], S1[0]);
#pragma unroll
    for (int r = 1; r < 16; ++r) tm = fmaxf(tm, fmaxf(S0[r], S1[r]));
    tm = xor32_max(tm);
    const float mn = fmaxf(m, tm); sum *= __builtin_amdgcn_exp2f(m - mn); m = mn; mt[TILE] = mn;
    float ps = 0.f;
#pragma unroll
    for (int r = 0; r < 16; ++r) { S0[r] = __builtin_amdgcn_exp2f(S0[r] - mn); S1[r] = __builtin_amdgcn_exp2f(S1[r] - mn); ps += S0[r] + S1[r]; }
    sum += ps;
    Pf[2 * TILE][0] = sbat::cvt8(S0[0], S0[1], S0[2], S0[3], S0[4], S0[5], S0[6], S0[7]); Pf[2 * TILE][1] = sbat::cvt8(S0[8], S0[9], S0[10], S0[11], S0[12], S0[13], S0[14], S0[15]);
    Pf[2 * TILE + 1][0] = sbat::cvt8(S1[0], S1[1], S1[2], S1[3], S1[4], S1[5], S1[6], S1[7]); Pf[2 * TILE + 1][1] = sbat::cvt8(S1[8], S1[9], S1[10], S1[11], S1[12], S1[13], S1[14], S1[15]);
#pragma unroll
    for (int r = 0; r < 16; ++r) { S0[r] = 0.f; S1[r] = 0.f; }
}
template <int S> __device__ __forceinline__ void pv(f32x16 (&O)[4], const f16x8 (&Pf)[8][2], const LAS unsigned char* lds, int lane, int hi) {
    const int i16 = lane & 15, dhalf = (lane >> 4) & 1;
    const LAS unsigned char* va = lds + Step<S>::buf * BUFB + (4 * hi + (i16 >> 2)) * VST + (dhalf * 16 + 4 * (i16 & 3)) * 2;
#pragma unroll
    for (int dblk = 0; dblk < 4; ++dblk)
#pragma unroll
        for (int sb = 0; sb < 2; ++sb)
#pragma unroll
            for (int sp = 0; sp < 2; ++sp) { const LAS unsigned char* pp = va + (32 * sb + 16 * sp) * VST + dblk * 64; const s16x4 lo = sbat::vtr(pp), h4 = sbat::vtr(pp + 8 * VST);
                const bf16x8 vf = (bf16x8){lo[0], lo[1], lo[2], lo[3], h4[0], h4[1], h4[2], h4[3]};
                O[dblk] = SB_MFMA(__builtin_bit_cast(f16x8, vf), Pf[2 * Step<S>::tile + sb][sp], O[dblk]); }
}
}
__device__ __forceinline__ void phase_xattn(Frame& F) {
    using namespace xat;
    unsigned char* ws = F.ws; const bf16* q = (const bf16*)(ws + WS_Q); const bf16* kv = (const bf16*)(ws + WS_KV); bf16* o = (bf16*)(ws + WS_O);
    const int tid = F.tid, lane = F.lane, w = F.wave, t32 = lane & 31, hi = lane >> 5; LAS unsigned char* lds = F.lds;
    const unsigned loff = (unsigned)((tid >> 4) * 2048 + (tid & 15) * 8) * 2u, lk = (unsigned)((tid >> 4) * KST + (tid & 15) * 16), lv = (unsigned)((tid >> 4) * VST + (tid & 15) * 16);
    for (int unit = F.bx; unit < 512; unit += F.G) {
        const int bh = (unit & 255) >> 2, qblk = ((unit & 3) << 1) | (unit >> 8), b = bh >> 2, hd = bh & 3;
        const size_t tok0 = (size_t)b * SEQ + qblk * 256 + 32 * w;
        const bf16* kvb = kv + (size_t)b * MEML * 2048 + hd * 256;
        const rsrc_t kvr = __builtin_amdgcn_make_buffer_rsrc((void*)kvb, 0, 0x7fffffff, 0x00020000);
        f16x8 qf[16];
        { const bf16* qrow = q + (tok0 + t32) * D + hd * 256 + 8 * hi;
#pragma unroll
          for (int kk = 0; kk < 16; ++kk) qf[kk] = *(const f16x8*)(qrow + 16 * kk); }
        f16x8 Pf[8][2]; float mt[4]; float m = -INFINITY, sum = 0.f;
        f32x16 S0, S1;
#pragma unroll
        for (int r = 0; r < 16; ++r) { S0[r] = 0.f; S1[r] = 0.f; }
        u32x4 rA[2], rB[2];
        ld<0>(rA, kvr, loff); st<0>(rA, lds, lk, lv); ld<1>(rB, kvr, loff); __syncthreads();
#define XA_KSTEP(S_, RL, RS) ld<S_ + 2>(RL, kvr, loff); qk<S_>(S0, S1, qf, lds, t32, hi); if ((S_) & 1) smax<((S_) / 2)>(S0, S1, Pf, mt, m, sum); st<S_ + 1>(RS, lds, lk, lv); __syncthreads();
        XA_KSTEP(0, rA, rB) XA_KSTEP(1, rB, rA) XA_KSTEP(2, rA, rB) XA_KSTEP(3, rB, rA) XA_KSTEP(4, rA, rB) XA_KSTEP(5, rB, rA) XA_KSTEP(6, rA, rB) XA_KSTEP(7, rB, rA)
#undef XA_KSTEP
#pragma unroll
        for (int t = 0; t < 3; ++t) { const _Float16 f = (_Float16)__builtin_amdgcn_exp2f(mt[t] - m);
#pragma unroll
            for (int sb = 0; sb < 2; ++sb)
#pragma unroll
                for (int sp = 0; sp < 2; ++sp) Pf[2 * t + sb][sp] = Pf[2 * t + sb][sp] * f; }
        sum = xor32_sum(sum); const float inv = 1.0f / sum;
        LAS unsigned char* stg = lds + 3 * BUFB + w * (32 * OST);
#define XA_VSTEP(S_, RL, RS) ld<S_ + 2>(RL, kvr, loff); pv<S_>(O, Pf, lds, lane, hi); st<S_ + 1>(RS, lds, lk, lv); __syncthreads();
#pragma unroll
        for (int dh = 0; dh < 2; ++dh) {
            f32x16 O[4];
#pragma unroll
            for (int dblk = 0; dblk < 4; ++dblk)
#pragma unroll
                for (int r = 0; r < 16; ++r) O[dblk][r] = 0.f;
            if (dh == 0) { XA_VSTEP(8, rA, rB) XA_VSTEP(9, rB, rA) XA_VSTEP(10, rA, rB) XA_VSTEP(11, rB, rA) }
            else         { XA_VSTEP(12, rA, rB) XA_VSTEP(13, rB, rA) XA_VSTEP(14, rA, rB) XA_VSTEP(15, rB, rA) }
            int le = lane; asm volatile("" : "+v"(le));
            const int t32e = le & 31, hie = le >> 5;
#pragma unroll
            for (int db = 0; db < 4; ++db)
#pragma unroll
                for (int rq = 0; rq < 4; ++rq) { u32x2 v; v.x = pk2(O[db][4 * rq] * inv, O[db][4 * rq + 1] * inv); v.y = pk2(O[db][4 * rq + 2] * inv, O[db][4 * rq + 3] * inv);
                    *(LAS u32x2*)(stg + t32e * OST + (db * 32 + 8 * rq + 4 * hie) * 2) = v; }
            LDS_WAIT();
            const int ch = le & 15;
#pragma unroll
            for (int i = 0; i < 8; ++i) { const int row = i * 4 + (le >> 4); const u32x4 v = *(const LAS u32x4*)(stg + row * OST + ch * 16);
                *(u32x4*)(o + (tok0 + row) * D + hd * 256 + dh * 128 + ch * 8) = v; }
            LDS_WAIT();
        }
#undef XA_VSTEP
    }
}


namespace xat2 {
#define XA2_NPARK 7
__device__ __forceinline__ int lane_now() { int l; asm volatile("v_mbcnt_lo_u32_b32 %0, -1, 0\n\tv_mbcnt_hi_u32_b32 %0, -1, %0" : "=v"(l)); return l; }
__device__ __forceinline__ void dma_kv(const char* src0, LAS unsigned char* lds, int w, unsigned gofs) {
#pragma unroll
    for (int i = 0; i < 16; ++i) __builtin_amdgcn_global_load_lds((const unsigned*)(src0 + gofs + (size_t)i * 16 * 4096), (LAS unsigned*)(lds + (w + 8 * i) * 1024), 16, 0, 0);
}
}
__device__ __forceinline__ void phase_xattn2(Frame& F) {
    using namespace xat;
    unsigned char* ws = F.ws; const bf16* q = (const bf16*)(ws + WS_Q); const bf16* kv = (const bf16*)(ws + WS_KV); bf16* o = (bf16*)(ws + WS_O);
    const int w = F.wave; LAS unsigned char* lds = F.lds;
#define XA2_GOFS(L) ((unsigned)(2 * w + ((L) >> 5)) * 4096u + 16u * (unsigned)(((L) & 31) ^ (((2 * (w & 1) + ((L) >> 5)) << 2) | ((w >> 1) & 3))))
    for (int cu = F.bx; cu < 256; cu += F.G) {
        const int bh = cu >> 2, qp = cu & 3, b = bh >> 2, hd = bh & 3;
        const char* kvb = (const char*)(kv + (size_t)b * MEML * 2048 + hd * 256);
        const size_t tokA = (size_t)b * SEQ + 512 * qp + 32 * w;
        int lane = xat2::lane_now();
        xat2::dma_kv(kvb, lds, w, XA2_GOFS(lane));
        lane = xat2::lane_now();
        const int t32 = lane & 31, hi = lane >> 5;
        const int kA = t32 * 512 + ((hi ^ (((t32 & 3) << 2) | ((t32 >> 2) & 3))) << 4);
        f16x8 PfA[8][2], PfB[8][2]; float invA = 0.f, invB = 0.f;
#define XA2_LOADQ(TOK0) { const bf16* qrow = q + ((TOK0) + t32) * D + hd * 256 + 8 * hi; _Pragma("unroll") for (int kk = 0; kk < 16; ++kk) qf[kk] = *(const f16x8*)(qrow + 16 * kk); }
#define XA2_QK(PF, INV) do { \
            float mt[4]; float m = -INFINITY, sum = 0.f; f32x16 S0, S1; _Pragma("unroll") for (int r = 0; r < 16; ++r) { S0[r] = 0.f; S1[r] = 0.f; } \
            XA2_QKT(PF, 0) XA2_QKT(PF, 1) XA2_QKT(PF, 2) XA2_QKT(PF, 3) \
            _Pragma("unroll") for (int t = 0; t < 3; ++t) { const _Float16 f = (_Float16)__builtin_amdgcn_exp2f(mt[t] - m); _Pragma("unroll") for (int sb = 0; sb < 2; ++sb) _Pragma("unroll") for (int sp = 0; sp < 2; ++sp) PF[2 * t + sb][sp] = PF[2 * t + sb][sp] * f; } \
            sum = xor32_sum(sum); INV = 1.0f / sum; } while (0)
#define XA2_RDB(G) { _Pragma("unroll") for (int j = 0; j < XA2_NB; ++j) { const int kk = (G) * XA2_NB + j; kb[(G) & XA2_PIPE][j][0] = *(const LAS f16x8*)(lds + (kAt ^ (32 * kk))); kb[(G) & XA2_PIPE][j][1] = *(const LAS f16x8*)(lds + ((kAt + 32 * 512) ^ (32 * kk))); } }
#define XA2_QKT(PF, T) { int kAt = kA + (64 * (T)) * 512; asm volatile("" : "+v"(kAt)); f16x8 kb[XA2_PIPE + 1][XA2_NB][2]; \
            if (XA2_PIPE) { XA2_RDB(0) } \
            _Pragma("unroll") for (int g = 0; g < 16 / XA2_NB; ++g) { \
                if (XA2_PIPE) { if (g + 1 < 16 / XA2_NB) { XA2_RDB(g + 1) } } else { XA2_RDB(g) } \
                __builtin_amdgcn_sched_barrier(0); \
                _Pragma("unroll") for (int j = 0; j < XA2_NB; ++j) { S0 = SB_MFMA(kb[g & XA2_PIPE][j][0], qf[g * XA2_NB + j], S0); S1 = SB_MFMA(kb[g & XA2_PIPE][j][1], qf[g * XA2_NB + j], S1); } \
                __builtin_amdgcn_sched_barrier(0); } \
            smax<T>(S0, S1, PF, mt, m, sum); __builtin_amdgcn_sched_barrier(0); }
        f16x8 qf[16];
        XA2_LOADQ(tokA);
        asm volatile("s_waitcnt vmcnt(0)" ::: "memory"); __syncthreads();
#define XA2_NB 4
#define XA2_PIPE 1
        XA2_QK(PfA, invA);
#undef XA2_NB
#undef XA2_PIPE
#define XA2_NB 2
#define XA2_PIPE 0
        XA2_LOADQ(tokA + 256);
        u32x4* pscr = (u32x4*)(ws + WS_QCV) + (size_t)cu * XA2_NPARK * NTHREADS + (w * 64 + xat2::lane_now());
#pragma unroll
        for (int i = 0; i < XA2_NPARK; ++i) pscr[i * NTHREADS] = __builtin_bit_cast(u32x4, PfA[i >> 1][i & 1]);
        XA2_QK(PfB, invB);
#undef XA2_NB
#undef XA2_PIPE
#undef XA2_RDB
#undef XA2_QK
#undef XA2_LOADQ
#undef XA2_QKT
        __syncthreads();
        { const int l2 = xat2::lane_now(); xat2::dma_kv(kvb + 2048, lds, w, XA2_GOFS(l2)); }
        asm volatile("s_waitcnt vmcnt(0)" ::: "memory"); __syncthreads();
        const int l3 = xat2::lane_now();
        const int i16 = l3 & 15, q4 = i16 >> 2, p4 = i16 & 3, dhalf = (l3 >> 4) & 1, hi3 = l3 >> 5;
        const int vA = (4 * hi3 + q4) * 512 + ((q4 << 6) | ((((dhalf << 1) | (p4 >> 1)) ^ hi3) << 4) | ((p4 & 1) << 3));
        LAS unsigned char* stg = lds + RING_BYTES + w * 2560;
#define XA2_PV(PF, INV, TOK0) do { _Pragma("unroll") for (int dh = 0; dh < 2; ++dh) { f32x16 O[4]; _Pragma("unroll") for (int db = 0; db < 4; ++db) _Pragma("unroll") for (int r = 0; r < 16; ++r) O[db][r] = 0.f; \
            _Pragma("unroll") for (int T = 0; T < 4; ++T) { int vAt = vA + 64 * T * 512; asm volatile("" : "+v"(vAt)); _Pragma("unroll") for (int db = 0; db < 4; ++db) _Pragma("unroll") for (int sb = 0; sb < 2; ++sb) _Pragma("unroll") for (int sp = 0; sp < 2; ++sp) { \
                const int rows0 = (32 * sb + 16 * sp) * 512, dx = (4 * dh + db) * 64; \
                const s16x4 lo = sbat::vtr(lds + ((vAt + rows0) ^ dx)), h4 = sbat::vtr(lds + ((vAt + rows0 + 8 * 512) ^ dx ^ 32)); \
                const bf16x8 vf = (bf16x8){lo[0], lo[1], lo[2], lo[3], h4[0], h4[1], h4[2], h4[3]}; \
                O[db] = SB_MFMA(__builtin_bit_cast(f16x8, vf), PF[2 * T + sb][sp], O[db]); if (sb == 1 && sp == 1) __builtin_amdgcn_sched_barrier(0); } } \
            const int le = xat2::lane_now(); const int t32e = le & 31, hie = le >> 5; \
            _Pragma("unroll") for (int db = 0; db < 4; ++db) { \
              if (F8_MO) { \
                _Pragma("unroll") for (int rq = 0; rq < 4; ++rq) *(LAS unsigned*)(stg + t32e * 48 + 8 * rq + 4 * hie) = f8x4(O[db][4 * rq] * ((INV) * F8_HSCALE), O[db][4 * rq + 1] * ((INV) * F8_HSCALE), O[db][4 * rq + 2] * ((INV) * F8_HSCALE), O[db][4 * rq + 3] * ((INV) * F8_HSCALE)); \
                LDS_WAIT(); \
                { const int row = le >> 1, hf = le & 1; const u32x4 v = *(const LAS u32x4*)(stg + row * 48 + hf * 16); \
                    *(u32x4*)((unsigned char*)o + ((TOK0) + row) * D + hd * 256 + (4 * dh + db) * 32 + hf * 16) = v; } \
                LDS_WAIT(); \
              } else { \
                _Pragma("unroll") for (int rq = 0; rq < 4; ++rq) { u32x2 v; v.x = pk2(O[db][4 * rq] * (INV), O[db][4 * rq + 1] * (INV)); v.y = pk2(O[db][4 * rq + 2] * (INV), O[db][4 * rq + 3] * (INV)); \
                    *(LAS u32x2*)(stg + t32e * 80 + (8 * rq + 4 * hie) * 2) = v; } \
                LDS_WAIT(); \
                _Pragma("unroll") for (int i = 0; i < 2; ++i) { const int row = (le >> 2) + 16 * i, ch = le & 3; const u32x4 v = *(const LAS u32x4*)(stg + row * 80 + ch * 16); \
                    *(u32x4*)(o + ((TOK0) + row) * D + hd * 256 + (4 * dh + db) * 32 + ch * 8) = v; } \
                LDS_WAIT(); } } } } while (0)
        XA2_PV(PfB, invB, tokA + 256);
#pragma unroll
        for (int i = 0; i < XA2_NPARK; ++i) PfA[i >> 1][i & 1] = __builtin_bit_cast(f16x8, pscr[i * NTHREADS]);
        XA2_PV(PfA, invA, tokA);
#undef XA2_PV
#undef XA2_GOFS
        __syncthreads();
    }
}

__device__ __forceinline__ void phase_gates(Frame& F) {
    unsigned char* ws = F.ws; const bf16* xbp = (const bf16*)(ws + WS_XB); const bf16* wg = (const bf16*)(ws + WS_WIN) + (size_t)NPROJ * D; const float* ssq = (const float*)(ws + WS_SSQ); float* gates = (float*)(ws + WS_GATES);
    const int tid = F.tid, lane = F.lane, w = F.wave, l16 = lane & 15, g = lane >> 4, tpb = NTOK / F.G; LAS unsigned char* lds = F.lds;
    constexpr int WST = 2064;
    for (int e = tid; e < 16 * 128; e += NTHREADS) { const int n = e >> 7, k8 = (e & 127) * 8; u32x4 o_ = (u32x4){0u, 0u, 0u, 0u}; if (n < 8) o_ = *(const u32x4*)(wg + (size_t)n * D + k8); *(LAS u32x4*)(lds + n * WST + k8 * 2) = o_; }
    __syncthreads();
    for (int t0 = w * 16; t0 < tpb; t0 += NWAVES * 16) { const int tokb = F.bx * tpb + t0;
        f32x4 acc = (f32x4){0.f, 0.f, 0.f, 0.f}; const bf16* xrow = xbp + (size_t)(tokb + l16) * D + 8 * g;
        const float rsv = pg8::rstd_from_ssq(ssq, tokb + l16);
#pragma unroll
        for (int kb = 0; kb < 2; ++kb) { f16x8 af[16];
#pragma unroll
            for (int j = 0; j < 16; ++j) af[j] = *(const f16x8*)(xrow + 32 * (16 * kb + j));
            __builtin_amdgcn_sched_barrier(0);
#pragma unroll
            for (int j = 0; j < 16; ++j) { const int kk = 16 * kb + j; const f16x8 b0 = *(const LAS f16x8*)(lds + l16 * WST + (32 * kk + 8 * g) * 2); acc = ML_MFMA(af[j], b0, acc); }
            __builtin_amdgcn_sched_barrier(0); }
        float rs4[4];
#pragma unroll
        for (int r = 0; r < 4; ++r) rs4[r] = __int_as_float(__builtin_amdgcn_ds_bpermute((4 * g + r) << 2, __float_as_int(rsv)));
        if (l16 < 8) {
#pragma unroll
            for (int r = 0; r < 4; ++r) gates[(size_t)(tokb + 4 * g + r) * 8 + l16] = acc[r] * rs4[r]; } }
    __syncthreads();
}

__device__ __forceinline__ void phase_router1(Frame& F, int l) {
    unsigned char* ws = F.ws; const bf16* xbp = (const bf16*)(ws + WS_XB); const float* wr = (const float*)(ws + WS_WR); const float* ssq = (const float*)(ws + WS_SSQ);
    u32x4* tokinfo = (u32x4*)(ws + WS_TOKINFO); int* cntb = (int*)(ws + WS_CNTB); unsigned char* xq8 = ws + WS_XQ8; const bool f8 = layer_f8(l);
    const int tid = F.tid, lane = F.lane, w = F.wave, l16 = lane & 15, g = lane >> 4, tpb = NTOK / F.G; LAS unsigned char* lds = F.lds;
    constexpr int WST = 2064;
    LAS int* clsL = (LAS int*)(lds + SCR_OFF); LAS float* fL = (LAS float*)(lds + SCR_OFF + 2048); LAS float* lgL = (LAS float*)(lds + 32 * WST) + w * 512;
    for (int e = tid; e < 32 * 128; e += NTHREADS) { const int n = e >> 7, k8 = (e & 127) * 8; u32x4 o_ = (u32x4){0u, 0u, 0u, 0u};
        if (n < 20) { const f32x4 a0 = *(const f32x4*)(wr + n * D + k8), a1 = *(const f32x4*)(wr + n * D + k8 + 4); o_.x = pk2(a0[0], a0[1]); o_.y = pk2(a0[2], a0[3]); o_.z = pk2(a1[0], a1[1]); o_.w = pk2(a1[2], a1[3]); }
        *(LAS u32x4*)(lds + n * WST + k8 * 2) = o_; }
    __syncthreads();
    for (int t0 = w * 16; t0 < tpb; t0 += NWAVES * 16) { const int tokb = F.bx * tpb + t0;
        f32x4 acc0 = (f32x4){0.f, 0.f, 0.f, 0.f}, acc1 = acc0; const bf16* xrow = xbp + (size_t)(tokb + l16) * D + 8 * g;
        const float rsv = pg8::rstd_from_ssq(ssq, tokb + l16);
        const float bias0 = wr[20 * D + l16]; float bias1 = wr[20 * D + 16 + (l16 & 3)];
#pragma unroll
        for (int kb = 0; kb < 2; ++kb) { f16x8 af[16];
#pragma unroll
            for (int j = 0; j < 16; ++j) af[j] = *(const f16x8*)(xrow + 32 * (16 * kb + j));
            __builtin_amdgcn_sched_barrier(0);
            if (f8) {
#pragma unroll
                for (int j = 0; j < 16; ++j) { u32x2 o; o.x = f8x4((float)af[j][0], (float)af[j][1], (float)af[j][2], (float)af[j][3]); o.y = f8x4((float)af[j][4], (float)af[j][5], (float)af[j][6], (float)af[j][7]);
                    *(u32x2*)(xq8 + (size_t)(tokb + l16) * D + 32 * (16 * kb + j) + 8 * g) = o; } }
#pragma unroll
            for (int j = 0; j < 16; ++j) { const int kk = 16 * kb + j; const f16x8 b0 = *(const LAS f16x8*)(lds + l16 * WST + (32 * kk + 8 * g) * 2), b1 = *(const LAS f16x8*)(lds + (16 + l16) * WST + (32 * kk + 8 * g) * 2);
                acc0 = ML_MFMA(af[j], b0, acc0); acc1 = ML_MFMA(af[j], b1, acc1); } }
        bias1 = l16 < 4 ? bias1 : 0.f;
#pragma unroll
        for (int r = 0; r < 4; ++r) { const float rs = __int_as_float(__builtin_amdgcn_ds_bpermute((4 * g + r) << 2, __float_as_int(rsv))); lgL[(4 * g + r) * 32 + l16] = acc0[r] * rs + bias0; lgL[(4 * g + r) * 32 + 16 + l16] = acc1[r] * rs + bias1; }
        LDS_WAIT();
        if (lane < 16) { const LAS float* lp = lgL + lane * 32; const f32x4 lg = *(const LAS f32x4*)lp; const int tok = tokb + lane;
            int gs = 0; float gm = lg[0];
#pragma unroll
            for (int j = 1; j < 4; ++j) if (lg[j] > gm) { gm = lg[j]; gs = j; }
            float gsum = 0.f;
#pragma unroll
            for (int j = 0; j < 4; ++j) gsum += __expf(lg[j] - gm);
            const float psel = 1.f / gsum; const f32x4 es = *(const LAS f32x4*)(lp + 4 + 4 * gs);
            int i0 = 0; float m0 = es[0];
#pragma unroll
            for (int e = 1; e < 4; ++e) if (es[e] > m0) { m0 = es[e]; i0 = e; }
            int i1 = -1; float m1 = -INFINITY;
#pragma unroll
            for (int e = 0; e < 4; ++e) if (e != i0 && es[e] > m1) { m1 = es[e]; i1 = e; }
            const float e1 = __expf(m1 - m0); const float w0 = 1.f / (1.f + e1), w1 = e1 / (1.f + e1);
            const int ea = i0 < i1 ? i0 : i1, eb = i0 < i1 ? i1 : i0; const float ga = psel * (i0 < i1 ? w0 : w1), gb = psel * (i0 < i1 ? w1 : w0);
            const int lt = t0 + lane; clsL[lt] = gs * 6 + pair_index(ea, eb); fL[lt] = ga; fL[tpb + lt] = gb; fL[2 * tpb + lt] = rsv; (void)tok; }
        LDS_WAIT(); }
    __syncthreads();
    int c_ = 0, rank_ = 0;
    if (F.tid < tpb) { c_ = clsL[F.tid]; for (int t = 0; t < F.tid; ++t) rank_ += (clsL[t] == c_) ? 1 : 0; }
    LAS int* baseL = (LAS int*)(lds + SCR_OFF + 1024);
    if (F.tid >= 256 && F.tid < 256 + 32) { const int c = F.tid - 256; int n = 0; if (c < NCLS) for (int t = 0; t < tpb; ++t) n += (clsL[t] == c) ? 1 : 0;
        int base = 0; if (n > 0) base = (int)__hip_atomic_fetch_add((GAS unsigned*)(F.ctl + CW_CNT + l * 32 + c), (unsigned)n, __ATOMIC_RELAXED, __HIP_MEMORY_SCOPE_AGENT);
        baseL[c] = base; }
    __syncthreads();
    if (F.tid < tpb) { int* tokl = (int*)(ws + WS_SLOT); float* gwa = (float*)(ws + WS_SLOT + SLOT_ARR); float* gwb = (float*)(ws + WS_SLOT + 2 * SLOT_ARR); float* rsl = (float*)(ws + WS_SLOT + 3 * SLOT_ARR);
        const size_t o = (size_t)c_ * CLSCAP + baseL[c_] + rank_; tokl[o] = F.bx * tpb + F.tid; gwa[o] = fL[F.tid]; gwb[o] = fL[tpb + F.tid]; rsl[o] = fL[2 * tpb + F.tid]; }
}
__device__ __forceinline__ void phase_router2(Frame& F, int l) {
    unsigned char* ws = F.ws; const u32x4* tokinfo = (const u32x4*)(ws + WS_TOKINFO); const int* cntb = (const int*)(ws + WS_CNTB);
    int* tokl = (int*)(ws + WS_SLOT); float* gwa = (float*)(ws + WS_SLOT + SLOT_ARR); float* gwb = (float*)(ws + WS_SLOT + 2 * SLOT_ARR); float* rsl = (float*)(ws + WS_SLOT + 3 * SLOT_ARR);
    const int tpb = NTOK / F.G; LAS int* baseL = (LAS int*)(F.lds + SCR_OFF);
    { const int c = F.tid & 31, part = F.tid >> 5; int acc = 0; for (int b2 = part; b2 < F.bx; b2 += 16) acc += cntb[b2 * 32 + c];
      ((LAS int*)(F.lds + SCR_OFF + 1024))[part * 32 + c] = acc; }
    __syncthreads();
    if (F.tid < 32) { int acc = 0;
#pragma unroll
        for (int part = 0; part < 16; ++part) acc += ((LAS int*)(F.lds + SCR_OFF + 1024))[part * 32 + F.tid]; baseL[F.tid] = acc;
        if (F.bx == F.G - 1 && F.tid < NCLS) F.ctl[CW_CNT + l * 32 + F.tid] = (unsigned)(acc + cntb[F.bx * 32 + F.tid]); }
    __syncthreads();
    if (F.tid < tpb) { const int tok = F.bx * tpb + F.tid; const u32x4 inf = tokinfo[tok]; const int cls = inf.x & 255, rank = inf.x >> 8;
        const size_t o = (size_t)cls * CLSCAP + baseL[cls] + rank; tokl[o] = tok; gwa[o] = __uint_as_float(inf.y); gwb[o] = __uint_as_float(inf.z); rsl[o] = __uint_as_float(inf.w); }
}

__device__ __forceinline__ const char* uni_ptr(const char* p) { const unsigned long long v = (unsigned long long)p; const unsigned lo = __builtin_amdgcn_readfirstlane((unsigned)v), hi = __builtin_amdgcn_readfirstlane((unsigned)(v >> 32)); return (const char*)(((unsigned long long)hi << 32) | lo); }
struct SchedMoe {
    const LAS int* tb; const unsigned* cnt; const char* A; const char* B; const int* tokl; int ncol, G, c, nwg; bool up; int eb;
    __device__ __forceinline__ bool next(int i, pg8::Unit& u) const {
        const long L = (long)i * G + c; if (L >= nwg) return false;
        const int id = pg8::xcd_remap((int)L, nwg); const int rt = id / ncol, ct = id % ncol;
        int cls = 0;
#pragma unroll 1
        for (int k = 1; k < NCLS; ++k) if (rt >= tb[k]) cls = k;
        const int slot0 = (rt - tb[cls]) * 256; const int g = cls / 6, pr = cls % 6;
        const int ea = pr < 3 ? 0 : (pr < 5 ? 1 : 2), eb = pr < 3 ? pr + 1 : (pr < 5 ? pr - 1 : 3);
        u.pm = rt; u.pn = ct; u.cls = cls; u.slot0 = slot0; u.nvalid = (int)cnt[cls] - slot0; u.rows = tokl + (size_t)cls * CLSCAP + slot0;
        if (up) { const int ge = g * 4 + (ct < 4 ? ea : eb); u.a = A; u.b = B + ((size_t)ge * 1024 + (ct & 3) * 256) * (size_t)(D * this->eb); }
        else { u.a = A + (size_t)rt * 256 * 1024 * this->eb; u.b = B + ((size_t)cls * 1024 + ct * 256) * (size_t)(1024 * this->eb); }
        u.a = uni_ptr(u.a); u.b = uni_ptr(u.b); u.rows = (const int*)uni_ptr((const char*)u.rows);
        u.pm = __builtin_amdgcn_readfirstlane(u.pm); u.pn = __builtin_amdgcn_readfirstlane(u.pn); u.cls = __builtin_amdgcn_readfirstlane(u.cls); u.slot0 = __builtin_amdgcn_readfirstlane(u.slot0); u.nvalid = __builtin_amdgcn_readfirstlane(u.nvalid);
        return true;
    }
};

__global__ void __launch_bounds__(NTHREADS, 2) hyb_fwd(Args args) {
    extern __shared__ __attribute__((aligned(16))) unsigned char lds[];
    Frame F;
    F.lds = (LAS unsigned char*)lds; F.MISC = (volatile LAS unsigned*)(F.lds + MISC_OFF);
    F.tid = threadIdx.x; F.lane = F.tid & 63; F.wave = __builtin_amdgcn_readfirstlane(F.tid >> 6); F.G = gridDim.x; F.bx = blockIdx.x;
    F.ws = args.ws; F.ctl = (unsigned*)(args.ws + WS_CTL); F.out = args.out;
    for (int u = F.tid; u < (PTAB_OFF - LDSCTL_OFF) / 4; u += NTHREADS) ((LAS unsigned*)(F.lds + LDSCTL_OFF))[u] = 0u;
    if (F.tid == 0) {
#pragma unroll
        for (int i = 0; i < 26; ++i) ((LAS unsigned long long*)(F.lds + PTAB_OFF))[i] = (unsigned long long)args.in[i]; }
    __syncthreads();
    XcdBarrier bar; bar.bar = F.ctl + CW_BAR; bar.x = 0; bar.st = nullptr;
    const bool one_launch = (args.ph_hi - args.ph_lo) > 1;
    if (one_launch) bar = xcd_barrier_post(F.ctl + CW_BAR, F.MISC + 8);
    const int wave0 = __builtin_amdgcn_readfirstlane((int)threadIdx.x >> 6);
    for (int ph = args.ph_lo; ph < args.ph_hi; ++ph) {
        {
          GAS unsigned char* w_ = (GAS unsigned char*)args.ws; asm volatile("" : "+s"(w_)); F.ws = (unsigned char*)w_; F.ctl = (unsigned*)(F.ws + WS_CTL);
          GAS float* o_ = (GAS float*)args.out; asm volatile("" : "+s"(o_)); F.out = (float*)o_;
          unsigned lb_ = 0; asm volatile("" : "+s"(lb_)); F.lds = (LAS unsigned char*)lds + lb_; F.MISC = (volatile LAS unsigned*)(F.lds + MISC_OFF);
          int g_ = gridDim.x, b_ = blockIdx.x; asm volatile("" : "+s"(g_), "+s"(b_)); F.G = g_; F.bx = b_; }
        unsigned char* ws = F.ws;
        bf16* xb = (bf16*)(ws + WS_XB); float* ssq = (float*)(ws + WS_SSQ);
        const int l = ph / PH_PER_LAYER, p = ph % PH_PER_LAYER;
#define PH_BEGIN() do { int wv_ = wave0; unsigned z_ = 0u; asm volatile("" : "+s"(wv_), "+s"(z_)); F.lane = (int)__builtin_amdgcn_mbcnt_hi(~0u, __builtin_amdgcn_mbcnt_lo(~0u, z_)); F.wave = wv_; F.tid = wv_ * 64 + F.lane; } while (0)
        if (ph == PH_FINAL) {
            PH_BEGIN();
            const float* g = F.in_(25); const int gw = F.bx * NWAVES + F.wave, NGW = F.G * NWAVES;
            constexpr int RB = 2;
            for (int m0 = gw; m0 < NTOK; m0 += RB * NGW) { u32x4 q4[RB][2]; f32x4 gg[2][2];
#pragma unroll
                for (int j = 0; j < 2; ++j) { gg[j][0] = ((const f32x4*)g)[128 * j + 2 * F.lane]; gg[j][1] = ((const f32x4*)g)[128 * j + 2 * F.lane + 1]; }
#pragma unroll
                for (int r4 = 0; r4 < RB; ++r4) { const int mm = m0 + r4 * NGW; const int m = mm < NTOK ? mm : NTOK - 1; const u32x4* xr = (const u32x4*)(xb + (size_t)m * D) + F.lane; q4[r4][0] = xr[0]; q4[r4][1] = xr[64]; }
                __builtin_amdgcn_sched_barrier(0);
#pragma unroll
                for (int r4 = 0; r4 < RB; ++r4) { const int m = m0 + r4 * NGW; if (m < NTOK) { float v[16]; float s_ = 0.f;
#pragma unroll
                    for (int j = 0; j < 2; ++j) { const u32x4 q_ = q4[r4][j]; v[8 * j] = bflo(q_.x); v[8 * j + 1] = bfhi(q_.x); v[8 * j + 2] = bflo(q_.y); v[8 * j + 3] = bfhi(q_.y); v[8 * j + 4] = bflo(q_.z); v[8 * j + 5] = bfhi(q_.z); v[8 * j + 6] = bflo(q_.w); v[8 * j + 7] = bfhi(q_.w); }
#pragma unroll
                    for (int e = 0; e < 16; ++e) s_ += v[e] * v[e];
                    const float r = rsqrtf(wave_sum(s_) * (1.0f / D) + EPS);
#pragma unroll
                    for (int j = 0; j < 2; ++j) { const f32x4 g0 = gg[j][0], g1 = gg[j][1]; f32x4* op = (f32x4*)(F.out + (size_t)m * D) + 128 * j + 2 * F.lane;
                        op[0] = (f32x4){v[8 * j] * r * g0[0], v[8 * j + 1] * r * g0[1], v[8 * j + 2] * r * g0[2], v[8 * j + 3] * r * g0[3]}; op[1] = (f32x4){v[8 * j + 4] * r * g1[0], v[8 * j + 5] * r * g1[1], v[8 * j + 6] * r * g1[2], v[8 * j + 7] * r * g1[3]}; } } } }
        } else if (p == 0) {
            PH_BEGIN(); phase_convert(F, l, l == 0 ? 0 : 1);
        } else if (p == 1) {
            PH_BEGIN();
            if (l > 0) phase_gates(F);
            { pg8::SchedInKv S; S.A = (const char*)xb; S.B = (const char*)(ws + WS_WIN); S.A2 = (const char*)(ws + WS_MEMB); S.B2 = (const char*)(ws + WS_WMKV); S.G = F.G; S.c = F.bx; S.tstep = (size_t)256 * D * 2;
              S.ncol = l > 0 ? 14 : 15; S.nkv = l > 0 ? 0 : 128;
              pg8::EpiScaleBf16 E{(bf16*)(ws + WS_PROJ), NPROJ, ssq, l == 0 ? (const float*)(ws + WS_RTAB) : nullptr, (float*)(ws + WS_GATES), 14, (bf16*)(ws + WS_KV), 2048, (const float*)(ws + WS_MEMR)};
              pg8::gemm_phase<pg8::EpiScaleBf16, pg8::SchedInKv, false>(F.lds, F.tid, D, S, E); }
        } else if (p == 2) {
            PH_BEGIN(); phase_mixer(F, l, l, args.mode);
        } else if (p == 3) {
            PH_BEGIN(); phase_ml_scan(F); if (l > 0) { __syncthreads(); phase_convert(F, l, 2); }
        } else if (p == 4) {
            PH_BEGIN();
            X3Pf pf; x3_load(F, F.bx, pf);
            for (int it = F.bx; it < 1024; it += F.G) { Frame G = F;
                { int t_ = F.wave * 64 + pg8::lane_fresh(); G.tid = t_; G.lane = t_ & 63; G.wave = __builtin_amdgcn_readfirstlane(t_ >> 6);
                  unsigned lb_ = 0; asm volatile("" : "+s"(lb_)); G.lds = F.lds + lb_;
                  GAS unsigned char* w_ = (GAS unsigned char*)F.ws; asm volatile("" : "+s"(w_)); G.ws = (unsigned char*)w_; }
                ml_x3(G, l, it, pf, (it + F.G < 1024) ? it + F.G : -1); }
        } else if (p == 5 || p == 8) {
            PH_BEGIN();
            if (p == 8 && F8_MO) { pg8::SchedDense S; S.init(ws + WS_O, ws + WS_WMO, NTOK, D, D / 2, F.G, F.bx);
                pg8::EpiRes<false, true> E{xb, ssq, args.mode == 2};
                pg8::gemm_phase<pg8::EpiRes<false, true>, pg8::SchedDense, false, true>(F.lds, F.tid, D / 2, S, E); }
            else { pg8::SchedDense S; S.init(p == 5 ? ws + WS_Y : ws + WS_O, p == 5 ? ws + WS_WOUT : ws + WS_WMO, NTOK, D, D, F.G, F.bx);
                pg8::EpiRes<false> E{xb, ssq, args.mode == 2, (p == 5 && F8_Q) ? ws + WS_XQ8 : nullptr};
                pg8::gemm_phase<pg8::EpiRes<false>, pg8::SchedDense, false>(F.lds, F.tid, D, S, E); }
        } else if (p == 6) {
            PH_BEGIN();
            if (F8_Q) { pg8::SchedDense S; S.init(ws + WS_XQ8, ws + WS_WMQ, NTOK, D, D / 2, F.G, F.bx);
                pg8::EpiScaleBf16 E{(bf16*)(ws + WS_Q), D, ssq, nullptr, nullptr, 1 << 30, nullptr, 0, nullptr, 1.0f / F8_WSCALE};
                pg8::gemm_phase<pg8::EpiScaleBf16, pg8::SchedDense, false, true>(F.lds, F.tid, D / 2, S, E); }
            else { pg8::SchedDense S; S.init(xb, ws + WS_WMQ, NTOK, D, D, F.G, F.bx);
                pg8::EpiScaleBf16 E{(bf16*)(ws + WS_Q), D, ssq, nullptr, nullptr, 1 << 30, nullptr, 0, nullptr};
                pg8::gemm_phase<pg8::EpiScaleBf16, pg8::SchedDense, false>(F.lds, F.tid, D, S, E); }
        } else if (p == 7) {
            PH_BEGIN(); phase_xattn2(F);
        } else if (p == 9) {
            PH_BEGIN(); phase_router1(F, l);
        } else if (p == 10) {
            continue;
        } else {
            PH_BEGIN();
            LAS int* tb = (LAS int*)(F.lds + SCR_OFF); const unsigned* cnt = F.ctl + CW_CNT + l * 32;
            __syncthreads();
            if (F.tid < 32) tb[40 + F.tid] = (F.tid < NCLS) ? (((int)__hip_atomic_load(cnt + F.tid, RLX_AGENT) + 255) >> 8) : 0;
            __syncthreads();
            if (F.tid == 0) { int acc = 0; for (int k = 0; k < NCLS; ++k) { tb[k] = acc; acc += tb[40 + k]; } tb[NCLS] = acc; }
            __syncthreads();
            SchedMoe S; S.tb = tb; S.cnt = cnt; S.tokl = (const int*)(ws + WS_SLOT); S.G = F.G; S.c = F.bx; S.up = (p == 11);
            const bool f8 = layer_f8(l); S.eb = f8 ? 1 : 2;
            if (p == 11) { S.ncol = 8; S.nwg = tb[NCLS] * 8; S.A = f8 ? (const char*)(ws + WS_XQ8) : (const char*)xb; S.B = (const char*)(ws + WS_W13);
                if (f8) { pg8::EpiMoe1<true> E{(bf16*)(ws + WS_HID), (const float*)(ws + WS_SLOT + 3 * SLOT_ARR), (const float*)(ws + WS_SLOT + SLOT_ARR), (const float*)(ws + WS_SLOT + 2 * SLOT_ARR)};
                    pg8::gemm_phase<pg8::EpiMoe1<true>, SchedMoe, true, true>(F.lds, F.tid, D / 2, S, E); }
                else { pg8::EpiMoe1<false> E{(bf16*)(ws + WS_HID), (const float*)(ws + WS_SLOT + 3 * SLOT_ARR), (const float*)(ws + WS_SLOT + SLOT_ARR), (const float*)(ws + WS_SLOT + 2 * SLOT_ARR)};
                    pg8::gemm_phase<pg8::EpiMoe1<false>, SchedMoe, true, false>(F.lds, F.tid, D, S, E); } }
            else { S.ncol = 4; S.nwg = tb[NCLS] * 4; S.A = (const char*)(ws + WS_HID); S.B = (const char*)(ws + WS_W2C);
                if (f8) { pg8::EpiRes<true, true> E{xb, ssq, args.mode == 2}; pg8::gemm_phase<pg8::EpiRes<true, true>, SchedMoe, false, true>(F.lds, F.tid, 512, S, E); }
                else { pg8::EpiRes<true, false> E{xb, ssq, args.mode == 2}; pg8::gemm_phase<pg8::EpiRes<true, false>, SchedMoe, false, false>(F.lds, F.tid, 1024, S, E); }
                if (l + 1 < DEPTH) {
                    pg8::SchedKv K; K.A2 = (const char*)(ws + WS_MEMB8); K.B2 = (const char*)(ws + (((l + 1) & 1) ? WS_WMKV2 : WS_WMKV)); K.G = F.G; K.c = F.bx; K.tstep = (size_t)256 * D;
                    pg8::EpiScaleBf16 EK{nullptr, 0, ssq, nullptr, nullptr, 14, (bf16*)(ws + WS_KV), 2048, (const float*)(ws + WS_MEMR), 1.0f / F8_WSCALE};
                    int t2 = F.tid; asm volatile("" : "+v"(t2));
                    pg8::gemm_phase<pg8::EpiScaleBf16, pg8::SchedKv, false, true>(F.lds, t2, D / 2, K, EK); } }
            __syncthreads();
        }
        if (p == 12 && l + 1 < DEPTH && (args.ph_hi - args.ph_lo) > 1) continue;
        if (ph + 1 < args.ph_hi) xcd_barrier(bar);
    }
}

extern "C" void kernel_launch(void* const* d_in, const int* in_sizes, int n_in, void* d_out, int out_size, void* d_ws, size_t ws_size, hipStream_t stream) {
    static int grid = 0;
    if (grid == 0) {
        if (n_in != 26 || in_sizes[0] != NTOK * D || out_size != NTOK * D || ws_size < WS_END) { fprintf(stderr, "kernel_launch: unexpected shapes (n_in %d, in0 %d, out %d, ws %zu, need %zu); nothing launched\n", n_in, n_in > 0 ? in_sizes[0] : -1, out_size, ws_size, (size_t)WS_END); grid = -1; return; }
        int dev = 0, cus = 0;
        if (hipGetDevice(&dev) != hipSuccess || hipDeviceGetAttribute(&cus, hipDeviceAttributeMultiprocessorCount, dev) != hipSuccess) { grid = -1; return; }
        if (hipFuncSetAttribute((const void*)hyb_fwd, hipFuncAttributeMaxDynamicSharedMemorySize, LDS_BYTES) != hipSuccess) { fprintf(stderr, "kernel_launch: hipFuncSetAttribute failed\n"); grid = -1; return; }
        int per_cu = 0;
        if (hipOccupancyMaxActiveBlocksPerMultiprocessor(&per_cu, (const void*)hyb_fwd, NTHREADS, LDS_BYTES) != hipSuccess || per_cu < 1) fprintf(stderr, "kernel_launch: occupancy query reports %d\n", per_cu);
        (void)hipGetLastError();
        grid = cus >= 256 ? 256 : (cus >= 128 ? 128 : 64);
    }
    if (grid < 0) return;
    (void)hipMemsetAsync((char*)d_ws + WS_CTL, 0, CTL_ZERO_BYTES, stream);
    Args a{};
    for (int i = 0; i < 26; ++i) a.in[i] = (const float*)d_in[i];
    a.out = (float*)d_out; a.ws = (unsigned char*)d_ws;
#if MK_N_LAUNCHES == 1
    a.ph_lo = 0; a.ph_hi = N_PHASES;
    hipLaunchKernelGGL(hyb_fwd, dim3(grid), dim3(NTHREADS), LDS_BYTES, stream, a);
#else
    for (int ph = 0; ph < N_PHASES; ++ph) {
        a.ph_lo = ph; a.ph_hi = ph + 1; hipLaunchKernelGGL(hyb_fwd, dim3(grid), dim3(NTHREADS), LDS_BYTES, stream, a);
        if (MK_REPEAT_P >= 0 && ph != PH_FINAL && ph % PH_PER_LAYER == MK_REPEAT_P) {
            if (MK_REPEAT_P == 2) (void)hipMemsetD32Async((hipDeviceptr_t)((char*)d_ws + WS_CTL + (CW_Q + ph / PH_PER_LAYER) * 4), MK_PROBE_QSTART, 1, stream);
            a.mode = MK_PROBE_MODE; hipLaunchKernelGGL(hyb_fwd, dim3(grid), dim3(NTHREADS), LDS_BYTES, stream, a); a.mode = 0; } }
#endif
}
```
